# Optimizing an MI355X kernel written in HIP

```python
import math
import jax, jax.numpy as jnp
from jax import lax
import numpy as np

D_MODEL = 1024
BATCH = 8
SEQ = 2048
DEPTH = 1

D_MIX = D_MODEL
GLA_WIDTH = D_MIX // 2
S5_WIDTH = D_MIX - GLA_WIDTH
GLA_HEADS = 4
GLA_DV = GLA_WIDTH // GLA_HEADS
GLA_DK = GLA_DV // 2
GLA_LOWRANK = 16
GLA_TAU = 16.0
GLA_CHUNK = 64
S5_CH = 16
S5_GROUPS = S5_WIDTH // S5_CH
S5_STATE = 64
DT_MIN = 1e-3
DT_MAX = 1e-1
N_EXPERTS = 32
TOP_K = 4
D_FF = D_MODEL
SWIGLU_ALPHA = 1.702
SWIGLU_LIMIT = 7.0
MOE_BLOCK = 128
EPS = 1e-6
Q_COLS = GLA_HEADS * GLA_DK
K_COLS = GLA_HEADS * GLA_DK
V_COLS = GLA_WIDTH
G_COLS = GLA_WIDTH
A_COLS = GLA_LOWRANK
U_COLS = S5_WIDTH
N_IN = Q_COLS + K_COLS + V_COLS + G_COLS + A_COLS + U_COLS
SPLITS = [Q_COLS, Q_COLS + K_COLS, Q_COLS + K_COLS + V_COLS, Q_COLS + K_COLS + V_COLS + G_COLS,
          Q_COLS + K_COLS + V_COLS + G_COLS + A_COLS]

kernel_name = "hymba_gla_s5_moe_block"


def rmsnorm(x, g):
    xf = x.astype(jnp.float32)
    r = lax.rsqrt(jnp.mean(xf * xf, axis=-1, keepdims=True) + EPS)
    return (xf * r * g.astype(jnp.float32)).astype(x.dtype)


def gla_chunked(q, k, v, log_a):
    f32 = jnp.float32
    B_, H_, T_, DK_ = q.shape
    DV_ = v.shape[-1]
    C = GLA_CHUNK
    nc = T_ // C
    q = q.astype(f32).reshape(B_, H_, nc, C, DK_) * (DK_ ** -0.5)
    k = k.astype(f32).reshape(B_, H_, nc, C, DK_)
    v = v.astype(f32).reshape(B_, H_, nc, C, DV_)
    b = jnp.cumsum(log_a.astype(f32).reshape(B_, H_, nc, C, DK_), axis=3)
    b_last = b[:, :, :, -1:, :]
    q_dec = q * jnp.exp(b)
    k_inv = k * jnp.exp(-b)
    k_to_end = k * jnp.exp(b_last - b)
    causal = jnp.tril(jnp.ones((C, C), dtype=bool))
    scores = jnp.where(causal, jnp.einsum('bhnik,bhnjk->bhnij', q_dec, k_inv), 0.0)
    o_intra = jnp.einsum('bhnij,bhnjv->bhniv', scores, v)
    delta = jnp.einsum('bhnjk,bhnjv->bhnkv', k_to_end, v)
    decay = jnp.exp(b_last[:, :, :, 0, :])

    def step(S, inp):
        d, dS = inp
        return d[..., None] * S + dS, S

    S0 = jnp.zeros((B_, H_, DK_, DV_), f32)
    _, S_prev = lax.scan(step, S0, (jnp.moveaxis(decay, 2, 0), jnp.moveaxis(delta, 2, 0)))
    S_prev = jnp.moveaxis(S_prev, 0, 2)
    o_inter = jnp.einsum('bhnik,bhnkv->bhniv', q_dec, S_prev)
    return (o_intra + o_inter).reshape(B_, H_, T_, DV_)


def s5_layer(u, lam_re, lam_im, log_dt, b_re, b_im, c_re, c_im, d, glu_w, glu_b):
    f32 = jnp.float32
    B_, T_, _ = u.shape
    uf = u.astype(f32).reshape(B_, T_, S5_GROUPS, S5_CH)
    lr = lam_re.astype(f32)
    li = lam_im.astype(f32)
    dt = jnp.exp(log_dt.astype(f32))[:, None]
    mag = jnp.exp(lr * dt)
    ab_re = mag * jnp.cos(li * dt)
    ab_im = mag * jnp.sin(li * dt)
    den = lr * lr + li * li
    f_re = ((ab_re - 1.0) * lr + ab_im * li) / den
    f_im = (ab_im * lr - (ab_re - 1.0) * li) / den
    br = b_re.astype(f32)
    bi = b_im.astype(f32)
    bb_re = f_re[..., None] * br - f_im[..., None] * bi
    bb_im = f_re[..., None] * bi + f_im[..., None] * br
    bu_re = jnp.einsum('btgh,gph->btgp', uf, bb_re)
    bu_im = jnp.einsum('btgh,gph->btgp', uf, bb_im)
    a_re = jnp.broadcast_to(ab_re, (1, T_, S5_GROUPS, S5_STATE))
    a_im = jnp.broadcast_to(ab_im, (1, T_, S5_GROUPS, S5_STATE))

    def combine(e1, e2):
        a1r, a1i, b1r, b1i = e1
        a2r, a2i, b2r, b2i = e2
        return (a2r * a1r - a2i * a1i,
                a2r * a1i + a2i * a1r,
                a2r * b1r - a2i * b1i + b2r,
                a2r * b1i + a2i * b1r + b2i)

    _, _, xr, xi = lax.associative_scan(combine, (a_re, a_im, bu_re, bu_im), axis=1)
    y = (jnp.einsum('btgp,ghp->btgh', xr, c_re.astype(f32))
         - jnp.einsum('btgp,ghp->btgh', xi, c_im.astype(f32))
         + d.astype(f32) * uf)
    y = jax.nn.gelu(y.reshape(B_, T_, S5_WIDTH))
    return y * jax.nn.sigmoid(y @ glu_w.astype(f32) + glu_b.astype(f32))


def moe_ffn(h, router_w, router_b, w_gu, b_gu, w_down, b_down):
    f32 = jnp.float32
    B_, T_, D_ = h.shape
    N = B_ * T_
    NK = N * TOP_K
    xt = h.reshape(N, D_)
    logits = (xt @ router_w + router_b).astype(f32)
    top_val, top_idx = lax.top_k(logits, TOP_K)
    gate = jax.nn.softmax(top_val, axis=-1)
    flat_e = top_idx.reshape(NK).astype(jnp.int32)
    flat_tok = jnp.arange(NK, dtype=jnp.int32) // TOP_K
    flat_w = gate.reshape(NK)
    order = jnp.argsort(flat_e)
    se, stok, sw = flat_e[order], flat_tok[order], flat_w[order]
    counts = jnp.zeros((N_EXPERTS,), jnp.int32).at[flat_e].add(1)
    starts = jnp.cumsum(counts) - counts
    padded = (counts + MOE_BLOCK - 1) // MOE_BLOCK * MOE_BLOCK
    pends = jnp.cumsum(padded)
    pstarts = pends - padded
    dest = pstarts[se] + jnp.arange(NK, dtype=jnp.int32) - starts[se]
    n_blocks = -(-NK // MOE_BLOCK) + N_EXPERTS
    cap = n_blocks * MOE_BLOCK
    tok_buf = jnp.full((cap,), N, jnp.int32).at[dest].set(stok)
    w_buf = jnp.zeros((cap,), f32).at[dest].set(sw)
    block_e = jnp.minimum(
        jnp.searchsorted(pends, jnp.arange(n_blocks, dtype=jnp.int32) * MOE_BLOCK, side='right'),
        N_EXPERTS - 1).astype(jnp.int32)
    x_pad = jnp.concatenate([xt, jnp.zeros((1, D_), xt.dtype)], axis=0)
    xb = x_pad[tok_buf].reshape(n_blocks, MOE_BLOCK, D_)

    def expert_block(args):
        xblk, e = args
        gu = xblk @ w_gu[e] + b_gu[e]
        g, up = gu[:, :D_FF], gu[:, D_FF:]
        g = jnp.minimum(g, SWIGLU_LIMIT)
        up = jnp.clip(up, -SWIGLU_LIMIT, SWIGLU_LIMIT)
        act = (up + 1.0) * (g * jax.nn.sigmoid(SWIGLU_ALPHA * g))
        return act @ w_down[e] + b_down[e]

    yb = lax.map(expert_block, (xb, block_e)).reshape(cap, D_)
    out = jnp.zeros((N + 1, D_), f32).at[tok_buf].add(yb.astype(f32) * w_buf[:, None])[:N]
    return out.reshape(B_, T_, D_).astype(h.dtype)


def setup_inputs(seed: int = 0) -> dict:
    key = jax.random.key(seed)
    ks = jax.random.split(key, 32)
    f32 = jnp.float32
    L, D = DEPTH, D_MODEL

    def nrm(k, shape, scale):
        return jax.random.normal(k, shape, f32) * scale

    n_idx = jnp.arange(S5_STATE, dtype=f32)
    return {
        "x": nrm(ks[0], (BATCH, SEQ, D), 1.0),
        "c": nrm(ks[1], (BATCH, D), 1.0),
        "ada_w": nrm(ks[2], (L, D, 6 * D), 0.02),
        "ada_b": nrm(ks[3], (L, 6 * D), 0.02),
        "mix_pre_g": 1.0 + nrm(ks[4], (L, D), 0.05),
        "mix_post_g": 1.0 + nrm(ks[5], (L, D), 0.05),
        "ffn_pre_g": 1.0 + nrm(ks[6], (L, D), 0.05),
        "ffn_post_g": 1.0 + nrm(ks[7], (L, D), 0.05),
        "w_in": nrm(ks[8], (L, D, N_IN), D ** -0.5),
        "w_alpha": nrm(ks[9], (L, GLA_LOWRANK, GLA_HEADS * GLA_DK), GLA_LOWRANK ** -0.5),
        "b_alpha": nrm(ks[10], (L, GLA_HEADS * GLA_DK), 0.1),
        "gla_norm_g": 1.0 + nrm(ks[11], (L, GLA_DV), 0.05),
        "s5_lambda_re": -0.5 + nrm(ks[12], (L, S5_GROUPS, S5_STATE), 0.01),
        "s5_lambda_im": math.pi * n_idx + nrm(ks[13], (L, S5_GROUPS, S5_STATE), 0.01),
        "s5_log_dt": jax.random.uniform(ks[14], (L, S5_GROUPS), f32, math.log(DT_MIN), math.log(DT_MAX)),
        "s5_b_re": nrm(ks[15], (L, S5_GROUPS, S5_STATE, S5_CH), (2 * S5_CH) ** -0.5),
        "s5_b_im": nrm(ks[16], (L, S5_GROUPS, S5_STATE, S5_CH), (2 * S5_CH) ** -0.5),
        "s5_c_re": nrm(ks[17], (L, S5_GROUPS, S5_CH, S5_STATE), S5_STATE ** -0.5),
        "s5_c_im": nrm(ks[18], (L, S5_GROUPS, S5_CH, S5_STATE), S5_STATE ** -0.5),
        "s5_d": nrm(ks[19], (L, S5_GROUPS, S5_CH), 1.0),
        "s5_glu_w": nrm(ks[20], (L, S5_WIDTH, S5_WIDTH), S5_WIDTH ** -0.5),
        "s5_glu_b": nrm(ks[21], (L, S5_WIDTH), 0.01),
        "w_out": nrm(ks[22], (L, D_MIX, D), D_MIX ** -0.5),
        "router_w": nrm(ks[23], (L, D, N_EXPERTS), D ** -0.5),
        "router_b": nrm(ks[24], (L, N_EXPERTS), 0.01),
        "exp_w_gu": nrm(ks[25], (L, N_EXPERTS, D, 2 * D_FF), D ** -0.5),
        "exp_b_gu": nrm(ks[26], (L, N_EXPERTS, 2 * D_FF), 0.01),
        "exp_w_down": nrm(ks[27], (L, N_EXPERTS, D_FF, D), D_FF ** -0.5),
        "exp_b_down": nrm(ks[28], (L, N_EXPERTS, D), 0.01),
    }


def reference(x, c, ada_w, ada_b, mix_pre_g, mix_post_g, ffn_pre_g, ffn_post_g, w_in, w_alpha, b_alpha,
              gla_norm_g, s5_lambda_re, s5_lambda_im, s5_log_dt, s5_b_re, s5_b_im, s5_c_re, s5_c_im, s5_d,
              s5_glu_w, s5_glu_b, w_out, router_w, router_b, exp_w_gu, exp_b_gu, exp_w_down, exp_b_down):
    B_, T_, D_ = x.shape
    h = x
    for l in range(DEPTH):
        mod = jax.nn.silu(c) @ ada_w[l] + ada_b[l]
        sh1, sc1, g1, sh2, sc2, g2 = jnp.split(mod, 6, axis=-1)

        hn = rmsnorm(h, mix_pre_g[l]) * (1.0 + sc1[:, None, :]) + sh1[:, None, :]
        proj = hn @ w_in[l]
        q, k, v, og, a_lr, u = jnp.split(proj, SPLITS, axis=-1)

        def heads(t, dh):
            return t.reshape(B_, T_, GLA_HEADS, dh).transpose(0, 2, 1, 3)

        log_a = jax.nn.log_sigmoid((a_lr @ w_alpha[l] + b_alpha[l]).astype(jnp.float32)) / GLA_TAU
        o = gla_chunked(heads(q, GLA_DK), heads(k, GLA_DK), heads(v, GLA_DV), heads(log_a, GLA_DK))
        o = rmsnorm(o, gla_norm_g[l]).transpose(0, 2, 1, 3)
        gla_out = (o * jax.nn.silu(og.astype(jnp.float32)).reshape(B_, T_, GLA_HEADS, GLA_DV))
        gla_out = gla_out.reshape(B_, T_, GLA_WIDTH).astype(hn.dtype)

        s5_out = s5_layer(u, s5_lambda_re[l], s5_lambda_im[l], s5_log_dt[l], s5_b_re[l], s5_b_im[l],
                          s5_c_re[l], s5_c_im[l], s5_d[l], s5_glu_w[l], s5_glu_b[l]).astype(hn.dtype)

        mix = jnp.concatenate([gla_out, s5_out], axis=-1) @ w_out[l]
        h = h + g1[:, None, :] * rmsnorm(mix, mix_post_g[l])

        hn2 = rmsnorm(h, ffn_pre_g[l]) * (1.0 + sc2[:, None, :]) + sh2[:, None, :]
        ff = moe_ffn(hn2, router_w[l], router_b[l], exp_w_gu[l], exp_b_gu[l], exp_w_down[l], exp_b_down[l])
        h = h + g2[:, None, :] * rmsnorm(ff, ffn_post_g[l])
    return h
```

```cpp
#include <hip/hip_runtime.h>
#include <cstdio>
#include <cstdint>

#define LAS __attribute__((address_space(3)))
typedef unsigned short bf16_t;
typedef unsigned v4u __attribute__((ext_vector_type(4)));
typedef unsigned v2u __attribute__((ext_vector_type(2)));
typedef float f32x4 __attribute__((ext_vector_type(4)));
typedef __bf16 bf16x2 __attribute__((ext_vector_type(2)));
typedef short s16x4 __attribute__((ext_vector_type(4)));
typedef short s16x8 __attribute__((ext_vector_type(8)));

constexpr int NB = 8, NT = 2048, D = 1024, NTOK = NB * NT;
constexpr int NIN = 2064, NPROJ = 2048;
constexpr int GH = 4, DK = 64, DV = 128;
constexpr int SG = 32, SP = 64, SC = 16;
constexpr int NE = 32, DFF = 1024;
constexpr int LISTCAP = 16384, MAXROWS = 65536 + NE * 256;
constexpr float EPS = 1e-6f;
constexpr int PQ = 0, PK = 256, PV = 512, PG = 1024, PU = 1536;

constexpr size_t MiB = 1u << 20;
constexpr size_t WS_CTL = 0, CTL_BYTES = 64 * 1024;
constexpr size_t WS_MOD = 1 * MiB;
constexpr size_t WS_S5AB = 2 * MiB, WS_S5BB = 2 * MiB + 65536;
constexpr size_t WS_WIN_T = 3 * MiB, WS_GLU_T = 7 * MiB, WS_WOUT_T = 8 * MiB, WS_ALR = 10 * MiB;
constexpr size_t WS_ROUTE_E = 11 * MiB, WS_ROUTE_W = 11 * MiB + 512 * 1024, WS_LIST = 12 * MiB;
constexpr size_t WS_HN = 16 * MiB, WS_PROJ = 48 * MiB, WS_MIXIN = 112 * MiB, WS_Y5 = 144 * MiB, WS_MIX = 160 * MiB, WS_H1 = 192 * MiB;
constexpr size_t WS_DELTA = 256 * MiB, WS_SPREV = 288 * MiB;
constexpr size_t WS_GU_T = 320 * MiB, WS_DN_T = 448 * MiB, WS_HACT = 512 * MiB, WS_YEXP = 656 * MiB;
constexpr size_t WS_SE = 800 * MiB, WS_SMF = 804 * MiB, WS_UX = 810 * MiB, WS_DX = 834 * MiB, WS_BC = 850 * MiB, WS_DEC = 866 * MiB, WS_END = 868 * MiB;
constexpr size_t WS_APOW = 14 * MiB, WS_A256 = 14 * MiB + 512 * 1024;
constexpr int CW_CNT = 8192;
constexpr int CW_BAR = 4096;

constexpr int NWAVES = 8, NTHR = 512;
constexpr int LDS_BYTES = 163840;
constexpr int MISC_OFF = 131072 + 8192;

__device__ __forceinline__ float bf2f(unsigned v) { return __uint_as_float(v << 16); }
__device__ __forceinline__ unsigned f2bf(float f) { unsigned u = __float_as_uint(f); return (u + 0x7fffu + ((u >> 16) & 1u)) >> 16; }
typedef float f32x2_t __attribute__((ext_vector_type(2)));
__device__ __forceinline__ unsigned pk2(float lo, float hi) { const f32x2_t v = {lo, hi}; return __builtin_bit_cast(unsigned, __builtin_convertvector(v, bf16x2)); }
__device__ __forceinline__ float wave_sum(float v) {
#pragma unroll
    for (int o = 1; o < 64; o <<= 1) v += __shfl_xor(v, o);
    return v;
}
__device__ __forceinline__ float sigmoidf_(float x) { return __builtin_amdgcn_rcpf(1.f + __builtin_amdgcn_exp2f(-1.4426950408889634f * x)); }
__device__ __forceinline__ float logsigmoidf_(float z) { return fminf(z, 0.f) - 0.6931471805599453f * __builtin_amdgcn_logf(1.f + __builtin_amdgcn_exp2f(-1.4426950408889634f * fabsf(z))); }
__device__ __forceinline__ float gelu_tanh(float y) { return y * sigmoidf_(1.5957691216057308f * (y + 0.044715f * y * y * y)); }

__device__ __forceinline__ float sat8(float x) { return __builtin_amdgcn_fmed3f(x, -448.f, 448.f); }
__device__ __forceinline__ unsigned pk4_fp8(float a, float b, float c, float d) { int p = __builtin_amdgcn_cvt_pk_fp8_f32(sat8(a), sat8(b), 0, false); p = __builtin_amdgcn_cvt_pk_fp8_f32(sat8(c), sat8(d), p, true); return (unsigned)p; }
constexpr float W8_SCALE = 64.f, ACT8_SCALE = 4.f, Y8_SCALE = 8.f;
constexpr int SC_ONE = 0x7f7f7f7f, SC_W8 = 0x79797979, SC_ACT8 = 0x7d7d7d7d;

#define XB_TMO      128
#define XB_XCNT(j)  (256  + 64 * (j))
#define XB_XSUB(j)  (1280 + 64 * (j))
#define XB_XGEN(j)  (2304 + 64 * (j))
#define XB_TOP      3328
#define XB_TOPGEN   3392
#define XCD_BAR_WORDS 3456
#define XB_SPIN_CAP (1u << 18)

__device__ __forceinline__ unsigned xb_ld(unsigned* p)              { return __hip_atomic_load(p, __ATOMIC_RELAXED, __HIP_MEMORY_SCOPE_AGENT); }
__device__ __forceinline__ unsigned xb_add(unsigned* p, unsigned v) { return __hip_atomic_fetch_add(p, v, __ATOMIC_RELAXED, __HIP_MEMORY_SCOPE_AGENT); }
__device__ __forceinline__ unsigned xb_xcc_id() { return (unsigned)__builtin_amdgcn_s_getreg((3 << 11) | 20) & 0xFu; }
#define XB_SPIN(cond, bar) do { unsigned _sp = 0; while (cond) { __builtin_amdgcn_s_sleep(1); \
    if ((++_sp & 255u) == 0u) { if (xb_ld(&(bar)[XB_TMO])) break; if (_sp > XB_SPIN_CAP) { atomicAdd(&(bar)[XB_TMO], 1u); break; } } } } while (0)

struct XcdBarrier {
    unsigned* bar; unsigned x;
    volatile LAS unsigned* st;
};
__device__ __forceinline__ XcdBarrier xcd_barrier_post(unsigned* bar, volatile LAS unsigned* st) {
    XcdBarrier b; b.bar = bar; b.x = xb_xcc_id(); b.st = st;
    if (threadIdx.x == 0) (void)xb_add(&bar[XB_XCNT(b.x)], 1u);
    return b;
}
__device__ __forceinline__ void xcd_barrier_complete(unsigned* bar, unsigned x, unsigned& nloc, unsigned& nx) {
    const unsigned G = gridDim.x * gridDim.y * gridDim.z;
    unsigned sum, cnt, mine, sp = 0u;
    for (;;) {
        sum = 0u; cnt = 0u; mine = 0u;
#pragma unroll
        for (unsigned j = 0; j < 16; ++j) { const unsigned c = xb_ld(&bar[XB_XCNT(j)]); sum += c; cnt += (c > 0u) ? 1u : 0u; mine = (j == x) ? c : mine; }
        if (sum == G) break;
        __builtin_amdgcn_s_sleep(1);
        if ((++sp & 255u) == 0u) { if (xb_ld(&bar[XB_TMO])) break; if (sp > XB_SPIN_CAP) { atomicAdd(&bar[XB_TMO], 1u); break; } }
    }
    nloc = mine > 0u ? mine : 1u; nx = cnt > 0u ? cnt : 1u;
}
__device__ __forceinline__ void xcd_barrier(const XcdBarrier& b) {
    asm volatile("s_waitcnt vmcnt(0)" ::: "memory");
    __syncthreads();
    if (threadIdx.x == 0) {
        unsigned* bar = b.bar;
        __builtin_amdgcn_s_waitcnt(0);
        unsigned nloc = b.st[0], nx = b.st[1];
        if (nloc == 0u) { xcd_barrier_complete(bar, b.x, nloc, nx); b.st[0] = nloc; b.st[1] = nx; }
        const unsigned old = xb_add(&bar[XB_XSUB(b.x)], 1u);
        const unsigned gen = old / nloc;
        if (old + 1u == (gen + 1u) * nloc) {
            __builtin_amdgcn_fence(__ATOMIC_RELEASE, "agent");
            asm volatile("s_waitcnt vmcnt(0)" ::: "memory");
            const unsigned og = xb_add(&bar[XB_TOP], 1u);
            const unsigned tg = og / nx;
            if (og + 1u == (tg + 1u) * nx) xb_add(&bar[XB_TOPGEN], 1u);
            else XB_SPIN(xb_ld(&bar[XB_TOPGEN]) == tg, bar);
            __builtin_amdgcn_fence(__ATOMIC_ACQUIRE, "agent");
            xb_add(&bar[XB_XGEN(b.x)], 1u);
            asm volatile("s_waitcnt vmcnt(0)" ::: "memory");
        } else {
            __builtin_amdgcn_fence(__ATOMIC_ACQUIRE, "agent");
            XB_SPIN(xb_ld(&bar[XB_XGEN(b.x)]) == gen, bar);
            asm volatile("s_waitcnt vmcnt(0)" ::: "memory");
        }
    }
    __syncthreads();
}


namespace pg8 {
typedef short bf16x8 __attribute__((ext_vector_type(8)));
typedef unsigned u32x4 __attribute__((ext_vector_type(4)));
constexpr int BM = 256, BK = 64, HALF = 128, HTB = HALF * BK * 2, STAGE_BYTES = 8 * HTB, NXCD = 8, WGM = 4;
__device__ __forceinline__ int lds_byte(int r, int c) { const int st = (r >> 4) * 2 + (c >> 5), rr = r & 15, cc = c & 31, ob = rr * 64 + cc * 2; return st * 1024 + (ob ^ (((ob >> 9) & 1) << 5)); }
__device__ __forceinline__ void stage_rc(int b, int& R, int& C) { const int st = b / 1024, sb = b % 1024, swz = sb ^ (((sb >> 9) & 1) << 5); R = (st >> 1) * 16 + swz / 64; C = (st & 1) * 32 + (swz % 64) / 2; }
__device__ __forceinline__ int perm32(int rho) { const int n = rho >> 4, i = rho & 15; return 8 * (i >> 2) + 4 * n + (i & 3); }
__device__ __forceinline__ unsigned cvt_pk_bf16(float lo, float hi) { unsigned r; asm volatile("v_cvt_pk_bf16_f32 %0, %1, %2" : "=v"(r) : "v"(lo), "v"(hi)); return r; }

typedef int v8i_t __attribute__((ext_vector_type(8)));
typedef int v4i_t __attribute__((ext_vector_type(4)));
template <int H> __device__ __forceinline__ bf16x8 half8(v8i_t v) { const v4i_t h = H ? __builtin_shufflevector(v, v, 4, 5, 6, 7) : __builtin_shufflevector(v, v, 0, 1, 2, 3); return __builtin_bit_cast(bf16x8, h); }
__device__ __forceinline__ unsigned ufl(unsigned v) { return (unsigned)__builtin_amdgcn_readfirstlane((int)v); }
struct Unit { int pm, pn, e, ui; unsigned ao, bo; };

__device__ __forceinline__ bool order_map(int i, int G, int c, int nM, int nN, int& pm, int& pn) {
    const int nwg = nM * nN; const long L = (long)i * G + c; if (L >= nwg) return false;
    int wgid = (int)L; { const int q = nwg / NXCD, r = nwg % NXCD, xcd = wgid % NXCD, off = wgid / NXCD; wgid = (xcd < r ? xcd * (q + 1) : r * (q + 1) + (xcd - r) * q) + off; }
    const int nig = WGM * nN, gid = wgid / nig, fm = gid * WGM, gsz = (nM - fm) < WGM ? (nM - fm) : WGM;
    pm = fm + ((wgid % nig) % gsz); pn = (wgid % nig) / gsz; return true;
}
struct DenseSched {
    const char* A; const char* Bt; int nM, nN, K, G, c, ldaB, ldbB;
    __device__ __forceinline__ void init(const bf16_t* A_, const bf16_t* Bt_, int M, int N, int K_, int G_, int c_) { A = (const char*)A_; Bt = (const char*)Bt_; nM = M / BM; nN = N / BM; K = K_; G = G_; c = c_; ldaB = K_ * 2; ldbB = K_ * 2; }
    __device__ __forceinline__ bool next(int i, Unit& u) const { int pm, pn; if (!order_map(i, G, c, nM, nN, pm, pn)) return false;
        u.pm = pm; u.pn = pn; u.e = 0; u.ui = i; u.ao = (unsigned)pm * BM * ldaB; u.bo = (unsigned)pn * BM * ldbB; return true; }
    __device__ __forceinline__ const LAS unsigned short* tok(int) const { return nullptr; }
    __device__ __forceinline__ const char* abuf() const { return A; }
    __device__ __forceinline__ const char* bbuf() const { return Bt; }
};

template <class Epi, class Sched, bool GATHER, bool FP8 = false, bool ALIGN = true>
__device__ __forceinline__ void gemm_phase(LAS unsigned char* lds, const int nt, const Sched& S, const Epi& E) {
    const int ldaB = S.ldaB, ldbB = S.ldbB;
    const __amdgpu_buffer_rsrc_t rsA = __builtin_amdgcn_make_buffer_rsrc((void*)S.abuf(), (short)0, 0x7ffffff0, 0x00020000);
    const __amdgpu_buffer_rsrc_t rsB = __builtin_amdgcn_make_buffer_rsrc((void*)S.bbuf(), (short)0, 0x7ffffff0, 0x00020000);
    const int tid = threadIdx.x, wid = __builtin_amdgcn_readfirstlane(tid >> 6), lane = tid & 63, wr = wid >> 2, wc = wid & 3, fr = lane & 15, fq = lane >> 4;
    int voffA[2], voffB[2];
#pragma unroll
    for (int i = 0; i < 2; ++i) { int R, C; stage_rc(tid * 16 + i * 8192, R, C); const int Rb = (R & ~31) + perm32(R & 31);
        voffA[i] = GATHER ? (C * 2) : (R * ldaB + C * 2); voffB[i] = Rb * ldbB + C * 2; }
    int vg0[2], vg1[2];
    const unsigned kstep = 128u;
    const unsigned hstepA = (unsigned)HALF * ldaB, hstep = (unsigned)HALF * ldbB;
    const unsigned ldsw = (unsigned)wid * 1024u;
    const int aoff = lds_byte(wr * 64 + fr, fq * 8), boff = lds_byte(wc * 32 + fr, fq * 8);
#define PG8_SA(b, h) (((b) * 2 + (h)) * HTB)
#define PG8_SB(b, h) ((4 + (b) * 2 + (h)) * HTB)
#define PG8_STAGE(bufoff, rs, soff, voff) do { _Pragma("unroll") for (int _i = 0; _i < 2; ++_i) \
        __builtin_amdgcn_raw_ptr_buffer_load_lds(rs, (LAS void*)(lds + (bufoff) + ldsw + _i * 8192), 16, (voff)[_i], (int)(soff), 0, 0); } while (0)
#define PG8_STAGE_A(bufoff, uoff, kb, h) do { if constexpr (GATHER) { if ((h) == 0) PG8_STAGE(bufoff, rsA, (kb), vg0); else PG8_STAGE(bufoff, rsA, (kb), vg1); } \
        else PG8_STAGE(bufoff, rsA, (uoff) + (kb) + (h) * hstepA, voffA); } while (0)
#define PG8_LDA(dst, b, h) do { _Pragma("unroll") for (int m = 0; m < 4; ++m) { const v4i_t _lo = *(const LAS v4i_t*)(lds + PG8_SA(b, h) + aoff + m * 2048), _hi = *(const LAS v4i_t*)(lds + PG8_SA(b, h) + aoff + m * 2048 + 1024); \
        dst[m] = __builtin_shufflevector(_lo, _hi, 0, 1, 2, 3, 4, 5, 6, 7); } } while (0)
#define PG8_LDB(dst, b, h) do { _Pragma("unroll") for (int n = 0; n < 2; ++n) { const v4i_t _lo = *(const LAS v4i_t*)(lds + PG8_SB(b, h) + boff + n * 2048), _hi = *(const LAS v4i_t*)(lds + PG8_SB(b, h) + boff + n * 2048 + 1024); \
        dst[n] = __builtin_shufflevector(_lo, _hi, 0, 1, 2, 3, 4, 5, 6, 7); } } while (0)
#define PG8_MMA(ai, bj, At, Bt) do { __builtin_amdgcn_s_setprio(1); _Pragma("unroll") for (int m = 0; m < 4; ++m) _Pragma("unroll") for (int n = 0; n < 2; ++n) { \
        if constexpr (FP8) acc[ai][bj][m][n] = __builtin_amdgcn_mfma_scale_f32_16x16x128_f8f6f4(Bt[n], At[m], acc[ai][bj][m][n], 0, 0, 0, E.scale_b, 0, E.scale_a); \
        else { acc[ai][bj][m][n] = __builtin_amdgcn_mfma_f32_16x16x32_bf16(half8<0>(Bt[n]), half8<0>(At[m]), acc[ai][bj][m][n], 0, 0, 0); \
               acc[ai][bj][m][n] = __builtin_amdgcn_mfma_f32_16x16x32_bf16(half8<1>(Bt[n]), half8<1>(At[m]), acc[ai][bj][m][n], 0, 0, 0); } } \
        __builtin_amdgcn_s_setprio(0); } while (0)
#define PG8_WAIT_V(n) asm volatile("s_waitcnt vmcnt(" #n ")" ::: "memory")
#define PG8_WAIT_L(n) asm volatile("s_waitcnt lgkmcnt(" #n ")" ::: "memory")
#define PG8_BAR __builtin_amdgcn_s_barrier()
#define PG8_SCHED __builtin_amdgcn_sched_barrier(0)
#define PG8_TROW(_i) (16 * ((wid + 8 * (_i)) >> 1) + (lane >> 2))
#define PG8_TOKOFF(dst0, dst1, tk) do { _Pragma("unroll") for (int _i = 0; _i < 2; ++_i) { dst0[_i] = (int)(tk)[PG8_TROW(_i)] * ldaB + voffA[0]; dst1[_i] = (int)(tk)[HALF + PG8_TROW(_i)] * ldaB + voffA[0]; } } while (0)
    Unit cur, nxt; int ui = 0;
    if (!S.next(0, cur)) return;
    f32x4 acc[2][2][4][2];
#pragma unroll
    for (int a = 0; a < 2; ++a)
#pragma unroll
        for (int b = 0; b < 2; ++b)
#pragma unroll
            for (int m = 0; m < 4; ++m)
#pragma unroll
                for (int n = 0; n < 2; ++n) acc[a][b][m][n] = (f32x4){0.f, 0.f, 0.f, 0.f};
    v8i_t At[4], B0[2], B1[2];
    unsigned cA = ufl(cur.ao), cB = ufl(cur.bo);
    if constexpr (GATHER) { const LAS unsigned short* tk = S.tok(0); PG8_TOKOFF(vg0, vg1, tk); } else { vg0[0] = vg0[1] = vg1[0] = vg1[1] = 0; }
    PG8_STAGE(PG8_SB(0, 0), rsB, cB, voffB); PG8_STAGE(PG8_SB(0, 1), rsB, cB + hstep, voffB); PG8_STAGE_A(PG8_SA(0, 0), cA, 0u, 0); PG8_STAGE_A(PG8_SA(0, 1), cA, 0u, 1);
    if (wr == 1) PG8_BAR;
    PG8_WAIT_V(2); PG8_BAR;
    PG8_STAGE(PG8_SB(1, 0), rsB, cB + kstep, voffB); PG8_STAGE_A(PG8_SA(1, 0), cA, kstep, 0); PG8_STAGE(PG8_SB(1, 1), rsB, cB + hstep + kstep, voffB);
    PG8_WAIT_V(6); PG8_BAR;
    for (;;) {
        const bool has_next = S.next(ui + 1, nxt);
        const unsigned nA = ufl(has_next ? nxt.ao : cA), nB = ufl(has_next ? nxt.bo : cB);
#pragma clang loop unroll(disable)
        for (int t = 0; t < nt; t += 2) {
            const bool last = (t == nt - 2);
            const unsigned k1 = (unsigned)(t + 1) * kstep;
            const unsigned a2 = last ? nA : cA, k2 = last ? 0u : (unsigned)(t + 2) * kstep, b2 = last ? nB : cB + (unsigned)(t + 2) * kstep;
            const unsigned k3 = k2 + kstep, b3 = b2 + kstep;
            if constexpr (GATHER) { if (last && has_next) { const LAS unsigned short* tk = S.tok(ui + 1);
#pragma unroll
                for (int _i = 0; _i < 2; ++_i) vg0[_i] = (int)tk[PG8_TROW(_i)] * ldaB + voffA[0]; } }
            PG8_LDB(B0, 0, 0); PG8_LDB(B1, 0, 1); PG8_SCHED; PG8_LDA(At, 0, 0); PG8_STAGE_A(PG8_SA(1, 1), cA, k1, 1);
            PG8_WAIT_V(8); PG8_WAIT_L(0); PG8_BAR; PG8_MMA(0, 0, At, B0); PG8_MMA(0, 1, At, B1); PG8_BAR; PG8_SCHED;
            if constexpr (GATHER) { if (last && has_next) { const LAS unsigned short* tk = S.tok(ui + 1);
#pragma unroll
                for (int _i = 0; _i < 2; ++_i) vg1[_i] = (int)tk[HALF + PG8_TROW(_i)] * ldaB + voffA[0]; } }
            PG8_LDA(At, 0, 1); PG8_STAGE(PG8_SB(0, 0), rsB, b2, voffB); PG8_STAGE(PG8_SB(0, 1), rsB, b2 + hstep, voffB); PG8_STAGE_A(PG8_SA(0, 0), a2, k2, 0);
            PG8_WAIT_V(8); PG8_WAIT_L(0); PG8_BAR; PG8_MMA(1, 0, At, B0); PG8_MMA(1, 1, At, B1); PG8_BAR; PG8_SCHED;
            PG8_LDB(B0, 1, 0); PG8_LDB(B1, 1, 1); PG8_SCHED; PG8_LDA(At, 1, 0); PG8_STAGE_A(PG8_SA(0, 1), a2, k2, 1);
            PG8_WAIT_V(8); PG8_WAIT_L(0); PG8_BAR; PG8_MMA(0, 0, At, B0); PG8_MMA(0, 1, At, B1); PG8_BAR; PG8_SCHED;
            PG8_LDA(At, 1, 1); PG8_STAGE(PG8_SB(1, 0), rsB, b3, voffB); PG8_STAGE(PG8_SB(1, 1), rsB, b3 + hstep, voffB); PG8_STAGE_A(PG8_SA(1, 0), a2, k3, 0);
            PG8_WAIT_V(8); PG8_WAIT_L(0); PG8_BAR; PG8_MMA(1, 0, At, B0); PG8_MMA(1, 1, At, B1); PG8_BAR; PG8_SCHED;
        }
        if constexpr (ALIGN) { if (wr == 0) PG8_BAR; }
        E(acc, cur, wr, wc, fr, fq);
        if (!has_next) break;
#pragma unroll
        for (int a = 0; a < 2; ++a)
#pragma unroll
            for (int b = 0; b < 2; ++b)
#pragma unroll
                for (int m = 0; m < 4; ++m)
#pragma unroll
                    for (int n = 0; n < 2; ++n) acc[a][b][m][n] = (f32x4){0.f, 0.f, 0.f, 0.f};
        cur = nxt; cA = nA; cB = nB; ++ui;
        if constexpr (ALIGN) { if (wr == 1) PG8_BAR; }
    }
    PG8_WAIT_V(0);
    if constexpr (!ALIGN) { if (wr == 0) PG8_BAR; }
    PG8_BAR;
#undef PG8_SA
#undef PG8_SB
#undef PG8_STAGE
#undef PG8_STAGE_A
#undef PG8_LDA
#undef PG8_LDB
#undef PG8_MMA
#undef PG8_WAIT_V
#undef PG8_WAIT_L
#undef PG8_BAR
#undef PG8_SCHED
#undef PG8_TOKOFF
#undef PG8_TROW
}

struct EpiStore {
    static constexpr int scale_a = 0x7f7f7f7f, scale_b = 0x7f7f7f7f;
    bf16_t* O; int ldc;
    __device__ __forceinline__ void operator()(const f32x4 (&acc)[2][2][4][2], const Unit& u, int wr, int wc, int fr, int fq) const {
        const int row0 = u.pm * BM + wr * 64 + fr, col0 = u.pn * BM + wc * 32 + 8 * fq;
#pragma unroll
        for (int ai = 0; ai < 2; ++ai)
#pragma unroll
            for (int m = 0; m < 4; ++m) { bf16_t* rowp = O + (size_t)(row0 + ai * HALF + m * 16) * ldc + col0;
#pragma unroll
                for (int bj = 0; bj < 2; ++bj) { const f32x4 v0 = acc[ai][bj][m][0], v1 = acc[ai][bj][m][1];
                    u32x4 w; w.x = cvt_pk_bf16(v0[0], v0[1]); w.y = cvt_pk_bf16(v0[2], v0[3]); w.z = cvt_pk_bf16(v1[0], v1[1]); w.w = cvt_pk_bf16(v1[2], v1[3]);
                    *(u32x4*)(rowp + bj * HALF) = w; } }
    }
};
struct EpiGlu {
    static constexpr int scale_a = 0x7f7f7f7f, scale_b = 0x7f7f7f7f;
    const bf16_t* Y5; bf16_t* O; const float* bias;
    __device__ __forceinline__ void operator()(const f32x4 (&acc)[2][2][4][2], const Unit& u, int wr, int wc, int fr, int fq) const {
        const int row0 = u.pm * BM + wr * 64 + fr, col0 = u.pn * BM + wc * 32 + 8 * fq;
        f32x4 bv[2][2];
#pragma unroll
        for (int bj = 0; bj < 2; ++bj)
#pragma unroll
            for (int n = 0; n < 2; ++n) bv[bj][n] = *(const f32x4*)(bias + col0 + bj * HALF + 4 * n);
#pragma unroll
        for (int ai = 0; ai < 2; ++ai) {
            u32x4 yv[4][2];
#pragma unroll
            for (int m = 0; m < 4; ++m)
#pragma unroll
                for (int bj = 0; bj < 2; ++bj) yv[m][bj] = *(const u32x4*)(Y5 + (size_t)(row0 + ai * HALF + m * 16) * 512 + col0 + bj * HALF);
#pragma unroll
            for (int m = 0; m < 4; ++m) { const int row = row0 + ai * HALF + m * 16;
#pragma unroll
                for (int bj = 0; bj < 2; ++bj) { const f32x4 z0 = acc[ai][bj][m][0] + bv[bj][0], z1 = acc[ai][bj][m][1] + bv[bj][1];
                    const u32x4 y = yv[m][bj];
                    float o[8];
                    o[0] = bf2f(y.x & 0xffffu) * sigmoidf_(z0[0]); o[1] = bf2f(y.x >> 16) * sigmoidf_(z0[1]); o[2] = bf2f(y.y & 0xffffu) * sigmoidf_(z0[2]); o[3] = bf2f(y.y >> 16) * sigmoidf_(z0[3]);
                    o[4] = bf2f(y.z & 0xffffu) * sigmoidf_(z1[0]); o[5] = bf2f(y.z >> 16) * sigmoidf_(z1[1]); o[6] = bf2f(y.w & 0xffffu) * sigmoidf_(z1[2]); o[7] = bf2f(y.w >> 16) * sigmoidf_(z1[3]);
                    u32x4 w; w.x = cvt_pk_bf16(o[0], o[1]); w.y = cvt_pk_bf16(o[2], o[3]); w.z = cvt_pk_bf16(o[4], o[5]); w.w = cvt_pk_bf16(o[6], o[7]);
                    *(u32x4*)(O + (size_t)row * 1024 + 512 + col0 + bj * HALF) = w; } } }
    }
};
constexpr int XT_TOK = 131072;
constexpr int XT_PS = 139264 + 128;
constexpr int XT_BIAS = 147456;
struct ExpSched {
    const char* A; const char* W; LAS unsigned char* lds; int nT, nN, G, c, ldaB, ldbB; unsigned estride;
    __device__ __forceinline__ bool next(int i, Unit& u) const { int pm, pn; if (!order_map(i, G, c, nT, nN, pm, pn)) return false;
        const int e = __builtin_amdgcn_readfirstlane((int)*(const LAS unsigned char*)(lds + XT_PS + 260 + pm));
        u.pm = pm; u.pn = pn; u.e = e; u.ui = i; u.ao = (unsigned)pm * BM * ldaB; u.bo = (unsigned)e * estride + (unsigned)pn * BM * ldbB; return true; }
    __device__ __forceinline__ const LAS unsigned short* tok(int i) const { return (const LAS unsigned short*)(lds + XT_TOK) + i * 256; }
    __device__ __forceinline__ const char* abuf() const { return A; }
    __device__ __forceinline__ const char* bbuf() const { return W; }
};
struct EpiSwiglu {
    static constexpr int scale_a = SC_ONE, scale_b = SC_W8;
    unsigned char* O; const LAS float* bias;
    __device__ __forceinline__ void operator()(const f32x4 (&acc)[2][2][4][2], const Unit& u, int wr, int wc, int fr, int fq) const {
        const int row0 = u.pm * BM + wr * 64 + fr, col0 = u.pn * HALF + wc * 32 + 8 * fq;
        f32x4 bg[2], bu[2];
#pragma unroll
        for (int n = 0; n < 2; ++n) { bg[n] = *(const LAS f32x4*)(bias + u.ui * 256 + wc * 32 + 8 * fq + 4 * n); bu[n] = *(const LAS f32x4*)(bias + u.ui * 256 + 128 + wc * 32 + 8 * fq + 4 * n); }
#pragma unroll
        for (int ai = 0; ai < 2; ++ai)
#pragma unroll
            for (int m = 0; m < 4; ++m) { const int row = row0 + ai * HALF + m * 16; float o[8];
#pragma unroll
                for (int n = 0; n < 2; ++n) { const f32x4 g4 = acc[ai][0][m][n] + bg[n], u4 = acc[ai][1][m][n] + bu[n];
#pragma unroll
                    for (int i = 0; i < 4; ++i) { const float g = fminf(g4[i], 7.f), up = fminf(fmaxf(u4[i], -7.f), 7.f); o[4 * n + i] = ACT8_SCALE * (up + 1.f) * (g * sigmoidf_(1.702f * g)); } }
                v2u w; w.x = pk4_fp8(o[0], o[1], o[2], o[3]); w.y = pk4_fp8(o[4], o[5], o[6], o[7]);
                *(v2u*)(O + (size_t)row * 1024 + col0) = w; }
    }
};
struct EpiDown {
    static constexpr int scale_a = SC_ACT8, scale_b = SC_W8;
    unsigned char* O; const LAS float* bias;
    __device__ __forceinline__ void operator()(const f32x4 (&acc)[2][2][4][2], const Unit& u, int wr, int wc, int fr, int fq) const {
        const int row0 = u.pm * BM + wr * 64 + fr, col0 = u.pn * BM + wc * 32 + 8 * fq;
#pragma unroll
        for (int bj = 0; bj < 2; ++bj) { const f32x4 b0 = *(const LAS f32x4*)(bias + u.ui * 256 + bj * HALF + wc * 32 + 8 * fq), b1 = *(const LAS f32x4*)(bias + u.ui * 256 + bj * HALF + wc * 32 + 8 * fq + 4);
#pragma unroll
            for (int ai = 0; ai < 2; ++ai)
#pragma unroll
                for (int m = 0; m < 4; ++m) { unsigned char* rowp = O + (size_t)(row0 + ai * HALF + m * 16) * 1024 + col0;
                    const f32x4 v0 = (acc[ai][bj][m][0] + b0) * Y8_SCALE, v1 = (acc[ai][bj][m][1] + b1) * Y8_SCALE;
                    v2u w; w.x = pk4_fp8(v0[0], v0[1], v0[2], v0[3]); w.y = pk4_fp8(v1[0], v1[1], v1[2], v1[3]);
                    *(v2u*)(rowp + bj * HALF) = w; } }
    }
};
struct S5Sched {
    const char* UX; const char* Mt; unsigned mstride; int c, ldaB, ldbB;
    __device__ __forceinline__ bool next(int i, Unit& u) const { const int L = c - 128; if (i > 0 || L < 0) return false;
        const int pm = (L >> 3) & 3, g = (L & 7) + 8 * (L >> 5);
        u.pm = pm; u.pn = 0; u.e = g; u.ui = 0; u.ao = (unsigned)(g * 1024 + pm * 256) * 768u; u.bo = (unsigned)g * mstride; return true; }
    __device__ __forceinline__ const LAS unsigned short* tok(int) const { return nullptr; }
    __device__ __forceinline__ const char* abuf() const { return UX; }
    __device__ __forceinline__ const char* bbuf() const { return Mt; }
};
struct EpiDX {
    static constexpr int scale_a = SC_ONE, scale_b = SC_ONE;
    float* O;
    __device__ __forceinline__ void operator()(const f32x4 (&acc)[2][2][4][2], const Unit& u, int wr, int wc, int fr, int fq) const {
        const int row0 = u.e * 1024 + u.pm * BM + wr * 64 + fr, col0 = wc * 32 + 8 * fq;
#pragma unroll
        for (int ai = 0; ai < 2; ++ai)
#pragma unroll
            for (int m = 0; m < 4; ++m) { float* rowp = O + (size_t)(row0 + ai * HALF + m * 16) * 128 + col0;
                *(f32x4*)rowp = acc[ai][0][m][0]; *(f32x4*)(rowp + 4) = acc[ai][0][m][1]; }
    }
};
struct EpiS5Y {
    static constexpr int scale_a = SC_ONE, scale_b = SC_ONE;
    bf16_t* Y5;
    __device__ __forceinline__ void operator()(const f32x4 (&acc)[2][2][4][2], const Unit& u, int wr, int wc, int fr, int fq) const {
        const int g = u.e, r0 = u.pm * BM + wr * 64 + fr;
#pragma unroll
        for (int bj = 0; bj < 2; ++bj) { const int col = bj * HALF + wc * 32 + 8 * fq, t = col >> 4, h0 = col & 15;
#pragma unroll
            for (int ai = 0; ai < 2; ++ai)
#pragma unroll
                for (int m = 0; m < 4; ++m) { const int r = r0 + ai * HALF + m * 16;
                    const f32x4 v0 = acc[ai][bj][m][0], v1 = acc[ai][bj][m][1];
                    u32x4 w; w.x = cvt_pk_bf16(gelu_tanh(v0[0]), gelu_tanh(v0[1])); w.y = cvt_pk_bf16(gelu_tanh(v0[2]), gelu_tanh(v0[3]));
                    w.z = cvt_pk_bf16(gelu_tanh(v1[0]), gelu_tanh(v1[1])); w.w = cvt_pk_bf16(gelu_tanh(v1[2]), gelu_tanh(v1[3]));
                    *(u32x4*)(Y5 + ((size_t)(r * 16 + t) * 512 + g * 16 + h0)) = w; } }
    }
};
struct EpiProj {
    static constexpr int scale_a = SC_ONE, scale_b = SC_ONE;
    bf16_t* O; bf16_t* UX;
    __device__ __forceinline__ void operator()(const f32x4 (&acc)[2][2][4][2], const Unit& u, int wr, int wc, int fr, int fq) const {
        const int row0 = u.pm * BM + wr * 64 + fr, col0 = u.pn * BM + wc * 32 + 8 * fq;
#pragma unroll
        for (int ai = 0; ai < 2; ++ai)
#pragma unroll
            for (int m = 0; m < 4; ++m) { const int row = row0 + ai * HALF + m * 16;
#pragma unroll
                for (int bj = 0; bj < 2; ++bj) { const f32x4 v0 = acc[ai][bj][m][0], v1 = acc[ai][bj][m][1]; const int col = col0 + bj * HALF;
                    u32x4 w; w.x = cvt_pk_bf16(v0[0], v0[1]); w.y = cvt_pk_bf16(v0[2], v0[3]); w.z = cvt_pk_bf16(v1[0], v1[1]); w.w = cvt_pk_bf16(v1[2], v1[3]);
                    if (col < 1536) *(u32x4*)(O + (size_t)row * 2048 + col) = w;
                    else { const int cu = col - 1536, g = cu >> 4, h0 = cu & 15; *(u32x4*)(UX + ((size_t)(g * 1024 + (row >> 4)) * 384 + (row & 15) * 16 + h0)) = w; } } }
    }
};
}

struct Args { const float* in[29]; float* out; unsigned char* ws; int ph_lo, ph_hi; };
enum { I_X = 0, I_C, I_ADAW, I_ADAB, I_MIXPRE, I_MIXPOST, I_FFNPRE, I_FFNPOST, I_WIN, I_WALPHA, I_BALPHA, I_GLANORM,
       I_LRE, I_LIM, I_LOGDT, I_BRE, I_BIM, I_CRE, I_CIM, I_SD, I_GLUW, I_GLUB, I_WOUT, I_RW, I_RB, I_WGU, I_BGU, I_WDN, I_BDN };

struct Ctx { int tid, lane, wave, bid, G, gw, ngw, gtid, ngt; LAS unsigned char* lds; };

template <int MODE> __device__ __forceinline__ int rowmap(int n) {
    if (MODE == 1) { return n < 1536 ? n : (n < 1552 ? -1 : n - 16); }
    if (MODE == 2) { const int jj = n & 1023, up = n >> 10; return 256 * (jj >> 7) + 128 * up + (jj & 127); }
    return n;
}
template <int MODE> __device__ __forceinline__ void transpose_item(const float* W, int K, int N, int kb, int nb, bf16_t* dst, int lane) {
    const int n = nb * 64 + lane, nn = n < N ? n : N - 1;
    const float* src = W + (size_t)(kb * 64) * N + nn;
    float v[64];
#pragma unroll
    for (int i = 0; i < 64; ++i) v[i] = src[(size_t)i * N];
    const int row = n < N ? rowmap<MODE>(n) : -1;
    if (row >= 0) {
        bf16_t* p = dst + (size_t)row * K + kb * 64;
#pragma unroll
        for (int c = 0; c < 8; ++c) { v4u o; o.x = pk2(v[8 * c], v[8 * c + 1]); o.y = pk2(v[8 * c + 2], v[8 * c + 3]); o.z = pk2(v[8 * c + 4], v[8 * c + 5]); o.w = pk2(v[8 * c + 6], v[8 * c + 7]);
            *(v4u*)(p + 8 * c) = o; }
    }
}
struct XItem { const float* W; unsigned char* dst; int N, kt, n0, mode; };
__device__ __forceinline__ XItem xitem(const Args& a, int it) {
    XItem x;
    if (it < 2048) { const int e = it >> 6, r = it & 63; x.W = a.in[I_WGU] + (size_t)e * 1024 * 2048; x.dst = (unsigned char*)(a.ws + WS_GU_T) + (size_t)e * 2048 * 1024; x.N = 2048; x.kt = r >> 3; x.n0 = (r & 7) * 256; x.mode = 2; }
    else { const int i2 = it - 2048, e = i2 >> 5, r = i2 & 31; x.W = a.in[I_WDN] + (size_t)e * 1024 * 1024; x.dst = (unsigned char*)(a.ws + WS_DN_T) + (size_t)e * 1024 * 1024; x.N = 1024; x.kt = r >> 2; x.n0 = (r & 3) * 256; x.mode = 0; }
    return x;
}
constexpr int WI_P0 = 2048, WI_BAR = 1792, WI_NBAR = 9, WI_P3 = WI_P0 + WI_BAR * WI_NBAR, WI_P5 = WI_P3 + 1024, WI_P6 = WI_P5 + 3072, WI_END = 24576;
__device__ __forceinline__ void wconv_item(const Args& a, LAS unsigned char* T, int wi, int lane) {
    const XItem x = xitem(a, wi >> 3); const int n0 = x.n0 + 32 * (wi & 7), r8 = lane >> 3, c4 = lane & 7;
    f32x4 v[16];
#pragma unroll
    for (int i = 0; i < 16; ++i) v[i] = __builtin_nontemporal_load((const f32x4*)(x.W + (size_t)(x.kt * 128 + 16 * r8 + i) * x.N + n0 + 4 * c4));
#pragma unroll
    for (int j = 0; j < 4; ++j) { v4u o;
        o.x = pk4_fp8(v[0][j] * W8_SCALE, v[1][j] * W8_SCALE, v[2][j] * W8_SCALE, v[3][j] * W8_SCALE); o.y = pk4_fp8(v[4][j] * W8_SCALE, v[5][j] * W8_SCALE, v[6][j] * W8_SCALE, v[7][j] * W8_SCALE);
        o.z = pk4_fp8(v[8][j] * W8_SCALE, v[9][j] * W8_SCALE, v[10][j] * W8_SCALE, v[11][j] * W8_SCALE); o.w = pk4_fp8(v[12][j] * W8_SCALE, v[13][j] * W8_SCALE, v[14][j] * W8_SCALE, v[15][j] * W8_SCALE);
        *(LAS v4u*)(T + (4 * c4 + j) * 144 + 16 * r8) = o; }
    asm volatile("s_waitcnt lgkmcnt(0)" ::: "memory");
#pragma unroll
    for (int q = 0; q < 4; ++q) { const int idx = lane + 64 * q, n = idx >> 3, ch = idx & 7;
        const int row = x.mode == 2 ? rowmap<2>(n0 + n) : n0 + n;
        *(v4u*)(x.dst + (size_t)row * 1024 + x.kt * 128 + 16 * ch) = *(const LAS v4u*)(T + n * 144 + 16 * ch); }
    asm volatile("s_waitcnt lgkmcnt(0)" ::: "memory");
}
__device__ __forceinline__ void xcd_barrier_conv(const XcdBarrier& b, const Args& a, const Ctx& c, int bi) {
    asm volatile("s_waitcnt vmcnt(0)" ::: "memory");
    __syncthreads();
    if (c.wave == 0) {
      if (threadIdx.x == 0) {
        unsigned* bar = b.bar;
        __builtin_amdgcn_s_waitcnt(0);
        unsigned nloc = b.st[0], nx = b.st[1];
        if (nloc == 0u) { xcd_barrier_complete(bar, b.x, nloc, nx); b.st[0] = nloc; b.st[1] = nx; }
        const unsigned old = xb_add(&bar[XB_XSUB(b.x)], 1u);
        const unsigned gen = old / nloc;
        if (old + 1u == (gen + 1u) * nloc) {
            __builtin_amdgcn_fence(__ATOMIC_RELEASE, "agent");
            asm volatile("s_waitcnt vmcnt(0)" ::: "memory");
            const unsigned og = xb_add(&bar[XB_TOP], 1u);
            const unsigned tg = og / nx;
            if (og + 1u == (tg + 1u) * nx) xb_add(&bar[XB_TOPGEN], 1u);
            else XB_SPIN(xb_ld(&bar[XB_TOPGEN]) == tg, bar);
            __builtin_amdgcn_fence(__ATOMIC_ACQUIRE, "agent");
            xb_add(&bar[XB_XGEN(b.x)], 1u);
            asm volatile("s_waitcnt vmcnt(0)" ::: "memory");
        } else {
            __builtin_amdgcn_fence(__ATOMIC_ACQUIRE, "agent");
            XB_SPIN(xb_ld(&bar[XB_XGEN(b.x)]) == gen, bar);
            asm volatile("s_waitcnt vmcnt(0)" ::: "memory");
        }
      }
    } else if (bi >= 0 && bi < WI_NBAR) {
        wconv_item(a, c.lds + c.wave * 5120, WI_P0 + WI_BAR * bi + c.bid * 7 + (c.wave - 1), c.lane);
    }
    __syncthreads();
}
__device__ __forceinline__ void ph0_prologue(const Args& a, const Ctx& c) {
    if (c.bid < 192) {
        LAS float* sc = (LAS float*)c.lds;
        LAS float* part = (LAS float*)(c.lds + 32768);
        const float* cin = a.in[I_C];
        for (int i = c.tid; i < 8 * 1024; i += NTHR) { const int b = i >> 10, k = i & 1023; const float x = cin[i]; sc[k * 8 + b] = x * sigmoidf_(x); }
        const int cg = c.tid & 7, rg = c.tid >> 3, n0 = c.bid * 32;
        f32x4 w[16];
#pragma unroll
        for (int s2 = 0; s2 < 16; ++s2) w[s2] = __builtin_nontemporal_load((const f32x4*)(a.in[I_ADAW] + (size_t)(rg + 64 * s2) * 6144 + n0 + 4 * cg));
        __syncthreads();
        f32x4 acc[8];
#pragma unroll
        for (int b = 0; b < 8; ++b) acc[b] = (f32x4){0.f, 0.f, 0.f, 0.f};
#pragma unroll
        for (int s2 = 0; s2 < 16; ++s2) { const int k = rg + 64 * s2; const f32x4 s0 = *(const LAS f32x4*)(sc + k * 8), s1 = *(const LAS f32x4*)(sc + k * 8 + 4);
            acc[0] += w[s2] * s0.x; acc[1] += w[s2] * s0.y; acc[2] += w[s2] * s0.z; acc[3] += w[s2] * s0.w;
            acc[4] += w[s2] * s1.x; acc[5] += w[s2] * s1.y; acc[6] += w[s2] * s1.z; acc[7] += w[s2] * s1.w; }
#pragma unroll
        for (int b = 0; b < 8; ++b) *(LAS f32x4*)(part + (rg * 8 + b) * 32 + 4 * cg) = acc[b];
        __syncthreads();
        if (c.tid < 256) { const int b = c.tid >> 5, cl = c.tid & 31; float sum = a.in[I_ADAB][n0 + cl];
            for (int r2 = 0; r2 < 64; ++r2) sum += part[(r2 * 8 + b) * 32 + cl];
            ((float*)(a.ws + WS_MOD))[b * 6144 + n0 + cl] = sum; }
        __syncthreads();
    }
    if (c.gtid < SG * SP) {
        const int g = c.gtid / SP;
        const double lr = a.in[I_LRE][c.gtid], li = a.in[I_LIM][c.gtid], dt = exp((double)a.in[I_LOGDT][g]);
        const double mag = exp(lr * dt), abr = mag * cos(li * dt), abi = mag * sin(li * dt), den = lr * lr + li * li;
        const double fr = ((abr - 1.0) * lr + abi * li) / den, fi = (abi * lr - (abr - 1.0) * li) / den;
        float* AB = (float*)(a.ws + WS_S5AB); AB[c.gtid * 2] = (float)abr; AB[c.gtid * 2 + 1] = (float)abi;
        { float* AP = (float*)(a.ws + WS_APOW); double pr = 1.0, pi = 0.0;
            for (int n = 0; n <= 16; ++n) { AP[((g * 17 + n) * 64 + (c.gtid & 63)) * 2] = (float)pr; AP[((g * 17 + n) * 64 + (c.gtid & 63)) * 2 + 1] = (float)pi;
                const double tr = pr * abr - pi * abi, ti = pr * abi + pi * abr; pr = tr; pi = ti; }
            double sr = abr, si = abi;
            for (int q = 0; q < 8; ++q) { const double tr = sr * sr - si * si, ti = 2.0 * sr * si; sr = tr; si = ti; }
            float* A2 = (float*)(a.ws + WS_A256); A2[c.gtid * 2] = (float)sr; A2[c.gtid * 2 + 1] = (float)si; }
        float* BB = (float*)(a.ws + WS_S5BB);
        for (int h = 0; h < SC; ++h) { const double br = a.in[I_BRE][c.gtid * SC + h], bi = a.in[I_BIM][c.gtid * SC + h];
            BB[(c.gtid * SC + h) * 2] = (float)(fr * br - fi * bi); BB[(c.gtid * SC + h) * 2 + 1] = (float)(fr * bi + fi * br); }
    }
    { constexpr int IT_WIN = 16 * 33, IT_GLU = 8 * 8, IT_WOUT = 16 * 16, NITEMS = IT_WIN + IT_GLU + IT_WOUT;
        for (int it = (c.bid >= 192 ? (c.bid - 192) * NWAVES + c.wave : NITEMS); it < NITEMS; it += 64 * NWAVES) { int r = it;
            if (r < IT_WIN) { transpose_item<1>(a.in[I_WIN], 1024, NIN, r / 33, r % 33, (bf16_t*)(a.ws + WS_WIN_T), c.lane); continue; } r -= IT_WIN;
            if (r < IT_GLU) { transpose_item<0>(a.in[I_GLUW], 512, 512, r / 8, r % 8, (bf16_t*)(a.ws + WS_GLU_T), c.lane); continue; } r -= IT_GLU;
            transpose_item<0>(a.in[I_WOUT], 1024, 1024, r / 16, r % 16, (bf16_t*)(a.ws + WS_WOUT_T), c.lane); } }
    for (int wi = c.gw; wi < WI_P0; wi += c.ngw) wconv_item(a, c.lds + c.wave * 5120, wi, c.lane);
    __syncthreads();
}

__device__ __forceinline__ void ph1_norm1(const Args& a, const Ctx& c) {
    const float* mod = (const float*)(a.ws + WS_MOD);
    bf16_t* HN = (bf16_t*)(a.ws + WS_HN); float* ALR = (float*)(a.ws + WS_ALR);
    constexpr int PITCH = 2064, LO = 16 * PITCH, PART = 2 * LO;
    s16x8 wh[4], wl[4];
#pragma unroll
    for (int ks = 0; ks < 4; ++ks) { float wv[8];
#pragma unroll
        for (int j = 0; j < 8; ++j) wv[j] = a.in[I_WIN][(size_t)(128 * c.wave + 32 * ks + 8 * (c.lane >> 4) + j) * NIN + 1536 + (c.lane & 15)];
        unsigned hh[4], ll[4];
#pragma unroll
        for (int j = 0; j < 4; ++j) { hh[j] = pk2(wv[2 * j], wv[2 * j + 1]); ll[j] = pk2(wv[2 * j] - bf2f(hh[j] & 0xffffu), wv[2 * j + 1] - bf2f(hh[j] >> 16)); }
        wh[ks] = __builtin_bit_cast(s16x8, (v4u){hh[0], hh[1], hh[2], hh[3]}); wl[ks] = __builtin_bit_cast(s16x8, (v4u){ll[0], ll[1], ll[2], ll[3]}); }
    f32x4 xb[2][2][4];
#define P1_LOAD(buf, it_) do { const int r0_ = 2 * c.gw + 2 * c.ngw * (it_); _Pragma("unroll") for (int r = 0; r < 2; ++r) _Pragma("unroll") for (int j = 0; j < 4; ++j) \
        xb[buf][r][j] = __builtin_nontemporal_load((const f32x4*)(a.in[I_X] + (size_t)(r0_ + r) * D) + c.lane + 64 * j); } while (0)
    P1_LOAD(0, 0);
#pragma unroll
    for (int it = 0; it < 4; ++it) { const int row0 = 2 * c.gw + 2 * c.ngw * it, cbuf = it & 1;
        const int b = row0 / NT;
        f32x4 gv[4], shv[4], scv[4];
#pragma unroll
        for (int j = 0; j < 4; ++j) { const int col = 4 * c.lane + 256 * j; gv[j] = *(const f32x4*)(a.in[I_MIXPRE] + col); shv[j] = *(const f32x4*)(mod + b * 6144 + col); scv[j] = *(const f32x4*)(mod + b * 6144 + 1024 + col) + 1.f; }
        if (it + 1 < 4) P1_LOAD((it + 1) & 1, it + 1);
#pragma unroll
        for (int r = 0; r < 2; ++r) { float ss = 0.f;
#pragma unroll
            for (int j = 0; j < 4; ++j) { const f32x4 v = xb[cbuf][r][j]; ss += (v.x * v.x + v.y * v.y) + (v.z * v.z + v.w * v.w); }
            const float rstd = rsqrtf(wave_sum(ss) * (1.f / D) + EPS);
#pragma unroll
            for (int j = 0; j < 4; ++j) { const int col = 4 * c.lane + 256 * j;
                const f32x4 v = xb[cbuf][r][j] * rstd * gv[j] * scv[j] + shv[j];
                const unsigned h0 = pk2(v.x, v.y), h1 = pk2(v.z, v.w);
                *(v2u*)(HN + (size_t)(row0 + r) * D + col) = (v2u){h0, h1};
                const unsigned l0 = pk2(v.x - bf2f(h0 & 0xffffu), v.y - bf2f(h0 >> 16)), l1 = pk2(v.z - bf2f(h1 & 0xffffu), v.w - bf2f(h1 >> 16));
                const int off = (2 * c.wave + r) * PITCH + col * 2;
                *(LAS v2u*)(c.lds + off) = (v2u){h0, h1}; *(LAS v2u*)(c.lds + LO + off) = (v2u){l0, l1}; } }
        __syncthreads();
        { f32x4 pacc = (f32x4){0.f, 0.f, 0.f, 0.f};
#pragma unroll
            for (int ks = 0; ks < 4; ++ks) { const int aoff = (c.lane & 15) * PITCH + (128 * c.wave + 32 * ks + 8 * (c.lane >> 4)) * 2;
                const s16x8 ahi = *(const LAS s16x8*)(c.lds + aoff), alo = *(const LAS s16x8*)(c.lds + LO + aoff);
                pacc = __builtin_amdgcn_mfma_f32_16x16x32_bf16(ahi, wh[ks], pacc, 0, 0, 0);
                pacc = __builtin_amdgcn_mfma_f32_16x16x32_bf16(ahi, wl[ks], pacc, 0, 0, 0);
                pacc = __builtin_amdgcn_mfma_f32_16x16x32_bf16(alo, wh[ks], pacc, 0, 0, 0); }
            LAS float* part = (LAS float*)(c.lds + PART) + c.wave * 256;
#pragma unroll
            for (int r = 0; r < 4; ++r) part[(4 * (c.lane >> 4) + r) * 16 + (c.lane & 15)] = pacc[r]; }
        __syncthreads();
        if (c.tid < 256) { float sum = 0.f;
#pragma unroll
            for (int w2 = 0; w2 < 8; ++w2) sum += ((const LAS float*)(c.lds + PART))[w2 * 256 + c.tid];
            ALR[((size_t)(16 * c.bid + 2 * c.ngw * it) * 16) + c.tid] = sum; }
    }
#undef P1_LOAD
    __syncthreads();
}

__device__ __forceinline__ float s5_e_val(const float* AP, const float* BB, int g, int row, int col) {
    if (row >= 128) return 0.f;
    const int p = row & 63, im = row >> 6, s_ = col >> 4, h = col & 15;
    const float ar = AP[((g * 17 + 15 - s_) * 64 + p) * 2], ai = AP[((g * 17 + 15 - s_) * 64 + p) * 2 + 1];
    const float br = BB[((g * 64 + p) * 16 + h) * 2], bi = BB[((g * 64 + p) * 16 + h) * 2 + 1];
    return im ? (ar * bi + ai * br) : (ar * br - ai * bi);
}
__device__ __forceinline__ float s5_f_val(const float* AP, const float* CR, const float* CI, int g, int t, int h, int col) {
    const int p = (col - 256) & 63, im = (col - 256) >> 6;
    const float ar = AP[((g * 17 + t + 1) * 64 + p) * 2], ai = AP[((g * 17 + t + 1) * 64 + p) * 2 + 1];
    const float cr = CR[(g * 16 + h) * 64 + p], ci = CI[(g * 16 + h) * 64 + p];
    return im ? -(cr * ai + ci * ar) : (cr * ar - ci * ai);
}
__device__ __forceinline__ void s5_build_mats(const Args& a, const Ctx& c) {
    const float* AP = (const float*)(a.ws + WS_APOW); const float* BB = (const float*)(a.ws + WS_S5BB);
    unsigned* E2 = (unsigned*)(a.ws + WS_SE); unsigned* MF2 = (unsigned*)(a.ws + WS_SMF); bf16_t* MF = (bf16_t*)(a.ws + WS_SMF);
    for (int q0 = c.gtid; q0 < SG * 256 * 128; q0 += 4 * c.ngt) { unsigned w[4];
#pragma unroll
        for (int j = 0; j < 4; ++j) { const int q = q0 + j * c.ngt, qq = q < SG * 256 * 128 ? q : 0, g = qq >> 15, row = (qq >> 7) & 255, col = (qq & 127) * 2;
            w[j] = pk2(s5_e_val(AP, BB, g, row, col), s5_e_val(AP, BB, g, row, col + 1)); }
#pragma unroll
        for (int j = 0; j < 4; ++j) { const int q = q0 + j * c.ngt; if (q < SG * 256 * 128) E2[q] = w[j]; } }
    for (int q0 = c.gtid; q0 < SG * 256 * 192; q0 += 4 * c.ngt) { unsigned w[4]; bool st[4];
#pragma unroll
        for (int j = 0; j < 4; ++j) { const int q = q0 + j * c.ngt, qq = q < SG * 256 * 192 ? q : 0, g = qq / (256 * 192), rem = qq % (256 * 192), row = rem / 192, col = (rem % 192) * 2, t = row >> 4, h = row & 15;
            if (col < 256) { w[j] = 0u; st[j] = (col >> 4) > t; }
            else { w[j] = pk2(s5_f_val(AP, a.in[I_CRE], a.in[I_CIM], g, t, h, col), s5_f_val(AP, a.in[I_CRE], a.in[I_CIM], g, t, h, col + 1)); st[j] = true; }
            st[j] = st[j] && (q < SG * 256 * 192); }
#pragma unroll
        for (int j = 0; j < 4; ++j) if (st[j]) MF2[q0 + j * c.ngt] = w[j]; }
    for (int idx = c.gtid; idx < SG * 16 * 256; idx += c.ngt) { const int g = idx >> 12, tau = (idx >> 8) & 15, h = (idx >> 4) & 15, h2 = idx & 15;
        float sum = 0.f;
#pragma unroll 16
        for (int p = 0; p < 64; ++p) { const float ar = AP[((g * 17 + tau) * 64 + p) * 2], ai = AP[((g * 17 + tau) * 64 + p) * 2 + 1];
            const float br = BB[((g * 64 + p) * 16 + h2) * 2], bi = BB[((g * 64 + p) * 16 + h2) * 2 + 1];
            const float cr = a.in[I_CRE][(g * 16 + h) * 64 + p], ci = a.in[I_CIM][(g * 16 + h) * 64 + p];
            const float zr = ar * br - ai * bi, zi = ar * bi + ai * br;
            sum += cr * zr - ci * zi; }
        if (tau == 0 && h == h2) sum += a.in[I_SD][g * 16 + h];
        const bf16_t kv = (bf16_t)f2bf(sum);
        for (int t = tau; t < 16; ++t) MF[((size_t)g * 256 + t * 16 + h) * 384 + (t - tau) * 16 + h2] = kv; }
}

__device__ __forceinline__ void ph2_gemm1(const Args& a, const Ctx& c) {
    pg8::DenseSched S; S.init((const bf16_t*)(a.ws + WS_HN), (const bf16_t*)(a.ws + WS_WIN_T), NTOK, NPROJ, D, c.G, c.bid);
    pg8::EpiProj E{(bf16_t*)(a.ws + WS_PROJ), (bf16_t*)(a.ws + WS_UX)};
    pg8::gemm_phase<pg8::EpiProj, pg8::DenseSched, false>(c.lds, D / 64, S, E);
}
__device__ __forceinline__ void ph6_glu(const Args& a, const Ctx& c) {
    pg8::DenseSched S; S.init((const bf16_t*)(a.ws + WS_Y5), (const bf16_t*)(a.ws + WS_GLU_T), NTOK, 512, 512, c.G, c.bid);
    pg8::EpiGlu E{(const bf16_t*)(a.ws + WS_Y5), (bf16_t*)(a.ws + WS_MIXIN), a.in[I_GLUB]};
    pg8::gemm_phase<pg8::EpiGlu, pg8::DenseSched, false>(c.lds, 512 / 64, S, E);
}
__device__ __forceinline__ void ph7_wout(const Args& a, const Ctx& c) {
    pg8::DenseSched S; S.init((const bf16_t*)(a.ws + WS_MIXIN), (const bf16_t*)(a.ws + WS_WOUT_T), NTOK, D, D, c.G, c.bid);
    pg8::EpiStore E{(bf16_t*)(a.ws + WS_MIX), D};
    pg8::gemm_phase<pg8::EpiStore, pg8::DenseSched, false>(c.lds, D / 64, S, E);
}


__device__ __forceinline__ void s5_dx_gemm(const Args& a, const Ctx& c) {
    pg8::S5Sched S{(const char*)(a.ws + WS_UX), (const char*)(a.ws + WS_SE), 256u * 256u * 2u, c.bid, 768, 512};
    pg8::EpiDX E{(float*)(a.ws + WS_DX)};
    pg8::gemm_phase<pg8::EpiDX, pg8::S5Sched, false>(c.lds, 256 / 64, S, E);
}
__device__ __forceinline__ void s5_y_gemm(const Args& a, const Ctx& c) {
    pg8::S5Sched S{(const char*)(a.ws + WS_UX), (const char*)(a.ws + WS_SMF), 256u * 384u * 2u, c.bid, 768, 768};
    pg8::EpiS5Y E{(bf16_t*)(a.ws + WS_Y5)};
    pg8::gemm_phase<pg8::EpiS5Y, pg8::S5Sched, false>(c.lds, 384 / 64, S, E);
}
__device__ __forceinline__ void s5_scan(const Args& a, const Ctx& c) {
    const float* AP = (const float*)(a.ws + WS_APOW); const float* A2 = (const float*)(a.ws + WS_A256);
    const float* DX = (const float*)(a.ws + WS_DX); bf16_t* UX = (bf16_t*)(a.ws + WS_UX);
    LAS float* ES = (LAS float*)c.lds;
    for (int bg = c.bid; bg < NB * SG; bg += c.G) { const int b = bg >> 5, g = bg & 31, seg = c.wave, p = c.lane;
        const float ar = AP[((g * 17 + 16) * 64 + p) * 2], ai = AP[((g * 17 + 16) * 64 + p) * 2 + 1];
        const float mr = A2[(g * 64 + p) * 2], mi = A2[(g * 64 + p) * 2 + 1];
        float dr[16], di[16];
        const size_t r0 = (size_t)g * 1024 + b * 128 + seg * 16;
#pragma unroll
        for (int j = 0; j < 16; ++j) { dr[j] = DX[(r0 + j) * 128 + p]; di[j] = DX[(r0 + j) * 128 + 64 + p]; }
        float xr = 0.f, xi = 0.f;
#pragma unroll
        for (int j = 0; j < 16; ++j) { const float nr = ar * xr - ai * xi + dr[j], ni = ar * xi + ai * xr + di[j]; xr = nr; xi = ni; }
        ES[(seg * 64 + p) * 2] = xr; ES[(seg * 64 + p) * 2 + 1] = xi;
        __syncthreads();
        float cr = 0.f, ci = 0.f;
        for (int s2 = 0; s2 < seg; ++s2) { const float er = ES[(s2 * 64 + p) * 2], ei = ES[(s2 * 64 + p) * 2 + 1];
            const float nr = mr * cr - mi * ci + er, ni = mr * ci + mi * cr + ei; cr = nr; ci = ni; }
        xr = cr; xi = ci;
#pragma unroll
        for (int j = 0; j < 16; ++j) { UX[(r0 + j) * 384 + 256 + p] = (bf16_t)f2bf(xr); UX[(r0 + j) * 384 + 320 + p] = (bf16_t)f2bf(xi);
            const float nr = ar * xr - ai * xi + dr[j], ni = ar * xi + ai * xr + di[j]; xr = nr; xi = ni; }
        __syncthreads();
    }
}

__device__ __forceinline__ unsigned offb(unsigned row, unsigned ch) { return 256u * row + 16u * (ch ^ (((row & 3u) << 2) | ((row >> 2) & 3u))); }
__device__ __forceinline__ unsigned offr(unsigned row, unsigned ch) { return 128u * row + 16u * (ch ^ (row & 7u)); }
__device__ __forceinline__ s16x8 tr_frag(const LAS unsigned char* img, int lane, int cb, int ks) {
    const unsigned g = lane >> 4, q = (lane & 15) >> 2, pp = lane & 3;
    const unsigned a0 = offb(32 * ks + 8 * g + q, 2 * cb + (pp >> 1)) + 8 * (pp & 1), a1 = offb(32 * ks + 8 * g + 4 + q, 2 * cb + (pp >> 1)) + 8 * (pp & 1);
    const s16x4 lo = __builtin_amdgcn_ds_read_tr16_b64_v4i16((LAS s16x4*)(img + a0)), hi = __builtin_amdgcn_ds_read_tr16_b64_v4i16((LAS s16x4*)(img + a1));
    return __builtin_shufflevector(lo, hi, 0, 1, 2, 3, 4, 5, 6, 7);
}
__device__ __forceinline__ s16x8 row_frag(const LAS unsigned char* img, int lane, int rb, int ks) {
    return *(const LAS s16x8*)(img + offr(16 * rb + (lane & 15), 4 * ks + (lane >> 4)));
}
__device__ __forceinline__ void gla_pass_a(const Args& a, const Ctx& c) {
    const bf16_t* P = (const bf16_t*)(a.ws + WS_PROJ); const float* ALR = (const float*)(a.ws + WS_ALR);
    float* BC = (float*)(a.ws + WS_BC); bf16_t* DELTA = (bf16_t*)(a.ws + WS_DELTA); float* DEC = (float*)(a.ws + WS_DEC);
    LAS float* ALRl = (LAS float*)c.lds; LAS float* TOT = (LAS float*)(c.lds + 4096);
    LAS unsigned char* KT = c.lds + 8192; LAS unsigned char* VI = c.lds + 16384; LAS bf16_t* Kl = (LAS bf16_t*)(c.lds + 32768);
    const int w = c.wave, d = c.lane;
    const int hh = (c.bid >> 5) & 3;
    float wal[16];
#pragma unroll
    for (int j = 0; j < 16; ++j) wal[j] = a.in[I_WALPHA][j * 256 + hh * 64 + d];
    const float bal = a.in[I_BALPHA][hh * 64 + d];
    f32x4 pa = (f32x4){0.f, 0.f, 0.f, 0.f}; v4u pv[2], pkt;
#define GLA_A_PREFETCH(u_) do { const int b_ = (u_) >> 7, h_ = ((u_) >> 5) & 3, ch_ = (u_) & 31; const size_t r_ = (size_t)b_ * NT + ch_ * 64; \
        if (c.tid < 256) pa = *(const f32x4*)(ALR + (r_ + (c.tid >> 2)) * 16 + (c.tid & 3) * 4); \
        _Pragma("unroll") for (int i = 0; i < 2; ++i) { const int idx = c.tid + 512 * i; pv[i] = *(const v4u*)(P + (r_ + (idx >> 4)) * NPROJ + PV + h_ * 128 + 8 * (idx & 15)); } \
        pkt = *(const v4u*)(P + (r_ + (c.tid >> 3)) * NPROJ + PK + h_ * 64 + 8 * (c.tid & 7)); } while (0)
    if (c.bid < NB * GH * 32) GLA_A_PREFETCH(c.bid);
    for (int unit = c.bid; unit < NB * GH * 32; unit += c.G) {
        const int b = unit >> 7, h = (unit >> 5) & 3, ch = unit & 31; const size_t r0 = (size_t)b * NT + ch * 64;
        if (c.tid < 256) *(LAS f32x4*)(ALRl + (c.tid >> 2) * 16 + (c.tid & 3) * 4) = pa;
#pragma unroll
        for (int i = 0; i < 2; ++i) { const int idx = c.tid + 512 * i; *(LAS v4u*)(VI + offb(idx >> 4, idx & 15)) = pv[i]; }
        *(LAS v4u*)(Kl + (c.tid >> 3) * 64 + 8 * (c.tid & 7)) = pkt;
        __syncthreads();
        if (unit + c.G < NB * GH * 32) GLA_A_PREFETCH(unit + c.G);
        float loc[8]; float run = 0.f;
#pragma unroll
        for (int tt = 0; tt < 8; ++tt) { const int t = 8 * w + tt; float z = bal;
#pragma unroll
            for (int q = 0; q < 4; ++q) { const f32x4 x = *(const LAS f32x4*)(ALRl + t * 16 + 4 * q); z += x.x * wal[4 * q] + x.y * wal[4 * q + 1] + x.z * wal[4 * q + 2] + x.w * wal[4 * q + 3]; }
            run += logsigmoidf_(z) * (1.f / 16.f); loc[tt] = run; }
        TOT[w * 64 + d] = run;
        __syncthreads();
        float pre = 0.f, total = 0.f;
#pragma unroll
        for (int w2 = 0; w2 < 8; ++w2) { const float x = TOT[w2 * 64 + d]; total += x; pre += (w2 < w) ? x : 0.f; }
        float kte[8];
#pragma unroll
        for (int tt = 0; tt < 8; ++tt) { const int t = 8 * w + tt; const float bb = loc[tt] + pre;
            BC[(r0 + t) * 256 + h * 64 + d] = bb;
            kte[tt] = bf2f(Kl[t * 64 + d]) * __expf(total - bb); }
        { v4u o; o.x = pk2(kte[0], kte[1]); o.y = pk2(kte[2], kte[3]); o.z = pk2(kte[4], kte[5]); o.w = pk2(kte[6], kte[7]);
            *(LAS v4u*)(KT + offr(d, w)) = o; }
        if (w == 0) DEC[unit * 64 + d] = __expf(total);
        __syncthreads();
        { const int db = w >> 1, vb0 = 4 * (w & 1);
            f32x4 acc[4];
#pragma unroll
            for (int i = 0; i < 4; ++i) acc[i] = (f32x4){0.f, 0.f, 0.f, 0.f};
#pragma unroll
            for (int ks = 0; ks < 2; ++ks) { const s16x8 af = row_frag(KT, c.lane, db, ks);
#pragma unroll
                for (int i = 0; i < 4; ++i) { const s16x8 bf = tr_frag(VI, c.lane, vb0 + i, ks); acc[i] = __builtin_amdgcn_mfma_f32_16x16x32_bf16(af, bf, acc[i], 0, 0, 0); } }
            __syncthreads();
            LAS bf16_t* DT = (LAS bf16_t*)VI;
#pragma unroll
            for (int i = 0; i < 4; ++i)
#pragma unroll
                for (int r = 0; r < 4; ++r) DT[(16 * db + 4 * (c.lane >> 4) + r) * 128 + 16 * (vb0 + i) + (c.lane & 15)] = (bf16_t)f2bf(acc[i][r]); }
        __syncthreads();
        { const int row = c.tid >> 3, seg = c.tid & 7;
            const LAS v4u* src = (const LAS v4u*)(VI + row * 256 + seg * 32);
            v4u* dst = (v4u*)(DELTA + (size_t)unit * 8192 + row * 128 + seg * 16);
            dst[0] = src[0]; dst[1] = src[1]; }
        __syncthreads();
    }
#undef GLA_A_PREFETCH
}
__device__ __forceinline__ void gla_pass_b(const Args& a, const Ctx& c) {
    const unsigned* DELTA = (const unsigned*)(a.ws + WS_DELTA); const float* DEC = (const float*)(a.ws + WS_DEC); unsigned* SP = (unsigned*)(a.ws + WS_SPREV);
    for (int e = c.gtid; e < NB * GH * 4096; e += c.ngt) { const int bh = __builtin_amdgcn_readfirstlane(e >> 12), d = __builtin_amdgcn_readfirstlane((e >> 6) & 63), vp = e & 63;
        float s0 = 0.f, s1 = 0.f;
        unsigned dw[32]; float dc[32];
#pragma unroll
        for (int j = 0; j < 32; ++j) { const size_t unit = (size_t)bh * 32 + j; dw[j] = DELTA[unit * 4096 + d * 64 + vp]; dc[j] = DEC[unit * 64 + d]; }
#pragma unroll
        for (int j = 0; j < 32; ++j) { const size_t unit = (size_t)bh * 32 + j; SP[unit * 4096 + d * 64 + vp] = pk2(s0, s1); s0 = dc[j] * s0 + bf2f(dw[j] & 0xffffu); s1 = dc[j] * s1 + bf2f(dw[j] >> 16); }
    }
}
__device__ __forceinline__ void gla_pass_c(const Args& a, const Ctx& c) {
    const bf16_t* P = (const bf16_t*)(a.ws + WS_PROJ); const float* BC = (const float*)(a.ws + WS_BC); const bf16_t* SPV = (const bf16_t*)(a.ws + WS_SPREV);
    bf16_t* MI = (bf16_t*)(a.ws + WS_MIXIN);
    LAS unsigned char* VI = c.lds; LAS unsigned char* SI = c.lds + 16384; LAS unsigned char* QD = c.lds + 32768; LAS unsigned char* KI = c.lds + 40960; LAS unsigned char* PI = c.lds + 49152;
    LAS float* OI = (LAS float*)(c.lds + 57344);
    const int w = c.wave, lane = c.lane, g = lane >> 4, cl = lane & 15;
    v4u pv[2], psv[2], pq, pk; f32x4 pb0, pb1;
#define GLA_C_PREFETCH(u_) do { const int b_ = (u_) >> 7, h_ = ((u_) >> 5) & 3, ch_ = (u_) & 31; const size_t r_ = (size_t)b_ * NT + ch_ * 64; \
        _Pragma("unroll") for (int i = 0; i < 2; ++i) { const int idx = c.tid + 512 * i, row = idx >> 4, cc = idx & 15; \
            pv[i] = *(const v4u*)(P + (r_ + row) * NPROJ + PV + h_ * 128 + 8 * cc); psv[i] = *(const v4u*)(SPV + (size_t)(u_) * 8192 + row * 128 + 8 * cc); } \
        { const int t = c.tid >> 3, cc = c.tid & 7; pq = *(const v4u*)(P + (r_ + t) * NPROJ + PQ + h_ * 64 + 8 * cc); pk = *(const v4u*)(P + (r_ + t) * NPROJ + PK + h_ * 64 + 8 * cc); \
            pb0 = *(const f32x4*)(BC + (r_ + t) * 256 + h_ * 64 + 8 * cc); pb1 = *(const f32x4*)(BC + (r_ + t) * 256 + h_ * 64 + 8 * cc + 4); } } while (0)
    if (c.bid < NB * GH * 32) GLA_C_PREFETCH(c.bid);
    for (int unit = c.bid; unit < NB * GH * 32; unit += c.G) {
        const int b = unit >> 7, h = (unit >> 5) & 3, ch = unit & 31; const size_t r0 = (size_t)b * NT + ch * 64;
#pragma unroll
        for (int i = 0; i < 2; ++i) { const int idx = c.tid + 512 * i, row = idx >> 4, cc = idx & 15;
            *(LAS v4u*)(VI + offb(row, cc)) = pv[i];
            *(LAS v4u*)(SI + offb(row, cc)) = psv[i]; }
        { const int t = c.tid >> 3, cc = c.tid & 7;
            const v4u q8 = pq, k8 = pk; const f32x4 b0 = pb0, b1 = pb1;
            const float bb[8] = {b0.x, b0.y, b0.z, b0.w, b1.x, b1.y, b1.z, b1.w};
            const unsigned qw[4] = {q8.x, q8.y, q8.z, q8.w}, kw[4] = {k8.x, k8.y, k8.z, k8.w};
            unsigned qo[4], ko[4];
#pragma unroll
            for (int j = 0; j < 4; ++j) { const float e0 = __expf(bb[2 * j]), e1 = __expf(bb[2 * j + 1]);
                qo[j] = pk2(bf2f(qw[j] & 0xffffu) * 0.125f * e0, bf2f(qw[j] >> 16) * 0.125f * e1);
                ko[j] = pk2(bf2f(kw[j] & 0xffffu) * __builtin_amdgcn_rcpf(e0), bf2f(kw[j] >> 16) * __builtin_amdgcn_rcpf(e1)); }
            *(LAS v4u*)(QD + offr(t, cc)) = (v4u){qo[0], qo[1], qo[2], qo[3]};
            *(LAS v4u*)(KI + offr(t, cc)) = (v4u){ko[0], ko[1], ko[2], ko[3]}; }
        v4u og0, og1; { const bf16_t* ogp = P + (r0 + (c.tid >> 3)) * NPROJ + PG + h * 128 + 16 * (c.tid & 7); og0 = *(const v4u*)ogp; og1 = *(const v4u*)(ogp + 8); }
        __syncthreads();
        if (unit + c.G < NB * GH * 32) GLA_C_PREFETCH(unit + c.G);
        { const int ib = w >> 1;
#pragma unroll
            for (int jj = 0; jj < 2; ++jj) { const int jb = 2 * (w & 1) + jj; f32x4 sc = (f32x4){0.f, 0.f, 0.f, 0.f};
                if (jb <= ib) {
#pragma unroll
                    for (int ks = 0; ks < 2; ++ks) sc = __builtin_amdgcn_mfma_f32_16x16x32_bf16(row_frag(QD, lane, ib, ks), row_frag(KI, lane, jb, ks), sc, 0, 0, 0); }
#pragma unroll
                for (int r = 0; r < 4; ++r) { const int i = 16 * ib + 4 * g + r, j = 16 * jb + cl; const float v = (j <= i) ? sc[r] : 0.f;
                    *(LAS bf16_t*)(PI + offr(i, j >> 3) + 2 * (j & 7)) = (bf16_t)f2bf(v); } } }
        __syncthreads();
        { const int ib = w >> 1, vb0 = 4 * (w & 1);
            f32x4 acc[4];
#pragma unroll
            for (int i = 0; i < 4; ++i) acc[i] = (f32x4){0.f, 0.f, 0.f, 0.f};
#pragma unroll
            for (int ks = 0; ks < 2; ++ks) { const s16x8 ap = row_frag(PI, lane, ib, ks), aq = row_frag(QD, lane, ib, ks);
#pragma unroll
                for (int i = 0; i < 4; ++i) { acc[i] = __builtin_amdgcn_mfma_f32_16x16x32_bf16(ap, tr_frag(VI, lane, vb0 + i, ks), acc[i], 0, 0, 0);
                    acc[i] = __builtin_amdgcn_mfma_f32_16x16x32_bf16(aq, tr_frag(SI, lane, vb0 + i, ks), acc[i], 0, 0, 0); } }
#pragma unroll
            for (int i = 0; i < 4; ++i)
#pragma unroll
                for (int r = 0; r < 4; ++r) OI[(16 * ib + 4 * g + r) * 132 + 16 * (vb0 + i) + cl] = acc[i][r]; }
        __syncthreads();
        { const int t = c.tid >> 3, part = c.tid & 7; float o[16]; float ss = 0.f;
#pragma unroll
            for (int q = 0; q < 4; ++q) { const f32x4 x = *(const LAS f32x4*)(OI + t * 132 + 16 * part + 4 * q); o[4 * q] = x.x; o[4 * q + 1] = x.y; o[4 * q + 2] = x.z; o[4 * q + 3] = x.w;
                ss += (x.x * x.x + x.y * x.y) + (x.z * x.z + x.w * x.w); }
            ss += __shfl_xor(ss, 1); ss += __shfl_xor(ss, 2); ss += __shfl_xor(ss, 4);
            const float rstd = rsqrtf(ss * (1.f / 128.f) + EPS);
            const v4u g0 = og0, g1 = og1;
            const unsigned gw[8] = {g0.x, g0.y, g0.z, g0.w, g1.x, g1.y, g1.z, g1.w};
            unsigned ow[8];
#pragma unroll
            for (int j = 0; j < 8; ++j) { const float ga = bf2f(gw[j] & 0xffffu), gb = bf2f(gw[j] >> 16);
                const float n0 = a.in[I_GLANORM][16 * part + 2 * j], n1 = a.in[I_GLANORM][16 * part + 2 * j + 1];
                ow[j] = pk2(o[2 * j] * rstd * n0 * (ga * sigmoidf_(ga)), o[2 * j + 1] * rstd * n1 * (gb * sigmoidf_(gb))); }
            bf16_t* dst = MI + (r0 + t) * D + h * 128 + 16 * part;
            *(v4u*)dst = (v4u){ow[0], ow[1], ow[2], ow[3]}; *(v4u*)(dst + 8) = (v4u){ow[4], ow[5], ow[6], ow[7]}; }
    }
    __syncthreads();
#undef GLA_C_PREFETCH
}

constexpr int RT_PITCH = 2064, RT_LO = 16 * RT_PITCH, RT_PART = 2 * RT_LO;
__device__ __forceinline__ void ph8_norm2_router(const Args& a, const Ctx& c) {
    const float* mod = (const float*)(a.ws + WS_MOD);
    const bf16_t* MX = (const bf16_t*)(a.ws + WS_MIX);
    bf16_t* HN = (bf16_t*)(a.ws + WS_HN); bf16_t* H1B = (bf16_t*)(a.ws + WS_H1);
    unsigned* cnt = (unsigned*)(a.ws + WS_CTL) + CW_CNT;
    int* RE = (int*)(a.ws + WS_ROUTE_E); float* RW = (float*)(a.ws + WS_ROUTE_W); int* LIST = (int*)(a.ws + WS_LIST);
    s16x8 rwh[4][2], rwl[4][2];
#pragma unroll
    for (int ks = 0; ks < 4; ++ks)
#pragma unroll
        for (int cb = 0; cb < 2; ++cb) { float wv[8];
#pragma unroll
            for (int j = 0; j < 8; ++j) wv[j] = a.in[I_RW][(size_t)(128 * c.wave + 32 * ks + 8 * (c.lane >> 4) + j) * 32 + 16 * cb + (c.lane & 15)];
            unsigned hh[4], ll[4];
#pragma unroll
            for (int j = 0; j < 4; ++j) { hh[j] = pk2(wv[2 * j], wv[2 * j + 1]); ll[j] = pk2(wv[2 * j] - bf2f(hh[j] & 0xffffu), wv[2 * j + 1] - bf2f(hh[j] >> 16)); }
            rwh[ks][cb] = __builtin_bit_cast(s16x8, (v4u){hh[0], hh[1], hh[2], hh[3]}); rwl[ks][cb] = __builtin_bit_cast(s16x8, (v4u){ll[0], ll[1], ll[2], ll[3]}); }
    LAS unsigned* lcnt = (LAS unsigned*)(c.lds + 131072);
    LAS unsigned* lent = (LAS unsigned*)(c.lds + 131072 + 512);
    if (c.tid < 128) lcnt[c.tid] = 0u;
    __syncthreads();
#pragma unroll 1
    for (int it = 0; it < 4; ++it) { const int row0 = 2 * c.gw + 2 * c.ngw * it;
        const int b = row0 / NT;
        f32x4 y[2][4];
        v2u mwb[1][2][4]; f32x4 xvb[1][2][4]; constexpr int cbuf = 0;
#pragma unroll
        for (int r = 0; r < 2; ++r)
#pragma unroll
            for (int j = 0; j < 4; ++j) { const int col = 4 * c.lane + 256 * j; mwb[0][r][j] = __builtin_nontemporal_load((const v2u*)(MX + (size_t)(row0 + r) * D + col));
                xvb[0][r][j] = __builtin_nontemporal_load((const f32x4*)(a.in[I_X] + (size_t)(row0 + r) * D + col)); }
        f32x4 gmv[4], g1v[4], gfv[4], shv[4], scv[4];
#pragma unroll
        for (int j = 0; j < 4; ++j) { const int col = 4 * c.lane + 256 * j; gmv[j] = *(const f32x4*)(a.in[I_MIXPOST] + col); g1v[j] = *(const f32x4*)(mod + b * 6144 + 2048 + col);
            gfv[j] = *(const f32x4*)(a.in[I_FFNPRE] + col); shv[j] = *(const f32x4*)(mod + b * 6144 + 3072 + col); scv[j] = *(const f32x4*)(mod + b * 6144 + 4096 + col) + 1.f; }
#pragma unroll
        for (int r = 0; r < 2; ++r) { const int row = row0 + r;
            f32x4 m[4]; float ss = 0.f;
#pragma unroll
            for (int j = 0; j < 4; ++j) { const v2u w = mwb[cbuf][r][j];
                m[j] = (f32x4){bf2f(w.x & 0xffffu), bf2f(w.x >> 16), bf2f(w.y & 0xffffu), bf2f(w.y >> 16)};
                ss += (m[j].x * m[j].x + m[j].y * m[j].y) + (m[j].z * m[j].z + m[j].w * m[j].w); }
            const float rstd = rsqrtf(wave_sum(ss) * (1.f / D) + EPS);
            float s2 = 0.f;
#pragma unroll
            for (int j = 0; j < 4; ++j) { const int col = 4 * c.lane + 256 * j;
                m[j] = xvb[cbuf][r][j] + g1v[j] * (m[j] * rstd * gmv[j]);
                { v2u o; o.x = pk2(m[j].x, m[j].y); o.y = pk2(m[j].z, m[j].w); *(v2u*)(H1B + (size_t)row * D + col) = o; }
                s2 += (m[j].x * m[j].x + m[j].y * m[j].y) + (m[j].z * m[j].z + m[j].w * m[j].w); }
            const float rstd2 = rsqrtf(wave_sum(s2) * (1.f / D) + EPS);
#pragma unroll
            for (int j = 0; j < 4; ++j) { const int col = 4 * c.lane + 256 * j;
                y[r][j] = m[j] * rstd2 * gfv[j] * scv[j] + shv[j];
                *(unsigned*)((unsigned char*)HN + (size_t)row * D + col) = pk4_fp8(y[r][j].x, y[r][j].y, y[r][j].z, y[r][j].w); } }
#pragma unroll
        for (int r = 0; r < 2; ++r)
#pragma unroll
            for (int j = 0; j < 4; ++j) { const f32x4 v = y[r][j];
                const unsigned h0 = pk2(v.x, v.y), h1 = pk2(v.z, v.w);
                const unsigned l0 = pk2(v.x - bf2f(h0 & 0xffffu), v.y - bf2f(h0 >> 16)), l1 = pk2(v.z - bf2f(h1 & 0xffffu), v.w - bf2f(h1 >> 16));
                const int off = (2 * c.wave + r) * RT_PITCH + (4 * c.lane + 256 * j) * 2;
                *(LAS v2u*)(c.lds + off) = (v2u){h0, h1}; *(LAS v2u*)(c.lds + RT_LO + off) = (v2u){l0, l1}; }
        __syncthreads();
        { f32x4 pacc[2] = {(f32x4){0.f, 0.f, 0.f, 0.f}, (f32x4){0.f, 0.f, 0.f, 0.f}};
#pragma unroll
            for (int ks = 0; ks < 4; ++ks) { const int aoff = (c.lane & 15) * RT_PITCH + (128 * c.wave + 32 * ks + 8 * (c.lane >> 4)) * 2;
                const s16x8 ahi = *(const LAS s16x8*)(c.lds + aoff), alo = *(const LAS s16x8*)(c.lds + RT_LO + aoff);
#pragma unroll
                for (int cb = 0; cb < 2; ++cb) { pacc[cb] = __builtin_amdgcn_mfma_f32_16x16x32_bf16(ahi, rwh[ks][cb], pacc[cb], 0, 0, 0);
                    pacc[cb] = __builtin_amdgcn_mfma_f32_16x16x32_bf16(ahi, rwl[ks][cb], pacc[cb], 0, 0, 0);
                    pacc[cb] = __builtin_amdgcn_mfma_f32_16x16x32_bf16(alo, rwh[ks][cb], pacc[cb], 0, 0, 0); } }
            LAS float* part = (LAS float*)(c.lds + RT_PART) + c.wave * 512;
#pragma unroll
            for (int cb = 0; cb < 2; ++cb)
#pragma unroll
                for (int r = 0; r < 4; ++r) part[(4 * (c.lane >> 4) + r) * 32 + 16 * cb + (c.lane & 15)] = pacc[cb][r]; }
        __syncthreads();
        const int e = c.lane & 31, row = row0 + (c.lane >> 5), l4 = c.lane & 31;
        float val = a.in[I_RB][e];
#pragma unroll
        for (int w2 = 0; w2 < 8; ++w2) val += ((const LAS float*)(c.lds + RT_PART))[w2 * 512 + (c.tid >> 5) * 32 + e];
        int sel_e[4]; float sel_v[4];
#pragma unroll
        for (int k = 0; k < 4; ++k) { float mx = val;
#pragma unroll
            for (int o = 1; o < 32; o <<= 1) mx = fmaxf(mx, __shfl_xor(mx, o));
            const unsigned long long bal = __ballot(val == mx);
            const unsigned half = (unsigned)(c.lane >> 5 ? (bal >> 32) : (bal & 0xffffffffull));
            const int idx = __ffs((int)half) - 1;
            sel_e[k] = idx; sel_v[k] = mx; if (e == idx) val = -3.0e38f; }
        const float e0 = 1.f, e1 = __expf(sel_v[1] - sel_v[0]), e2 = __expf(sel_v[2] - sel_v[0]), e3 = __expf(sel_v[3] - sel_v[0]);
        const float inv = 1.f / (e0 + e1 + e2 + e3);
        if (l4 < 4) { const int ee = l4 == 0 ? sel_e[0] : l4 == 1 ? sel_e[1] : l4 == 2 ? sel_e[2] : sel_e[3];
            const float wv = (l4 == 0 ? e0 : l4 == 1 ? e1 : l4 == 2 ? e2 : e3) * inv;
            const unsigned ls = __hip_atomic_fetch_add((LAS unsigned*)lcnt + ee, 1u, __ATOMIC_RELAXED, __HIP_MEMORY_SCOPE_WORKGROUP);
            const unsigned en = __hip_atomic_fetch_add((LAS unsigned*)lcnt + 32, 1u, __ATOMIC_RELAXED, __HIP_MEMORY_SCOPE_WORKGROUP);
            lent[en & 511u] = (unsigned)row * 4u + (unsigned)l4; lent[512 + (en & 511u)] = (unsigned)ee | (ls << 8); RW[row * 4 + l4] = wv; }
    }
    __syncthreads();
    if (c.tid < 32) lcnt[64 + c.tid] = atomicAdd(cnt + c.tid * 64, lcnt[c.tid]);
    __syncthreads();
    { const unsigned nent = lcnt[32];
        for (unsigned t = c.tid; t < nent; t += NTHR) { const unsigned rk = lent[t], es = lent[512 + t], ee = es & 255u, slot = lcnt[64 + ee] + (es >> 8);
            RE[rk] = (int)(ee | (slot << 8)); LIST[ee * LISTCAP + slot] = (int)(rk >> 2); } }
    __syncthreads();
}

__device__ __forceinline__ void build_pstart(const Args& a, const Ctx& c, LAS int* ps, LAS int* cn) {
    if (c.tid < 64) {
        const unsigned* cnt = (const unsigned*)(a.ws + WS_CTL) + CW_CNT;
        const int n = c.tid < NE ? (int)__hip_atomic_load(cnt + c.tid * 64, __ATOMIC_RELAXED, __HIP_MEMORY_SCOPE_AGENT) : 0;
        const int pad = ((n + 255) >> 8) << 8; int inc = pad;
#pragma unroll
        for (int o = 1; o < 32; o <<= 1) { const int t = __shfl_up(inc, o); if (c.tid >= o) inc += t; }
        if (c.tid < NE) { ps[c.tid] = inc - pad; cn[c.tid] = n; }
        if (c.tid == NE - 1) ps[NE] = inc; }
    __syncthreads();
}
template <bool GATHER> __device__ __forceinline__ void exp_tables(const Args& a, const Ctx& c, pg8::ExpSched& S) {
    LAS int* ps = (LAS int*)(c.lds + pg8::XT_PS); LAS int* cn = ps + 33; LAS unsigned char* te = (LAS unsigned char*)(c.lds + pg8::XT_PS + 260);
    build_pstart(a, c, ps, cn);
    const int nT = ps[NE] >> 8;
    for (int t = c.tid; t < nT; t += NTHR) { int e = 0; for (int q = 1; q < NE; ++q) e = (t * 256 >= ps[q]) ? q : e; te[t] = (unsigned char)e; }
    __syncthreads();
    S.nT = nT; S.lds = c.lds; S.G = c.G; S.c = c.bid;
    { const int* LIST = (const int*)(a.ws + WS_LIST); LAS unsigned short* tk = (LAS unsigned short*)(c.lds + pg8::XT_TOK); LAS float* bt = (LAS float*)(c.lds + pg8::XT_BIAS);
        constexpr int MAXU = 10;
        int tokv[MAXU]; float biasv[MAXU];
        if (c.tid < 256) {
#pragma unroll
            for (int i = 0; i < MAXU; ++i) { pg8::Unit u; const bool ok = S.next(i, u); tokv[i] = 0; biasv[i] = 0.f;
                if (ok) { if (GATHER) { const int slot = u.pm * 256 - ps[u.e] + c.tid; if (slot < cn[u.e]) tokv[i] = LIST[u.e * LISTCAP + slot];
                        biasv[i] = a.in[I_BGU][u.e * 2048 + (c.tid >> 7) * 1024 + u.pn * 128 + (c.tid & 127)]; }
                    else biasv[i] = a.in[I_BDN][u.e * 1024 + u.pn * 256 + c.tid]; } }
#pragma unroll
            for (int i = 0; i < MAXU; ++i) { if (GATHER) tk[i * 256 + c.tid] = (unsigned short)tokv[i]; bt[i * 256 + c.tid] = biasv[i]; } }
        __syncthreads(); }
}
__device__ __forceinline__ void ph10_exp1(const Args& a, const Ctx& c) {
    pg8::ExpSched S; S.A = (const char*)(a.ws + WS_HN); S.W = (const char*)(a.ws + WS_GU_T); S.nN = 8; S.ldaB = D; S.ldbB = D; S.estride = 2048u * 1024u;
    exp_tables<true>(a, c, S);
    pg8::EpiSwiglu E{(unsigned char*)(a.ws + WS_HACT), (const LAS float*)(c.lds + pg8::XT_BIAS)};
    pg8::gemm_phase<pg8::EpiSwiglu, pg8::ExpSched, true, true>(c.lds, D / 128, S, E);
}
__device__ __forceinline__ void ph11_exp2(const Args& a, const Ctx& c) {
    pg8::ExpSched S; S.A = (const char*)(a.ws + WS_HACT); S.W = (const char*)(a.ws + WS_DN_T); S.nN = 4; S.ldaB = DFF; S.ldbB = DFF; S.estride = 1024u * 1024u;
    exp_tables<false>(a, c, S);
    pg8::EpiDown E{(unsigned char*)(a.ws + WS_YEXP), (const LAS float*)(c.lds + pg8::XT_BIAS)};
    pg8::gemm_phase<pg8::EpiDown, pg8::ExpSched, false, true>(c.lds, DFF / 128, S, E);
}

__device__ __forceinline__ f32x4 fp8x4_to_f32(unsigned w) { const f32x2_t lo = __builtin_amdgcn_cvt_pk_f32_fp8((int)w, false), hi = __builtin_amdgcn_cvt_pk_f32_fp8((int)w, true); return (f32x4){lo.x, lo.y, hi.x, hi.y}; }
__device__ __forceinline__ void ph12_final(const Args& a, const Ctx& c) {
    LAS int* ps = (LAS int*)c.lds; LAS int* cn = ps + 64;
    build_pstart(a, c, ps, cn);
    const float* mod = (const float*)(a.ws + WS_MOD);
    const unsigned char* YE = (const unsigned char*)(a.ws + WS_YEXP); const bf16_t* H1B = (const bf16_t*)(a.ws + WS_H1);
    const int* RE = (const int*)(a.ws + WS_ROUTE_E); const float* RW = (const float*)(a.ws + WS_ROUTE_W);
    int4 reA[4][2]; f32x4 rwA[4][2];
#pragma unroll
    for (int it = 0; it < 4; ++it)
#pragma unroll
        for (int r = 0; r < 2; ++r) { const int row = 2 * c.gw + 2 * c.ngw * it + r; const int rc = row < NTOK ? row : 0;
            reA[it][r] = *(const int4*)(RE + rc * 4); rwA[it][r] = *(const f32x4*)(RW + rc * 4); }
#pragma unroll
    for (int it = 0; it < 4; ++it) { const int row0 = 2 * c.gw + 2 * c.ngw * it; if (row0 >= NTOK) break;
        const int b = row0 / NT;
        int4 re[2]; f32x4 rw[2];
#pragma unroll
        for (int r = 0; r < 2; ++r) { re[r] = reA[it][r]; rw[r] = rwA[it][r]; }
        v2u hw[2][4];
#pragma unroll
        for (int r = 0; r < 2; ++r)
#pragma unroll
            for (int j = 0; j < 4; ++j) hw[r][j] = __builtin_nontemporal_load((const v2u*)(H1B + (size_t)(row0 + r) * D + 4 * c.lane + 256 * j));
        f32x4 f[2][4];
#pragma unroll
        for (int r = 0; r < 2; ++r) { const int rr[4] = {re[r].x, re[r].y, re[r].z, re[r].w}; const float ww[4] = {rw[r].x, rw[r].y, rw[r].z, rw[r].w};
            unsigned yw[4][4];
#pragma unroll
            for (int k = 0; k < 4; ++k) { const size_t pos = (size_t)(ps[rr[k] & 255] + (rr[k] >> 8));
#pragma unroll
                for (int j = 0; j < 4; ++j) yw[k][j] = __builtin_nontemporal_load((const unsigned*)(YE + pos * D + 4 * c.lane + 256 * j)); }
#pragma unroll
            for (int j = 0; j < 4; ++j) { f[r][j] = fp8x4_to_f32(yw[0][j]) * ww[0];
#pragma unroll
                for (int k = 1; k < 4; ++k) f[r][j] += fp8x4_to_f32(yw[k][j]) * ww[k]; } }
        f32x4 gfv[4], g2v[4];
#pragma unroll
        for (int j = 0; j < 4; ++j) { const int col = 4 * c.lane + 256 * j; gfv[j] = *(const f32x4*)(a.in[I_FFNPOST] + col); g2v[j] = *(const f32x4*)(mod + b * 6144 + 5120 + col); }
#pragma unroll
        for (int r = 0; r < 2; ++r) { float sf = 0.f;
#pragma unroll
            for (int j = 0; j < 4; ++j) sf += (f[r][j].x * f[r][j].x + f[r][j].y * f[r][j].y) + (f[r][j].z * f[r][j].z + f[r][j].w * f[r][j].w);
            const float rf = rsqrtf(wave_sum(sf) * (1.f / (D * Y8_SCALE * Y8_SCALE)) + EPS) * (1.f / Y8_SCALE);
#pragma unroll
            for (int j = 0; j < 4; ++j) { const int col = 4 * c.lane + 256 * j;
                const f32x4 gf = gfv[j], g2 = g2v[j];
                const f32x4 h = (f32x4){bf2f(hw[r][j].x & 0xffffu), bf2f(hw[r][j].x >> 16), bf2f(hw[r][j].y & 0xffffu), bf2f(hw[r][j].y >> 16)};
                __builtin_nontemporal_store(h + g2 * (f[r][j] * rf * gf), (f32x4*)(a.out + (size_t)(row0 + r) * D + col)); } }
    }
}

constexpr int NPHASE = 13;
__global__ void __launch_bounds__(NTHR, 2) mk_fwd(Args a) {
    extern __shared__ __attribute__((aligned(16))) unsigned char lds_raw[];
    Ctx c;
    c.lds = (LAS unsigned char*)lds_raw;
    c.tid = threadIdx.x; c.lane = c.tid & 63; c.wave = __builtin_amdgcn_readfirstlane(c.tid >> 6);
    c.bid = blockIdx.x; c.G = gridDim.x; c.gw = c.bid * NWAVES + c.wave; c.ngw = c.G * NWAVES; c.gtid = c.bid * NTHR + c.tid; c.ngt = c.G * NTHR;
    volatile LAS unsigned* MISC = (volatile LAS unsigned*)(c.lds + MISC_OFF);
    if (c.tid < 32) MISC[c.tid] = 0u;
    __syncthreads();
    const bool one = (a.ph_hi - a.ph_lo) > 1;
    XcdBarrier bar; bar.bar = (unsigned*)(a.ws + WS_CTL) + CW_BAR; bar.x = 0; bar.st = MISC + 8;
    if (one) bar = xcd_barrier_post((unsigned*)(a.ws + WS_CTL) + CW_BAR, MISC + 8);
    const int lo = a.ph_lo, hi = a.ph_hi;
#define IN(k) (lo <= (k) && (k) < hi)
#define SEAM(k) do { if (IN(k) && IN((k) + 1)) { if ((k) <= 8) xcd_barrier_conv(bar, a, c, (k)); else xcd_barrier(bar); } else __syncthreads(); } while (0)
    if (IN(0)) { ph0_prologue(a, c); SEAM(0); }
    if (IN(1)) { ph1_norm1(a, c); s5_build_mats(a, c); SEAM(1); }
    if (IN(2)) { ph2_gemm1(a, c); SEAM(2); }
    if (IN(3)) { gla_pass_a(a, c); s5_dx_gemm(a, c);
        if (c.bid < 128) { for (int wi = WI_P3 + c.bid * 8 + c.wave; wi < WI_P5; wi += 1024) wconv_item(a, c.lds + c.wave * 5120, wi, c.lane); __syncthreads(); }
        SEAM(3); }
    if (IN(4)) { gla_pass_b(a, c); s5_scan(a, c); SEAM(4); }
    if (IN(5)) { gla_pass_c(a, c); s5_y_gemm(a, c);
        if (c.bid < 128) { for (int wi = WI_P5 + c.bid * 8 + c.wave; wi < WI_P6; wi += 1024) wconv_item(a, c.lds + c.wave * 5120, wi, c.lane); __syncthreads(); }
        SEAM(5); }
    if (IN(6)) { ph6_glu(a, c);
        if (c.bid >= 128) { for (int wi = WI_P6 + (c.bid - 128) * 8 + c.wave; wi < WI_END; wi += 1024) wconv_item(a, c.lds + c.wave * 5120, wi, c.lane); __syncthreads(); }
        SEAM(6); }
    if (IN(7)) { ph7_wout(a, c); SEAM(7); }
    if (IN(8)) { ph8_norm2_router(a, c); if (IN(10)) xcd_barrier_conv(bar, a, c, 8); else __syncthreads(); }
    if (IN(10)) { ph10_exp1(a, c); SEAM(10); }
    if (IN(11)) { ph11_exp2(a, c); SEAM(11); }
    if (IN(12)) { ph12_final(a, c); }
#undef IN
#undef SEAM
}

extern "C" void kernel_launch(void* const* d_in, const int* in_sizes, int n_in, void* d_out, int out_size, void* d_ws, size_t ws_size, hipStream_t stream) {
    static int grid = 0;
    if (grid == 0) {
        if (n_in != 29 || in_sizes[0] != NTOK * D || out_size != NTOK * D || ws_size < WS_END) {
            fprintf(stderr, "kernel_launch: unexpected shapes (n_in %d, in0 %d, out %d, ws %zu < %zu)\n", n_in, n_in > 0 ? in_sizes[0] : -1, out_size, ws_size, (size_t)WS_END); grid = -1; return; }
        int dev = 0, cus = 0, per_cu = 0;
        if (hipGetDevice(&dev) != hipSuccess || hipDeviceGetAttribute(&cus, hipDeviceAttributeMultiprocessorCount, dev) != hipSuccess) { grid = -1; return; }
        if (hipFuncSetAttribute((const void*)mk_fwd, hipFuncAttributeMaxDynamicSharedMemorySize, LDS_BYTES) != hipSuccess) { fprintf(stderr, "kernel_launch: hipFuncSetAttribute failed\n"); grid = -1; return; }
        if (hipOccupancyMaxActiveBlocksPerMultiprocessor(&per_cu, (const void*)mk_fwd, NTHR, LDS_BYTES) != hipSuccess || per_cu < 1)
            fprintf(stderr, "kernel_launch: occupancy query reports %d\n", per_cu);
        (void)hipGetLastError();
        grid = 256;
        if (cus != 256) fprintf(stderr, "kernel_launch: built for a 256-CU device, found %d CUs\n", cus);
    }
    if (grid < 0) return;
    (void)hipMemsetAsync((char*)d_ws + WS_CTL, 0, CTL_BYTES, stream);
    Args a{};
    for (int i = 0; i < 29; ++i) a.in[i] = (const float*)d_in[i];
    a.out = (float*)d_out; a.ws = (unsigned char*)d_ws;
    a.ph_lo = 0; a.ph_hi = NPHASE;
    hipLaunchKernelGGL(mk_fwd, dim3(grid), dim3(NTHR), LDS_BYTES, stream, a);
}
```

```cpp
#include <hip/hip_runtime.h>
#include <cstdio>
#include <cstdint>

#define LAS __attribute__((address_space(3)))
typedef unsigned short bf16_t;
typedef unsigned v4u __attribute__((ext_vector_type(4)));
typedef unsigned v2u __attribute__((ext_vector_type(2)));
typedef float f32x4 __attribute__((ext_vector_type(4)));
typedef __bf16 bf16x2 __attribute__((ext_vector_type(2)));
typedef short s16x4 __attribute__((ext_vector_type(4)));
typedef short s16x8 __attribute__((ext_vector_type(8)));

constexpr int NB = 8, NT = 2048, D = 1024, NTOK = NB * NT;
constexpr int NIN = 2064, NPROJ = 2048;
constexpr int GH = 4, DK = 64, DV = 128;
constexpr int SG = 32, SP = 64, SC = 16;
constexpr int NE = 32, DFF = 1024;
constexpr int LISTCAP = 16384, MAXROWS = 65536 + NE * 256;
constexpr float EPS = 1e-6f;
constexpr int PQ = 0, PK = 256, PV = 512, PG = 1024, PU = 1536;

constexpr size_t MiB = 1u << 20;
constexpr size_t WS_CTL = 0, CTL_BYTES = 64 * 1024;
constexpr size_t WS_MOD = 1 * MiB;
constexpr size_t WS_S5AB = 2 * MiB, WS_S5BB = 2 * MiB + 65536;
constexpr size_t WS_WIN_T = 3 * MiB, WS_GLU_T = 7 * MiB, WS_WOUT_T = 8 * MiB, WS_ALR = 10 * MiB;
constexpr size_t WS_ROUTE_E = 11 * MiB, WS_ROUTE_W = 11 * MiB + 512 * 1024, WS_LIST = 12 * MiB;
constexpr size_t WS_HN = 16 * MiB, WS_PROJ = 48 * MiB, WS_MIXIN = 112 * MiB, WS_Y5 = 144 * MiB, WS_MIX = 160 * MiB, WS_H1 = 192 * MiB;
constexpr size_t WS_DELTA = 256 * MiB, WS_SPREV = 288 * MiB;
constexpr size_t WS_GU_T = 320 * MiB, WS_DN_T = 448 * MiB, WS_HACT = 512 * MiB, WS_YEXP = 656 * MiB;
constexpr size_t WS_SE = 800 * MiB, WS_SMF = 804 * MiB, WS_UX = 810 * MiB, WS_DX = 834 * MiB, WS_BC = 850 * MiB, WS_DEC = 866 * MiB, WS_END = 868 * MiB;
constexpr size_t WS_APOW = 14 * MiB, WS_A256 = 14 * MiB + 512 * 1024;
constexpr int CW_CNT = 8192;
constexpr int CW_BAR = 4096;

constexpr int NWAVES = 8, NTHR = 512;
constexpr int LDS_BYTES = 163840;
constexpr int MISC_OFF = 131072 + 8192;

__device__ __forceinline__ float bf2f(unsigned v) { return __uint_as_float(v << 16); }
__device__ __forceinline__ unsigned f2bf(float f) { unsigned u = __float_as_uint(f); return (u + 0x7fffu + ((u >> 16) & 1u)) >> 16; }
typedef float f32x2_t __attribute__((ext_vector_type(2)));
__device__ __forceinline__ unsigned pk2(float lo, float hi) { const f32x2_t v = {lo, hi}; return __builtin_bit_cast(unsigned, __builtin_convertvector(v, bf16x2)); }
__device__ __forceinline__ float wave_sum(float v) {
#pragma unroll
    for (int o = 1; o < 64; o <<= 1) v += __shfl_xor(v, o);
    return v;
}
__device__ __forceinline__ float sigmoidf_(float x) { return __builtin_amdgcn_rcpf(1.f + __builtin_amdgcn_exp2f(-1.4426950408889634f * x)); }
__device__ __forceinline__ float logsigmoidf_(float z) { return fminf(z, 0.f) - 0.6931471805599453f * __builtin_amdgcn_logf(1.f + __builtin_amdgcn_exp2f(-1.4426950408889634f * fabsf(z))); }
__device__ __forceinline__ float gelu_tanh(float y) { return y * sigmoidf_(1.5957691216057308f * (y + 0.044715f * y * y * y)); }

__device__ __forceinline__ float sat8(float x) { return __builtin_amdgcn_fmed3f(x, -448.f, 448.f); }
__device__ __forceinline__ unsigned pk4_fp8(float a, float b, float c, float d) { int p = __builtin_amdgcn_cvt_pk_fp8_f32(sat8(a), sat8(b), 0, false); p = __builtin_amdgcn_cvt_pk_fp8_f32(sat8(c), sat8(d), p, true); return (unsigned)p; }
constexpr float W8_SCALE = 64.f, ACT8_SCALE = 4.f, Y8_SCALE = 8.f;
constexpr int SC_ONE = 0x7f7f7f7f, SC_W8 = 0x79797979, SC_ACT8 = 0x7d7d7d7d;

#define XB_TMO      128
#define XB_XCNT(j)  (256  + 64 * (j))
#define XB_XSUB(j)  (1280 + 64 * (j))
#define XB_XGEN(j)  (2304 + 64 * (j))
#define XB_TOP      3328
#define XB_TOPGEN   3392
#define XCD_BAR_WORDS 3456
#define XB_SPIN_CAP (1u << 18)

__device__ __forceinline__ unsigned xb_ld(unsigned* p)              { return __hip_atomic_load(p, __ATOMIC_RELAXED, __HIP_MEMORY_SCOPE_AGENT); }
__device__ __forceinline__ unsigned xb_add(unsigned* p, unsigned v) { return __hip_atomic_fetch_add(p, v, __ATOMIC_RELAXED, __HIP_MEMORY_SCOPE_AGENT); }
__device__ __forceinline__ unsigned xb_xcc_id() { return (unsigned)__builtin_amdgcn_s_getreg((3 << 11) | 20) & 0xFu; }
#define XB_SPIN(cond, bar) do { unsigned _sp = 0; while (cond) { __builtin_amdgcn_s_sleep(1); \
    if ((++_sp & 255u) == 0u) { if (xb_ld(&(bar)[XB_TMO])) break; if (_sp > XB_SPIN_CAP) { atomicAdd(&(bar)[XB_TMO], 1u); break; } } } } while (0)

struct XcdBarrier {
    unsigned* bar; unsigned x;
    volatile LAS unsigned* st;
};
__device__ __forceinline__ XcdBarrier xcd_barrier_post(unsigned* bar, volatile LAS unsigned* st) {
    XcdBarrier b; b.bar = bar; b.x = xb_xcc_id(); b.st = st;
    if (threadIdx.x == 0) (void)xb_add(&bar[XB_XCNT(b.x)], 1u);
    return b;
}
__device__ __forceinline__ void xcd_barrier_complete(unsigned* bar, unsigned x, unsigned& nloc, unsigned& nx) {
    const unsigned G = gridDim.x * gridDim.y * gridDim.z;
    unsigned sum, cnt, mine, sp = 0u;
    for (;;) {
        sum = 0u; cnt = 0u; mine = 0u;
#pragma unroll
        for (unsigned j = 0; j < 16; ++j) { const unsigned c = xb_ld(&bar[XB_XCNT(j)]); sum += c; cnt += (c > 0u) ? 1u : 0u; mine = (j == x) ? c : mine; }
        if (sum == G) break;
        __builtin_amdgcn_s_sleep(1);
        if ((++sp & 255u) == 0u) { if (xb_ld(&bar[XB_TMO])) break; if (sp > XB_SPIN_CAP) { atomicAdd(&bar[XB_TMO], 1u); break; } }
    }
    nloc = mine > 0u ? mine : 1u; nx = cnt > 0u ? cnt : 1u;
}
__device__ __forceinline__ void xcd_barrier(const XcdBarrier& b) {
    asm volatile("s_waitcnt vmcnt(0)" ::: "memory");
    __syncthreads();
    if (threadIdx.x == 0) {
        unsigned* bar = b.bar;
        __builtin_amdgcn_s_waitcnt(0);
        unsigned nloc = b.st[0], nx = b.st[1];
        if (nloc == 0u) { xcd_barrier_complete(bar, b.x, nloc, nx); b.st[0] = nloc; b.st[1] = nx; }
        const unsigned old = xb_add(&bar[XB_XSUB(b.x)], 1u);
        const unsigned gen = old / nloc;
        if (old + 1u == (gen + 1u) * nloc) {
            __builtin_amdgcn_fence(__ATOMIC_RELEASE, "agent");
            asm volatile("s_waitcnt vmcnt(0)" ::: "memory");
            const unsigned og = xb_add(&bar[XB_TOP], 1u);
            const unsigned tg = og / nx;
            if (og + 1u == (tg + 1u) * nx) xb_add(&bar[XB_TOPGEN], 1u);
            else XB_SPIN(xb_ld(&bar[XB_TOPGEN]) == tg, bar);
            __builtin_amdgcn_fence(__ATOMIC_ACQUIRE, "agent");
            xb_add(&bar[XB_XGEN(b.x)], 1u);
            asm volatile("s_waitcnt vmcnt(0)" ::: "memory");
        } else {
            __builtin_amdgcn_fence(__ATOMIC_ACQUIRE, "agent");
            XB_SPIN(xb_ld(&bar[XB_XGEN(b.x)]) == gen, bar);
            asm volatile("s_waitcnt vmcnt(0)" ::: "memory");
        }
    }
    __syncthreads();
}


namespace pg8 {
typedef short bf16x8 __attribute__((ext_vector_type(8)));
typedef unsigned u32x4 __attribute__((ext_vector_type(4)));
constexpr int BM = 256, BK = 64, HALF = 128, HTB = HALF * BK * 2, STAGE_BYTES = 8 * HTB, NXCD = 8, WGM = 4;
__device__ __forceinline__ int lds_byte(int r, int c) { const int st = (r >> 4) * 2 + (c >> 5), rr = r & 15, cc = c & 31, ob = rr * 64 + cc * 2; return st * 1024 + (ob ^ (((ob >> 9) & 1) << 5)); }
__device__ __forceinline__ void stage_rc(int b, int& R, int& C) { const int st = b / 1024, sb = b % 1024, swz = sb ^ (((sb >> 9) & 1) << 5); R = (st >> 1) * 16 + swz / 64; C = (st & 1) * 32 + (swz % 64) / 2; }
__device__ __forceinline__ int perm32(int rho) { const int n = rho >> 4, i = rho & 15; return 8 * (i >> 2) + 4 * n + (i & 3); }
__device__ __forceinline__ unsigned cvt_pk_bf16(float lo, float hi) { unsigned r; asm volatile("v_cvt_pk_bf16_f32 %0, %1, %2" : "=v"(r) : "v"(lo), "v"(hi)); return r; }

typedef int v8i_t __attribute__((ext_vector_type(8)));
typedef int v4i_t __attribute__((ext_vector_type(4)));
template <int H> __device__ __forceinline__ bf16x8 half8(v8i_t v) { const v4i_t h = H ? __builtin_shufflevector(v, v, 4, 5, 6, 7) : __builtin_shufflevector(v, v, 0, 1, 2, 3); return __builtin_bit_cast(bf16x8, h); }
__device__ __forceinline__ unsigned ufl(unsigned v) { return (unsigned)__builtin_amdgcn_readfirstlane((int)v); }
struct Unit { int pm, pn, e, ui; unsigned ao, bo; };

__device__ __forceinline__ void acc_zero(f32x4 (&acc)[2][2][4][2]) {
#pragma unroll
    for (int a = 0; a < 2; ++a)
#pragma unroll
        for (int b = 0; b < 2; ++b)
#pragma unroll
            for (int m = 0; m < 4; ++m)
#pragma unroll
                for (int n = 0; n < 2; ++n) acc[a][b][m][n] = (f32x4){0.f, 0.f, 0.f, 0.f};
}
__device__ __forceinline__ bool order_map(int i, int G, int c, int nM, int nN, int& pm, int& pn) {
    const int nwg = nM * nN; const long L = (long)i * G + c; if (L >= nwg) return false;
    int wgid = (int)L; { const int q = nwg / NXCD, r = nwg % NXCD, xcd = wgid % NXCD, off = wgid / NXCD; wgid = (xcd < r ? xcd * (q + 1) : r * (q + 1) + (xcd - r) * q) + off; }
    const int nig = WGM * nN, gid = wgid / nig, fm = gid * WGM, gsz = (nM - fm) < WGM ? (nM - fm) : WGM;
    pm = fm + ((wgid % nig) % gsz); pn = (wgid % nig) / gsz; return true;
}
struct DenseSched {
    const char* A; const char* Bt; int nM, nN, K, G, c, ldaB, ldbB;
    __device__ __forceinline__ void init(const bf16_t* A_, const bf16_t* Bt_, int M, int N, int K_, int G_, int c_) { A = (const char*)A_; Bt = (const char*)Bt_; nM = M / BM; nN = N / BM; K = K_; G = G_; c = c_; ldaB = K_ * 2; ldbB = K_ * 2; }
    __device__ __forceinline__ bool next(int i, Unit& u) const { int pm, pn; if (!order_map(i, G, c, nM, nN, pm, pn)) return false;
        u.pm = pm; u.pn = pn; u.e = 0; u.ui = i; u.ao = (unsigned)pm * BM * ldaB; u.bo = (unsigned)pn * BM * ldbB; return true; }
    __device__ __forceinline__ const LAS unsigned short* tok(int) const { return nullptr; }
    __device__ __forceinline__ const char* abuf() const { return A; }
    __device__ __forceinline__ const char* bbuf() const { return Bt; }
};

template <class Epi, class Sched, bool GATHER, bool FP8 = false, bool ALIGN = true, bool GBASE = false>
__device__ __forceinline__ void gemm_phase(LAS unsigned char* lds, const int nt, const Sched& S, const Epi& E) {
    const int ldaB = S.ldaB, ldbB = S.ldbB;
    const __amdgpu_buffer_rsrc_t rsA = __builtin_amdgcn_make_buffer_rsrc((void*)S.abuf(), (short)0, 0x7ffffff0, 0x00020000);
    const __amdgpu_buffer_rsrc_t rsB = __builtin_amdgcn_make_buffer_rsrc((void*)S.bbuf(), (short)0, 0x7ffffff0, 0x00020000);
    const int tid = threadIdx.x, wid = __builtin_amdgcn_readfirstlane(tid >> 6), lane = tid & 63, wr = wid >> 2, wc = wid & 3, fr = lane & 15, fq = lane >> 4;
    int voffA[2], voffB[2];
#pragma unroll
    for (int i = 0; i < 2; ++i) { int R, C; stage_rc(tid * 16 + i * 8192, R, C); const int Rb = (R & ~31) + perm32(R & 31);
        voffA[i] = GATHER ? (C * 2) : (R * ldaB + C * 2); voffB[i] = Rb * ldbB + C * 2; }
    int vg0[2], vg1[2];
    const unsigned kstep = 128u;
    const unsigned hstepA = (unsigned)HALF * ldaB, hstep = (unsigned)HALF * ldbB;
    const unsigned ldsw = (unsigned)wid * 1024u;
    const int aoff = lds_byte(wr * 64 + fr, fq * 8), boff = lds_byte(wc * 32 + fr, fq * 8);
#define PG8_SA(b, h) (((b) * 2 + (h)) * HTB)
#define PG8_SB(b, h) ((4 + (b) * 2 + (h)) * HTB)
#define PG8_STAGE(bufoff, rs, soff, voff) do { _Pragma("unroll") for (int _i = 0; _i < 2; ++_i) \
        __builtin_amdgcn_raw_ptr_buffer_load_lds(rs, (LAS void*)(lds + (bufoff) + ldsw + _i * 8192), 16, (voff)[_i], (int)(soff), 0, 0); } while (0)
#define PG8_STAGE_A(bufoff, uoff, kb, h) do { if constexpr (GATHER) { const unsigned _so = GBASE ? (uoff) + (kb) : (kb); if ((h) == 0) PG8_STAGE(bufoff, rsA, _so, vg0); else PG8_STAGE(bufoff, rsA, _so, vg1); } \
        else PG8_STAGE(bufoff, rsA, (uoff) + (kb) + (h) * hstepA, voffA); } while (0)
#define PG8_LDA(dst, b, h) do { _Pragma("unroll") for (int m = 0; m < 4; ++m) { const v4i_t _lo = *(const LAS v4i_t*)(lds + PG8_SA(b, h) + aoff + m * 2048), _hi = *(const LAS v4i_t*)(lds + PG8_SA(b, h) + aoff + m * 2048 + 1024); \
        dst[m] = __builtin_shufflevector(_lo, _hi, 0, 1, 2, 3, 4, 5, 6, 7); } } while (0)
#define PG8_LDB(dst, b, h) do { _Pragma("unroll") for (int n = 0; n < 2; ++n) { const v4i_t _lo = *(const LAS v4i_t*)(lds + PG8_SB(b, h) + boff + n * 2048), _hi = *(const LAS v4i_t*)(lds + PG8_SB(b, h) + boff + n * 2048 + 1024); \
        dst[n] = __builtin_shufflevector(_lo, _hi, 0, 1, 2, 3, 4, 5, 6, 7); } } while (0)
#define PG8_MMA(ai, bj, At, Bt) do { __builtin_amdgcn_s_setprio(1); _Pragma("unroll") for (int m = 0; m < 4; ++m) _Pragma("unroll") for (int n = 0; n < 2; ++n) { \
        if constexpr (FP8) acc[ai][bj][m][n] = __builtin_amdgcn_mfma_scale_f32_16x16x128_f8f6f4(Bt[n], At[m], acc[ai][bj][m][n], 0, 0, 0, E.scale_b, 0, E.scale_a); \
        else { acc[ai][bj][m][n] = __builtin_amdgcn_mfma_f32_16x16x32_bf16(half8<0>(Bt[n]), half8<0>(At[m]), acc[ai][bj][m][n], 0, 0, 0); \
               acc[ai][bj][m][n] = __builtin_amdgcn_mfma_f32_16x16x32_bf16(half8<1>(Bt[n]), half8<1>(At[m]), acc[ai][bj][m][n], 0, 0, 0); } } \
        __builtin_amdgcn_s_setprio(0); } while (0)
#define PG8_WAIT_V(n) asm volatile("s_waitcnt vmcnt(" #n ")" ::: "memory")
#define PG8_WAIT_L(n) asm volatile("s_waitcnt lgkmcnt(" #n ")" ::: "memory")
#define PG8_BAR __builtin_amdgcn_s_barrier()
#define PG8_SCHED __builtin_amdgcn_sched_barrier(0)
#define PG8_TROW(_i) (16 * ((wid + 8 * (_i)) >> 1) + (lane >> 2))
#define PG8_TOKOFF(dst0, dst1, tk) do { _Pragma("unroll") for (int _i = 0; _i < 2; ++_i) { dst0[_i] = (int)(tk)[PG8_TROW(_i)] * ldaB + voffA[0]; dst1[_i] = (int)(tk)[HALF + PG8_TROW(_i)] * ldaB + voffA[0]; } } while (0)
    Unit cur, nxt; int ui = 0;
    if (!S.next(0, cur)) return;
    f32x4 acc[2][2][4][2];
    E.init(acc, cur, wc, fq);
    v8i_t At[4], B0[2], B1[2];
    unsigned cA = ufl(cur.ao), cB = ufl(cur.bo);
    if constexpr (GATHER) { const LAS unsigned short* tk = S.tok(0); PG8_TOKOFF(vg0, vg1, tk); } else { vg0[0] = vg0[1] = vg1[0] = vg1[1] = 0; }
    PG8_STAGE(PG8_SB(0, 0), rsB, cB, voffB); PG8_STAGE(PG8_SB(0, 1), rsB, cB + hstep, voffB); PG8_STAGE_A(PG8_SA(0, 0), cA, 0u, 0); PG8_STAGE_A(PG8_SA(0, 1), cA, 0u, 1);
    if (wr == 1) PG8_BAR;
    PG8_WAIT_V(2); PG8_BAR;
    PG8_STAGE(PG8_SB(1, 0), rsB, cB + kstep, voffB); PG8_STAGE_A(PG8_SA(1, 0), cA, kstep, 0); PG8_STAGE(PG8_SB(1, 1), rsB, cB + hstep + kstep, voffB);
    PG8_WAIT_V(6); PG8_BAR;
    for (;;) {
        const bool has_next = S.next(ui + 1, nxt);
        const unsigned nA = ufl(has_next ? nxt.ao : cA), nB = ufl(has_next ? nxt.bo : cB);
#pragma clang loop unroll(disable)
        for (int t = 0; t < nt; t += 2) {
            const bool last = (t == nt - 2);
            const unsigned k1 = (unsigned)(t + 1) * kstep;
            const unsigned a2 = last ? nA : cA, k2 = last ? 0u : (unsigned)(t + 2) * kstep, b2 = last ? nB : cB + (unsigned)(t + 2) * kstep;
            const unsigned k3 = k2 + kstep, b3 = b2 + kstep;
            if constexpr (GATHER) { if (last && has_next) { const LAS unsigned short* tk = S.tok(ui + 1);
#pragma unroll
                for (int _i = 0; _i < 2; ++_i) vg0[_i] = (int)tk[PG8_TROW(_i)] * ldaB + voffA[0]; } }
            PG8_LDB(B0, 0, 0); PG8_LDB(B1, 0, 1); PG8_SCHED; PG8_LDA(At, 0, 0); PG8_STAGE_A(PG8_SA(1, 1), cA, k1, 1);
            PG8_WAIT_V(8); PG8_WAIT_L(0); PG8_BAR; PG8_MMA(0, 0, At, B0); PG8_MMA(0, 1, At, B1); PG8_BAR; PG8_SCHED;
            if constexpr (GATHER) { if (last && has_next) { const LAS unsigned short* tk = S.tok(ui + 1);
#pragma unroll
                for (int _i = 0; _i < 2; ++_i) vg1[_i] = (int)tk[HALF + PG8_TROW(_i)] * ldaB + voffA[0]; } }
            PG8_LDA(At, 0, 1); PG8_STAGE(PG8_SB(0, 0), rsB, b2, voffB); PG8_STAGE(PG8_SB(0, 1), rsB, b2 + hstep, voffB); PG8_STAGE_A(PG8_SA(0, 0), a2, k2, 0);
            PG8_WAIT_V(8); PG8_WAIT_L(0); PG8_BAR; PG8_MMA(1, 0, At, B0); PG8_MMA(1, 1, At, B1); PG8_BAR; PG8_SCHED;
            PG8_LDB(B0, 1, 0); PG8_LDB(B1, 1, 1); PG8_SCHED; PG8_LDA(At, 1, 0); PG8_STAGE_A(PG8_SA(0, 1), a2, k2, 1);
            PG8_WAIT_V(8); PG8_WAIT_L(0); PG8_BAR; PG8_MMA(0, 0, At, B0); PG8_MMA(0, 1, At, B1); PG8_BAR; PG8_SCHED;
            PG8_LDA(At, 1, 1); PG8_STAGE(PG8_SB(1, 0), rsB, b3, voffB); PG8_STAGE(PG8_SB(1, 1), rsB, b3 + hstep, voffB); PG8_STAGE_A(PG8_SA(1, 0), a2, k3, 0);
            PG8_WAIT_V(8); PG8_WAIT_L(0); PG8_BAR; PG8_MMA(1, 0, At, B0); PG8_MMA(1, 1, At, B1); PG8_BAR; PG8_SCHED;
        }
        if constexpr (ALIGN) { if (wr == 0) PG8_BAR; }
        E(acc, cur, wr, wc, fr, fq);
        if (!has_next) break;
        E.init(acc, nxt, wc, fq);
        cur = nxt; cA = nA; cB = nB; ++ui;
        if constexpr (ALIGN) { if (wr == 1) PG8_BAR; }
    }
    PG8_WAIT_V(0);
    if constexpr (!ALIGN) { if (wr == 0) PG8_BAR; }
    PG8_BAR;
#undef PG8_SA
#undef PG8_SB
#undef PG8_STAGE
#undef PG8_STAGE_A
#undef PG8_LDA
#undef PG8_LDB
#undef PG8_MMA
#undef PG8_WAIT_V
#undef PG8_WAIT_L
#undef PG8_BAR
#undef PG8_SCHED
#undef PG8_TOKOFF
#undef PG8_TROW
}

struct EpiStore {
    static constexpr int scale_a = 0x7f7f7f7f, scale_b = 0x7f7f7f7f;
    __device__ __forceinline__ void init(f32x4 (&acc)[2][2][4][2], const Unit&, int, int) const { acc_zero(acc); }
    bf16_t* O; int ldc;
    __device__ __forceinline__ void operator()(const f32x4 (&acc)[2][2][4][2], const Unit& u, int wr, int wc, int fr, int fq) const {
        const int row0 = u.pm * BM + wr * 64 + fr, col0 = u.pn * BM + wc * 32 + 8 * fq;
#pragma unroll
        for (int ai = 0; ai < 2; ++ai)
#pragma unroll
            for (int m = 0; m < 4; ++m) { bf16_t* rowp = O + (size_t)(row0 + ai * HALF + m * 16) * ldc + col0;
#pragma unroll
                for (int bj = 0; bj < 2; ++bj) { const f32x4 v0 = acc[ai][bj][m][0], v1 = acc[ai][bj][m][1];
                    u32x4 w; w.x = cvt_pk_bf16(v0[0], v0[1]); w.y = cvt_pk_bf16(v0[2], v0[3]); w.z = cvt_pk_bf16(v1[0], v1[1]); w.w = cvt_pk_bf16(v1[2], v1[3]);
                    *(u32x4*)(rowp + bj * HALF) = w; } }
    }
};
struct EpiGlu {
    static constexpr int scale_a = 0x7f7f7f7f, scale_b = 0x7f7f7f7f;
    __device__ __forceinline__ void init(f32x4 (&acc)[2][2][4][2], const Unit&, int, int) const { acc_zero(acc); }
    const bf16_t* Y5; bf16_t* O; const float* bias;
    __device__ __forceinline__ void operator()(const f32x4 (&acc)[2][2][4][2], const Unit& u, int wr, int wc, int fr, int fq) const {
        const int row0 = u.pm * BM + wr * 64 + fr, col0 = u.pn * BM + wc * 32 + 8 * fq;
        f32x4 bv[2][2];
#pragma unroll
        for (int bj = 0; bj < 2; ++bj)
#pragma unroll
            for (int n = 0; n < 2; ++n) bv[bj][n] = *(const f32x4*)(bias + col0 + bj * HALF + 4 * n);
#pragma unroll
        for (int ai = 0; ai < 2; ++ai) {
            u32x4 yv[4][2];
#pragma unroll
            for (int m = 0; m < 4; ++m)
#pragma unroll
                for (int bj = 0; bj < 2; ++bj) yv[m][bj] = *(const u32x4*)(Y5 + (size_t)(row0 + ai * HALF + m * 16) * 512 + col0 + bj * HALF);
#pragma unroll
            for (int m = 0; m < 4; ++m) { const int row = row0 + ai * HALF + m * 16;
#pragma unroll
                for (int bj = 0; bj < 2; ++bj) { const f32x4 z0 = acc[ai][bj][m][0] + bv[bj][0], z1 = acc[ai][bj][m][1] + bv[bj][1];
                    const u32x4 y = yv[m][bj];
                    float o[8];
                    o[0] = bf2f(y.x & 0xffffu) * sigmoidf_(z0[0]); o[1] = bf2f(y.x >> 16) * sigmoidf_(z0[1]); o[2] = bf2f(y.y & 0xffffu) * sigmoidf_(z0[2]); o[3] = bf2f(y.y >> 16) * sigmoidf_(z0[3]);
                    o[4] = bf2f(y.z & 0xffffu) * sigmoidf_(z1[0]); o[5] = bf2f(y.z >> 16) * sigmoidf_(z1[1]); o[6] = bf2f(y.w & 0xffffu) * sigmoidf_(z1[2]); o[7] = bf2f(y.w >> 16) * sigmoidf_(z1[3]);
                    u32x4 w; w.x = cvt_pk_bf16(o[0], o[1]); w.y = cvt_pk_bf16(o[2], o[3]); w.z = cvt_pk_bf16(o[4], o[5]); w.w = cvt_pk_bf16(o[6], o[7]);
                    *(u32x4*)(O + (size_t)row * 1024 + 512 + col0 + bj * HALF) = w; } } }
    }
};
constexpr int XT_TOK = 131072;
constexpr int XT_PS = 139264 + 128;
constexpr int XT_BIAS = 147456;
struct ExpSched {
    const char* A; const char* W; LAS unsigned char* lds; int nT, nN, G, c, ldaB, ldbB; unsigned estride;
    __device__ __forceinline__ bool next(int i, Unit& u) const { int pm, pn; if (!order_map(i, G, c, nT, nN, pm, pn)) return false;
        const int e = __builtin_amdgcn_readfirstlane((int)*(const LAS unsigned char*)(lds + XT_PS + 260 + pm));
        u.pm = pm; u.pn = pn; u.e = e; u.ui = i; u.ao = (unsigned)pm * BM * ldaB; u.bo = (unsigned)e * estride + (unsigned)pn * BM * ldbB; return true; }
    int ident;
    __device__ __forceinline__ const LAS unsigned short* tok(int i) const { return (const LAS unsigned short*)(lds + XT_TOK) + (ident ? 0 : i * 256); }
    __device__ __forceinline__ const char* abuf() const { return A; }
    __device__ __forceinline__ const char* bbuf() const { return W; }
};
struct EpiSwiglu {
    static constexpr int scale_a = SC_ONE, scale_b = SC_W8;
    unsigned char* O; const LAS float* bias;
    __device__ __forceinline__ void init(f32x4 (&acc)[2][2][4][2], const Unit& u, int wc, int fq) const {
#pragma unroll
        for (int bj = 0; bj < 2; ++bj)
#pragma unroll
            for (int n = 0; n < 2; ++n) { const f32x4 bv = *(const LAS f32x4*)(bias + u.ui * 256 + bj * HALF + wc * 32 + 8 * fq + 4 * n);
#pragma unroll
                for (int ai = 0; ai < 2; ++ai)
#pragma unroll
                    for (int m = 0; m < 4; ++m) acc[ai][bj][m][n] = bv; }
    }
    __device__ __forceinline__ void operator()(const f32x4 (&acc)[2][2][4][2], const Unit& u, int wr, int wc, int fr, int fq) const {
        const int row0 = u.pm * BM + wr * 64 + fr, col0 = u.pn * HALF + wc * 32 + 8 * fq;
#pragma unroll
        for (int ai = 0; ai < 2; ++ai)
#pragma unroll
            for (int m = 0; m < 4; ++m) { const int row = row0 + ai * HALF + m * 16; float o[8];
#pragma unroll
                for (int n = 0; n < 2; ++n) { const f32x4 g4 = acc[ai][0][m][n], u4 = acc[ai][1][m][n];
#pragma unroll
                    for (int i = 0; i < 4; ++i) { const float g = fminf(g4[i], 7.f), up = __builtin_amdgcn_fmed3f(u4[i], -7.f, 7.f);
                        const float sg = g * __builtin_amdgcn_rcpf(1.f + __builtin_amdgcn_exp2f(-2.4554669595930157f * g));
                        o[4 * n + i] = fmaf(up, ACT8_SCALE, ACT8_SCALE) * sg; } }
                v2u w; w.x = (unsigned)__builtin_amdgcn_cvt_pk_fp8_f32(o[2], o[3], __builtin_amdgcn_cvt_pk_fp8_f32(o[0], o[1], 0, false), true);
                w.y = (unsigned)__builtin_amdgcn_cvt_pk_fp8_f32(o[6], o[7], __builtin_amdgcn_cvt_pk_fp8_f32(o[4], o[5], 0, false), true);
                *(v2u*)(O + (size_t)row * 1024 + col0) = w; }
    }
};
__device__ __forceinline__ v2u xchg16(v2u v) { v2u r; r.x = (unsigned)__builtin_amdgcn_ds_swizzle((int)v.x, 0x401f); r.y = (unsigned)__builtin_amdgcn_ds_swizzle((int)v.y, 0x401f); return r; }
struct EpiDown {
    static constexpr int scale_a = SC_ACT8, scale_b = SC_W8;
    unsigned char* O; const LAS float* bias;
    __device__ __forceinline__ void init(f32x4 (&acc)[2][2][4][2], const Unit& u, int wc, int fq) const {
#pragma unroll
        for (int bj = 0; bj < 2; ++bj)
#pragma unroll
            for (int n = 0; n < 2; ++n) { const f32x4 bv = *(const LAS f32x4*)(bias + u.ui * 256 + bj * HALF + wc * 32 + 8 * fq + 4 * n);
#pragma unroll
                for (int ai = 0; ai < 2; ++ai)
#pragma unroll
                    for (int m = 0; m < 4; ++m) acc[ai][bj][m][n] = bv; }
    }
    __device__ __forceinline__ void operator()(const f32x4 (&acc)[2][2][4][2], const Unit& u, int wr, int wc, int fr, int fq) const {
        const int row0 = u.pm * BM + wr * 64 + fr, col0 = u.pn * BM + wc * 32 + 8 * fq; const bool odd = (fq & 1) != 0;
        unsigned char* base = O + (size_t)row0 * 1024 + (odd ? col0 - 8 + HALF : col0);
#pragma unroll
        for (int ai = 0; ai < 2; ++ai)
#pragma unroll
            for (int m = 0; m < 4; ++m) { v2u w[2];
#pragma unroll
                for (int bj = 0; bj < 2; ++bj) { const f32x4 v0 = acc[ai][bj][m][0] * Y8_SCALE, v1 = acc[ai][bj][m][1] * Y8_SCALE;
                    w[bj].x = pk4_fp8(v0[0], v0[1], v0[2], v0[3]); w[bj].y = pk4_fp8(v1[0], v1[1], v1[2], v1[3]); }
                const v2u got = xchg16(odd ? w[0] : w[1]);
                const v4u out = odd ? (v4u){got.x, got.y, w[1].x, w[1].y} : (v4u){w[0].x, w[0].y, got.x, got.y};
                *(v4u*)(base + (size_t)(ai * HALF + m * 16) * 1024) = out; }
    }
};
struct S5Sched {
    const char* UX; const char* Mt; unsigned mstride; int c, ldaB, ldbB;
    __device__ __forceinline__ bool next(int i, Unit& u) const { const int L = c - 128; if (i > 0 || L < 0) return false;
        const int pm = (L >> 3) & 3, g = (L & 7) + 8 * (L >> 5);
        u.pm = pm; u.pn = 0; u.e = g; u.ui = 0; u.ao = (unsigned)(g * 1024 + pm * 256) * 768u; u.bo = (unsigned)g * mstride; return true; }
    __device__ __forceinline__ const LAS unsigned short* tok(int) const { return nullptr; }
    __device__ __forceinline__ const char* abuf() const { return UX; }
    __device__ __forceinline__ const char* bbuf() const { return Mt; }
};
struct EpiDX {
    static constexpr int scale_a = SC_ONE, scale_b = SC_ONE;
    __device__ __forceinline__ void init(f32x4 (&acc)[2][2][4][2], const Unit&, int, int) const { acc_zero(acc); }
    float* O;
    __device__ __forceinline__ void operator()(const f32x4 (&acc)[2][2][4][2], const Unit& u, int wr, int wc, int fr, int fq) const {
        const int row0 = u.e * 1024 + u.pm * BM + wr * 64 + fr, col0 = wc * 32 + 8 * fq;
#pragma unroll
        for (int ai = 0; ai < 2; ++ai)
#pragma unroll
            for (int m = 0; m < 4; ++m) { float* rowp = O + (size_t)(row0 + ai * HALF + m * 16) * 128 + col0;
                *(f32x4*)rowp = acc[ai][0][m][0]; *(f32x4*)(rowp + 4) = acc[ai][0][m][1]; }
    }
};
struct EpiS5Y {
    static constexpr int scale_a = SC_ONE, scale_b = SC_ONE;
    __device__ __forceinline__ void init(f32x4 (&acc)[2][2][4][2], const Unit&, int, int) const { acc_zero(acc); }
    bf16_t* Y5;
    __device__ __forceinline__ void operator()(const f32x4 (&acc)[2][2][4][2], const Unit& u, int wr, int wc, int fr, int fq) const {
        const int g = u.e, r0 = u.pm * BM + wr * 64 + fr;
#pragma unroll
        for (int bj = 0; bj < 2; ++bj) { const int col = bj * HALF + wc * 32 + 8 * fq, t = col >> 4, h0 = col & 15;
#pragma unroll
            for (int ai = 0; ai < 2; ++ai)
#pragma unroll
                for (int m = 0; m < 4; ++m) { const int r = r0 + ai * HALF + m * 16;
                    const f32x4 v0 = acc[ai][bj][m][0], v1 = acc[ai][bj][m][1];
                    u32x4 w; w.x = cvt_pk_bf16(gelu_tanh(v0[0]), gelu_tanh(v0[1])); w.y = cvt_pk_bf16(gelu_tanh(v0[2]), gelu_tanh(v0[3]));
                    w.z = cvt_pk_bf16(gelu_tanh(v1[0]), gelu_tanh(v1[1])); w.w = cvt_pk_bf16(gelu_tanh(v1[2]), gelu_tanh(v1[3]));
                    *(u32x4*)(Y5 + ((size_t)(r * 16 + t) * 512 + g * 16 + h0)) = w; } }
    }
};
struct EpiProj {
    static constexpr int scale_a = SC_ONE, scale_b = SC_ONE;
    __device__ __forceinline__ void init(f32x4 (&acc)[2][2][4][2], const Unit&, int, int) const { acc_zero(acc); }
    bf16_t* O; bf16_t* UX;
    __device__ __forceinline__ void operator()(const f32x4 (&acc)[2][2][4][2], const Unit& u, int wr, int wc, int fr, int fq) const {
        const int row0 = u.pm * BM + wr * 64 + fr, col0 = u.pn * BM + wc * 32 + 8 * fq;
#pragma unroll
        for (int ai = 0; ai < 2; ++ai)
#pragma unroll
            for (int m = 0; m < 4; ++m) { const int row = row0 + ai * HALF + m * 16;
#pragma unroll
                for (int bj = 0; bj < 2; ++bj) { const f32x4 v0 = acc[ai][bj][m][0], v1 = acc[ai][bj][m][1]; const int col = col0 + bj * HALF;
                    u32x4 w; w.x = cvt_pk_bf16(v0[0], v0[1]); w.y = cvt_pk_bf16(v0[2], v0[3]); w.z = cvt_pk_bf16(v1[0], v1[1]); w.w = cvt_pk_bf16(v1[2], v1[3]);
                    if (col < 1536) *(u32x4*)(O + (size_t)row * 2048 + col) = w;
                    else { const int cu = col - 1536, g = cu >> 4, h0 = cu & 15; *(u32x4*)(UX + ((size_t)(g * 1024 + (row >> 4)) * 384 + (row & 15) * 16 + h0)) = w; } } }
    }
};
}

struct Args { const float* in[29]; float* out; unsigned char* ws; int ph_lo, ph_hi; };
enum { I_X = 0, I_C, I_ADAW, I_ADAB, I_MIXPRE, I_MIXPOST, I_FFNPRE, I_FFNPOST, I_WIN, I_WALPHA, I_BALPHA, I_GLANORM,
       I_LRE, I_LIM, I_LOGDT, I_BRE, I_BIM, I_CRE, I_CIM, I_SD, I_GLUW, I_GLUB, I_WOUT, I_RW, I_RB, I_WGU, I_BGU, I_WDN, I_BDN };

struct Ctx { int tid, lane, wave, bid, G, gw, ngw, gtid, ngt; LAS unsigned char* lds; };

template <int MODE> __device__ __forceinline__ int rowmap(int n) {
    if (MODE == 1) { return n < 1536 ? n : (n < 1552 ? -1 : n - 16); }
    if (MODE == 2) { const int jj = n & 1023, up = n >> 10; return 256 * (jj >> 7) + 128 * up + (jj & 127); }
    return n;
}
template <int MODE> __device__ __forceinline__ void transpose_item(const float* W, int K, int N, int kb, int nb, bf16_t* dst, int lane) {
    const int n = nb * 64 + lane, nn = n < N ? n : N - 1;
    const float* src = W + (size_t)(kb * 64) * N + nn;
    float v[64];
#pragma unroll
    for (int i = 0; i < 64; ++i) v[i] = src[(size_t)i * N];
    const int row = n < N ? rowmap<MODE>(n) : -1;
    if (row >= 0) {
        bf16_t* p = dst + (size_t)row * K + kb * 64;
#pragma unroll
        for (int c = 0; c < 8; ++c) { v4u o; o.x = pk2(v[8 * c], v[8 * c + 1]); o.y = pk2(v[8 * c + 2], v[8 * c + 3]); o.z = pk2(v[8 * c + 4], v[8 * c + 5]); o.w = pk2(v[8 * c + 6], v[8 * c + 7]);
            *(v4u*)(p + 8 * c) = o; }
    }
}
struct XItem { const float* W; unsigned char* dst; int N, kt, n0, mode; };
__device__ __forceinline__ XItem xitem(const Args& a, int it) {
    XItem x;
    if (it < 2048) { const int e = it >> 6, r = it & 63; x.W = a.in[I_WGU] + (size_t)e * 1024 * 2048; x.dst = (unsigned char*)(a.ws + WS_GU_T) + (size_t)e * 2048 * 1024; x.N = 2048; x.kt = r >> 3; x.n0 = (r & 7) * 256; x.mode = 2; }
    else { const int i2 = it - 2048, e = i2 >> 5, r = i2 & 31; x.W = a.in[I_WDN] + (size_t)e * 1024 * 1024; x.dst = (unsigned char*)(a.ws + WS_DN_T) + (size_t)e * 1024 * 1024; x.N = 1024; x.kt = r >> 2; x.n0 = (r & 3) * 256; x.mode = 0; }
    return x;
}
constexpr int WI_P0 = 2048, WI_BAR = 1792, WI_NBAR = 9, WI_P3 = WI_P0 + WI_BAR * WI_NBAR, WI_P5 = WI_P3 + 1024, WI_P6 = WI_P5 + 3072, WI_END = 24576;
__device__ __forceinline__ void wconv_item(const Args& a, LAS unsigned char* T, int wi, int lane) {
    const XItem x = xitem(a, wi >> 3); const int n0 = x.n0 + 32 * (wi & 7), r8 = lane >> 3, c4 = lane & 7;
    f32x4 v[16];
#pragma unroll
    for (int i = 0; i < 16; ++i) v[i] = __builtin_nontemporal_load((const f32x4*)(x.W + (size_t)(x.kt * 128 + 16 * r8 + i) * x.N + n0 + 4 * c4));
#pragma unroll
    for (int j = 0; j < 4; ++j) { v4u o;
        o.x = pk4_fp8(v[0][j] * W8_SCALE, v[1][j] * W8_SCALE, v[2][j] * W8_SCALE, v[3][j] * W8_SCALE); o.y = pk4_fp8(v[4][j] * W8_SCALE, v[5][j] * W8_SCALE, v[6][j] * W8_SCALE, v[7][j] * W8_SCALE);
        o.z = pk4_fp8(v[8][j] * W8_SCALE, v[9][j] * W8_SCALE, v[10][j] * W8_SCALE, v[11][j] * W8_SCALE); o.w = pk4_fp8(v[12][j] * W8_SCALE, v[13][j] * W8_SCALE, v[14][j] * W8_SCALE, v[15][j] * W8_SCALE);
        *(LAS v4u*)(T + (4 * c4 + j) * 144 + 16 * r8) = o; }
    asm volatile("s_waitcnt lgkmcnt(0)" ::: "memory");
#pragma unroll
    for (int q = 0; q < 4; ++q) { const int idx = lane + 64 * q, n = idx >> 3, ch = idx & 7;
        const int row = x.mode == 2 ? rowmap<2>(n0 + n) : n0 + n;
        *(v4u*)(x.dst + (size_t)row * 1024 + x.kt * 128 + 16 * ch) = *(const LAS v4u*)(T + n * 144 + 16 * ch); }
    asm volatile("s_waitcnt lgkmcnt(0)" ::: "memory");
}
__device__ __forceinline__ void xcd_barrier_conv(const XcdBarrier& b, const Args& a, const Ctx& c, int bi) {
    asm volatile("s_waitcnt vmcnt(0)" ::: "memory");
    __syncthreads();
    if (c.wave == 0) {
      if (threadIdx.x == 0) {
        unsigned* bar = b.bar;
        __builtin_amdgcn_s_waitcnt(0);
        unsigned nloc = b.st[0], nx = b.st[1];
        if (nloc == 0u) { xcd_barrier_complete(bar, b.x, nloc, nx); b.st[0] = nloc; b.st[1] = nx; }
        const unsigned old = xb_add(&bar[XB_XSUB(b.x)], 1u);
        const unsigned gen = old / nloc;
        if (old + 1u == (gen + 1u) * nloc) {
            __builtin_amdgcn_fence(__ATOMIC_RELEASE, "agent");
            asm volatile("s_waitcnt vmcnt(0)" ::: "memory");
            const unsigned og = xb_add(&bar[XB_TOP], 1u);
            const unsigned tg = og / nx;
            if (og + 1u == (tg + 1u) * nx) xb_add(&bar[XB_TOPGEN], 1u);
            else XB_SPIN(xb_ld(&bar[XB_TOPGEN]) == tg, bar);
            __builtin_amdgcn_fence(__ATOMIC_ACQUIRE, "agent");
            xb_add(&bar[XB_XGEN(b.x)], 1u);
            asm volatile("s_waitcnt vmcnt(0)" ::: "memory");
        } else {
            __builtin_amdgcn_fence(__ATOMIC_ACQUIRE, "agent");
            XB_SPIN(xb_ld(&bar[XB_XGEN(b.x)]) == gen, bar);
            asm volatile("s_waitcnt vmcnt(0)" ::: "memory");
        }
      }
    } else if (bi >= 0 && bi < WI_NBAR) {
        wconv_item(a, c.lds + c.wave * 5120, WI_P0 + WI_BAR * bi + c.bid * 7 + (c.wave - 1), c.lane);
    }
    __syncthreads();
}
__device__ __forceinline__ void ph0_prologue(const Args& a, const Ctx& c) {
    if (c.bid < 192) {
        LAS float* sc = (LAS float*)c.lds;
        LAS float* part = (LAS float*)(c.lds + 32768);
        const float* cin = a.in[I_C];
        for (int i = c.tid; i < 8 * 1024; i += NTHR) { const int b = i >> 10, k = i & 1023; const float x = cin[i]; sc[k * 8 + b] = x * sigmoidf_(x); }
        const int cg = c.tid & 7, rg = c.tid >> 3, n0 = c.bid * 32;
        f32x4 w[16];
#pragma unroll
        for (int s2 = 0; s2 < 16; ++s2) w[s2] = __builtin_nontemporal_load((const f32x4*)(a.in[I_ADAW] + (size_t)(rg + 64 * s2) * 6144 + n0 + 4 * cg));
        __syncthreads();
        f32x4 acc[8];
#pragma unroll
        for (int b = 0; b < 8; ++b) acc[b] = (f32x4){0.f, 0.f, 0.f, 0.f};
#pragma unroll
        for (int s2 = 0; s2 < 16; ++s2) { const int k = rg + 64 * s2; const f32x4 s0 = *(const LAS f32x4*)(sc + k * 8), s1 = *(const LAS f32x4*)(sc + k * 8 + 4);
            acc[0] += w[s2] * s0.x; acc[1] += w[s2] * s0.y; acc[2] += w[s2] * s0.z; acc[3] += w[s2] * s0.w;
            acc[4] += w[s2] * s1.x; acc[5] += w[s2] * s1.y; acc[6] += w[s2] * s1.z; acc[7] += w[s2] * s1.w; }
#pragma unroll
        for (int b = 0; b < 8; ++b) *(LAS f32x4*)(part + (rg * 8 + b) * 32 + 4 * cg) = acc[b];
        __syncthreads();
        if (c.tid < 256) { const int b = c.tid >> 5, cl = c.tid & 31; float sum = a.in[I_ADAB][n0 + cl];
            for (int r2 = 0; r2 < 64; ++r2) sum += part[(r2 * 8 + b) * 32 + cl];
            ((float*)(a.ws + WS_MOD))[b * 6144 + n0 + cl] = sum; }
        __syncthreads();
    }
    if (c.gtid < SG * SP) {
        const int g = c.gtid / SP;
        const double lr = a.in[I_LRE][c.gtid], li = a.in[I_LIM][c.gtid], dt = exp((double)a.in[I_LOGDT][g]);
        const double mag = exp(lr * dt), abr = mag * cos(li * dt), abi = mag * sin(li * dt), den = lr * lr + li * li;
        const double fr = ((abr - 1.0) * lr + abi * li) / den, fi = (abi * lr - (abr - 1.0) * li) / den;
        float* AB = (float*)(a.ws + WS_S5AB); AB[c.gtid * 2] = (float)abr; AB[c.gtid * 2 + 1] = (float)abi;
        { float* AP = (float*)(a.ws + WS_APOW); double pr = 1.0, pi = 0.0;
            for (int n = 0; n <= 16; ++n) { AP[((g * 17 + n) * 64 + (c.gtid & 63)) * 2] = (float)pr; AP[((g * 17 + n) * 64 + (c.gtid & 63)) * 2 + 1] = (float)pi;
                const double tr = pr * abr - pi * abi, ti = pr * abi + pi * abr; pr = tr; pi = ti; }
            double sr = abr, si = abi;
            for (int q = 0; q < 8; ++q) { const double tr = sr * sr - si * si, ti = 2.0 * sr * si; sr = tr; si = ti; }
            float* A2 = (float*)(a.ws + WS_A256); A2[c.gtid * 2] = (float)sr; A2[c.gtid * 2 + 1] = (float)si; }
        float* BB = (float*)(a.ws + WS_S5BB);
        for (int h = 0; h < SC; ++h) { const double br = a.in[I_BRE][c.gtid * SC + h], bi = a.in[I_BIM][c.gtid * SC + h];
            BB[(c.gtid * SC + h) * 2] = (float)(fr * br - fi * bi); BB[(c.gtid * SC + h) * 2 + 1] = (float)(fr * bi + fi * br); }
    }
    { constexpr int IT_WIN = 16 * 33, IT_GLU = 8 * 8, IT_WOUT = 16 * 16, NITEMS = IT_WIN + IT_GLU + IT_WOUT;
        for (int it = (c.bid >= 192 ? (c.bid - 192) * NWAVES + c.wave : NITEMS); it < NITEMS; it += 64 * NWAVES) { int r = it;
            if (r < IT_WIN) { transpose_item<1>(a.in[I_WIN], 1024, NIN, r / 33, r % 33, (bf16_t*)(a.ws + WS_WIN_T), c.lane); continue; } r -= IT_WIN;
            if (r < IT_GLU) { transpose_item<0>(a.in[I_GLUW], 512, 512, r / 8, r % 8, (bf16_t*)(a.ws + WS_GLU_T), c.lane); continue; } r -= IT_GLU;
            transpose_item<0>(a.in[I_WOUT], 1024, 1024, r / 16, r % 16, (bf16_t*)(a.ws + WS_WOUT_T), c.lane); } }
    for (int wi = c.gw; wi < WI_P0; wi += c.ngw) wconv_item(a, c.lds + c.wave * 5120, wi, c.lane);
    __syncthreads();
}

__device__ __forceinline__ void ph1_norm1(const Args& a, const Ctx& c) {
    const float* mod = (const float*)(a.ws + WS_MOD);
    bf16_t* HN = (bf16_t*)(a.ws + WS_HN); float* ALR = (float*)(a.ws + WS_ALR);
    constexpr int PITCH = 2064, LO = 16 * PITCH, PART = 2 * LO;
    s16x8 wh[4], wl[4];
#pragma unroll
    for (int ks = 0; ks < 4; ++ks) { float wv[8];
#pragma unroll
        for (int j = 0; j < 8; ++j) wv[j] = a.in[I_WIN][(size_t)(128 * c.wave + 32 * ks + 8 * (c.lane >> 4) + j) * NIN + 1536 + (c.lane & 15)];
        unsigned hh[4], ll[4];
#pragma unroll
        for (int j = 0; j < 4; ++j) { hh[j] = pk2(wv[2 * j], wv[2 * j + 1]); ll[j] = pk2(wv[2 * j] - bf2f(hh[j] & 0xffffu), wv[2 * j + 1] - bf2f(hh[j] >> 16)); }
        wh[ks] = __builtin_bit_cast(s16x8, (v4u){hh[0], hh[1], hh[2], hh[3]}); wl[ks] = __builtin_bit_cast(s16x8, (v4u){ll[0], ll[1], ll[2], ll[3]}); }
    f32x4 xb[2][2][4];
#define P1_LOAD(buf, it_) do { const int r0_ = 2 * c.gw + 2 * c.ngw * (it_); _Pragma("unroll") for (int r = 0; r < 2; ++r) _Pragma("unroll") for (int j = 0; j < 4; ++j) \
        xb[buf][r][j] = __builtin_nontemporal_load((const f32x4*)(a.in[I_X] + (size_t)(r0_ + r) * D) + c.lane + 64 * j); } while (0)
    P1_LOAD(0, 0);
#pragma unroll
    for (int it = 0; it < 4; ++it) { const int row0 = 2 * c.gw + 2 * c.ngw * it, cbuf = it & 1;
        const int b = row0 / NT;
        f32x4 gv[4], shv[4], scv[4];
#pragma unroll
        for (int j = 0; j < 4; ++j) { const int col = 4 * c.lane + 256 * j; gv[j] = *(const f32x4*)(a.in[I_MIXPRE] + col); shv[j] = *(const f32x4*)(mod + b * 6144 + col); scv[j] = *(const f32x4*)(mod + b * 6144 + 1024 + col) + 1.f; }
        if (it + 1 < 4) P1_LOAD((it + 1) & 1, it + 1);
#pragma unroll
        for (int r = 0; r < 2; ++r) { float ss = 0.f;
#pragma unroll
            for (int j = 0; j < 4; ++j) { const f32x4 v = xb[cbuf][r][j]; ss += (v.x * v.x + v.y * v.y) + (v.z * v.z + v.w * v.w); }
            const float rstd = rsqrtf(wave_sum(ss) * (1.f / D) + EPS);
#pragma unroll
            for (int j = 0; j < 4; ++j) { const int col = 4 * c.lane + 256 * j;
                const f32x4 v = xb[cbuf][r][j] * rstd * gv[j] * scv[j] + shv[j];
                const unsigned h0 = pk2(v.x, v.y), h1 = pk2(v.z, v.w);
                *(v2u*)(HN + (size_t)(row0 + r) * D + col) = (v2u){h0, h1};
                const unsigned l0 = pk2(v.x - bf2f(h0 & 0xffffu), v.y - bf2f(h0 >> 16)), l1 = pk2(v.z - bf2f(h1 & 0xffffu), v.w - bf2f(h1 >> 16));
                const int off = (2 * c.wave + r) * PITCH + col * 2;
                *(LAS v2u*)(c.lds + off) = (v2u){h0, h1}; *(LAS v2u*)(c.lds + LO + off) = (v2u){l0, l1}; } }
        __syncthreads();
        { f32x4 pacc = (f32x4){0.f, 0.f, 0.f, 0.f};
#pragma unroll
            for (int ks = 0; ks < 4; ++ks) { const int aoff = (c.lane & 15) * PITCH + (128 * c.wave + 32 * ks + 8 * (c.lane >> 4)) * 2;
                const s16x8 ahi = *(const LAS s16x8*)(c.lds + aoff), alo = *(const LAS s16x8*)(c.lds + LO + aoff);
                pacc = __builtin_amdgcn_mfma_f32_16x16x32_bf16(ahi, wh[ks], pacc, 0, 0, 0);
                pacc = __builtin_amdgcn_mfma_f32_16x16x32_bf16(ahi, wl[ks], pacc, 0, 0, 0);
                pacc = __builtin_amdgcn_mfma_f32_16x16x32_bf16(alo, wh[ks], pacc, 0, 0, 0); }
            LAS float* part = (LAS float*)(c.lds + PART) + c.wave * 256;
#pragma unroll
            for (int r = 0; r < 4; ++r) part[(4 * (c.lane >> 4) + r) * 16 + (c.lane & 15)] = pacc[r]; }
        __syncthreads();
        if (c.tid < 256) { float sum = 0.f;
#pragma unroll
            for (int w2 = 0; w2 < 8; ++w2) sum += ((const LAS float*)(c.lds + PART))[w2 * 256 + c.tid];
            ALR[((size_t)(16 * c.bid + 2 * c.ngw * it) * 16) + c.tid] = sum; }
    }
#undef P1_LOAD
    __syncthreads();
}

__device__ __forceinline__ float s5_e_val(const float* AP, const float* BB, int g, int row, int col) {
    if (row >= 128) return 0.f;
    const int p = row & 63, im = row >> 6, s_ = col >> 4, h = col & 15;
    const float ar = AP[((g * 17 + 15 - s_) * 64 + p) * 2], ai = AP[((g * 17 + 15 - s_) * 64 + p) * 2 + 1];
    const float br = BB[((g * 64 + p) * 16 + h) * 2], bi = BB[((g * 64 + p) * 16 + h) * 2 + 1];
    return im ? (ar * bi + ai * br) : (ar * br - ai * bi);
}
__device__ __forceinline__ float s5_f_val(const float* AP, const float* CR, const float* CI, int g, int t, int h, int col) {
    const int p = (col - 256) & 63, im = (col - 256) >> 6;
    const float ar = AP[((g * 17 + t + 1) * 64 + p) * 2], ai = AP[((g * 17 + t + 1) * 64 + p) * 2 + 1];
    const float cr = CR[(g * 16 + h) * 64 + p], ci = CI[(g * 16 + h) * 64 + p];
    return im ? -(cr * ai + ci * ar) : (cr * ar - ci * ai);
}
__device__ __forceinline__ void s5_build_mats(const Args& a, const Ctx& c) {
    const float* AP = (const float*)(a.ws + WS_APOW); const float* BB = (const float*)(a.ws + WS_S5BB);
    unsigned* E2 = (unsigned*)(a.ws + WS_SE); unsigned* MF2 = (unsigned*)(a.ws + WS_SMF); bf16_t* MF = (bf16_t*)(a.ws + WS_SMF);
    for (int q0 = c.gtid; q0 < SG * 256 * 128; q0 += 4 * c.ngt) { unsigned w[4];
#pragma unroll
        for (int j = 0; j < 4; ++j) { const int q = q0 + j * c.ngt, qq = q < SG * 256 * 128 ? q : 0, g = qq >> 15, row = (qq >> 7) & 255, col = (qq & 127) * 2;
            w[j] = pk2(s5_e_val(AP, BB, g, row, col), s5_e_val(AP, BB, g, row, col + 1)); }
#pragma unroll
        for (int j = 0; j < 4; ++j) { const int q = q0 + j * c.ngt; if (q < SG * 256 * 128) E2[q] = w[j]; } }
    for (int q0 = c.gtid; q0 < SG * 256 * 192; q0 += 4 * c.ngt) { unsigned w[4]; bool st[4];
#pragma unroll
        for (int j = 0; j < 4; ++j) { const int q = q0 + j * c.ngt, qq = q < SG * 256 * 192 ? q : 0, g = qq / (256 * 192), rem = qq % (256 * 192), row = rem / 192, col = (rem % 192) * 2, t = row >> 4, h = row & 15;
            if (col < 256) { w[j] = 0u; st[j] = (col >> 4) > t; }
            else { w[j] = pk2(s5_f_val(AP, a.in[I_CRE], a.in[I_CIM], g, t, h, col), s5_f_val(AP, a.in[I_CRE], a.in[I_CIM], g, t, h, col + 1)); st[j] = true; }
            st[j] = st[j] && (q < SG * 256 * 192); }
#pragma unroll
        for (int j = 0; j < 4; ++j) if (st[j]) MF2[q0 + j * c.ngt] = w[j]; }
    for (int idx = c.gtid; idx < SG * 16 * 256; idx += c.ngt) { const int g = idx >> 12, tau = (idx >> 8) & 15, h = (idx >> 4) & 15, h2 = idx & 15;
        float sum = 0.f;
#pragma unroll 16
        for (int p = 0; p < 64; ++p) { const float ar = AP[((g * 17 + tau) * 64 + p) * 2], ai = AP[((g * 17 + tau) * 64 + p) * 2 + 1];
            const float br = BB[((g * 64 + p) * 16 + h2) * 2], bi = BB[((g * 64 + p) * 16 + h2) * 2 + 1];
            const float cr = a.in[I_CRE][(g * 16 + h) * 64 + p], ci = a.in[I_CIM][(g * 16 + h) * 64 + p];
            const float zr = ar * br - ai * bi, zi = ar * bi + ai * br;
            sum += cr * zr - ci * zi; }
        if (tau == 0 && h == h2) sum += a.in[I_SD][g * 16 + h];
        const bf16_t kv = (bf16_t)f2bf(sum);
        for (int t = tau; t < 16; ++t) MF[((size_t)g * 256 + t * 16 + h) * 384 + (t - tau) * 16 + h2] = kv; }
}

__device__ __forceinline__ void ph2_gemm1(const Args& a, const Ctx& c) {
    pg8::DenseSched S; S.init((const bf16_t*)(a.ws + WS_HN), (const bf16_t*)(a.ws + WS_WIN_T), NTOK, NPROJ, D, c.G, c.bid);
    pg8::EpiProj E{(bf16_t*)(a.ws + WS_PROJ), (bf16_t*)(a.ws + WS_UX)};
    pg8::gemm_phase<pg8::EpiProj, pg8::DenseSched, false>(c.lds, D / 64, S, E);
}
__device__ __forceinline__ void ph6_glu(const Args& a, const Ctx& c) {
    pg8::DenseSched S; S.init((const bf16_t*)(a.ws + WS_Y5), (const bf16_t*)(a.ws + WS_GLU_T), NTOK, 512, 512, c.G, c.bid);
    pg8::EpiGlu E{(const bf16_t*)(a.ws + WS_Y5), (bf16_t*)(a.ws + WS_MIXIN), a.in[I_GLUB]};
    pg8::gemm_phase<pg8::EpiGlu, pg8::DenseSched, false>(c.lds, 512 / 64, S, E);
}
__device__ __forceinline__ void ph7_wout(const Args& a, const Ctx& c) {
    pg8::DenseSched S; S.init((const bf16_t*)(a.ws + WS_MIXIN), (const bf16_t*)(a.ws + WS_WOUT_T), NTOK, D, D, c.G, c.bid);
    pg8::EpiStore E{(bf16_t*)(a.ws + WS_MIX), D};
    pg8::gemm_phase<pg8::EpiStore, pg8::DenseSched, false>(c.lds, D / 64, S, E);
}


__device__ __forceinline__ void s5_dx_gemm(const Args& a, const Ctx& c) {
    pg8::S5Sched S{(const char*)(a.ws + WS_UX), (const char*)(a.ws + WS_SE), 256u * 256u * 2u, c.bid, 768, 512};
    pg8::EpiDX E{(float*)(a.ws + WS_DX)};
    pg8::gemm_phase<pg8::EpiDX, pg8::S5Sched, false>(c.lds, 256 / 64, S, E);
}
__device__ __forceinline__ void s5_y_gemm(const Args& a, const Ctx& c) {
    pg8::S5Sched S{(const char*)(a.ws + WS_UX), (const char*)(a.ws + WS_SMF), 256u * 384u * 2u, c.bid, 768, 768};
    pg8::EpiS5Y E{(bf16_t*)(a.ws + WS_Y5)};
    pg8::gemm_phase<pg8::EpiS5Y, pg8::S5Sched, false>(c.lds, 384 / 64, S, E);
}
__device__ __forceinline__ void s5_scan(const Args& a, const Ctx& c) {
    const float* AP = (const float*)(a.ws + WS_APOW); const float* A2 = (const float*)(a.ws + WS_A256);
    const float* DX = (const float*)(a.ws + WS_DX); bf16_t* UX = (bf16_t*)(a.ws + WS_UX);
    LAS float* ES = (LAS float*)c.lds;
    for (int bg = c.bid; bg < NB * SG; bg += c.G) { const int b = bg >> 5, g = bg & 31, seg = c.wave, p = c.lane;
        const float ar = AP[((g * 17 + 16) * 64 + p) * 2], ai = AP[((g * 17 + 16) * 64 + p) * 2 + 1];
        const float mr = A2[(g * 64 + p) * 2], mi = A2[(g * 64 + p) * 2 + 1];
        float dr[16], di[16];
        const size_t r0 = (size_t)g * 1024 + b * 128 + seg * 16;
#pragma unroll
        for (int j = 0; j < 16; ++j) { dr[j] = DX[(r0 + j) * 128 + p]; di[j] = DX[(r0 + j) * 128 + 64 + p]; }
        float xr = 0.f, xi = 0.f;
#pragma unroll
        for (int j = 0; j < 16; ++j) { const float nr = ar * xr - ai * xi + dr[j], ni = ar * xi + ai * xr + di[j]; xr = nr; xi = ni; }
        ES[(seg * 64 + p) * 2] = xr; ES[(seg * 64 + p) * 2 + 1] = xi;
        __syncthreads();
        float cr = 0.f, ci = 0.f;
        for (int s2 = 0; s2 < seg; ++s2) { const float er = ES[(s2 * 64 + p) * 2], ei = ES[(s2 * 64 + p) * 2 + 1];
            const float nr = mr * cr - mi * ci + er, ni = mr * ci + mi * cr + ei; cr = nr; ci = ni; }
        xr = cr; xi = ci;
#pragma unroll
        for (int j = 0; j < 16; ++j) { UX[(r0 + j) * 384 + 256 + p] = (bf16_t)f2bf(xr); UX[(r0 + j) * 384 + 320 + p] = (bf16_t)f2bf(xi);
            const float nr = ar * xr - ai * xi + dr[j], ni = ar * xi + ai * xr + di[j]; xr = nr; xi = ni; }
        __syncthreads();
    }
}

__device__ __forceinline__ unsigned offb(unsigned row, unsigned ch) { return 256u * row + 16u * (ch ^ (((row & 3u) << 2) | ((row >> 2) & 3u))); }
__device__ __forceinline__ unsigned offr(unsigned row, unsigned ch) { return 128u * row + 16u * (ch ^ (row & 7u)); }
__device__ __forceinline__ s16x8 tr_frag(const LAS unsigned char* img, int lane, int cb, int ks) {
    const unsigned g = lane >> 4, q = (lane & 15) >> 2, pp = lane & 3;
    const unsigned a0 = offb(32 * ks + 8 * g + q, 2 * cb + (pp >> 1)) + 8 * (pp & 1), a1 = offb(32 * ks + 8 * g + 4 + q, 2 * cb + (pp >> 1)) + 8 * (pp & 1);
    const s16x4 lo = __builtin_amdgcn_ds_read_tr16_b64_v4i16((LAS s16x4*)(img + a0)), hi = __builtin_amdgcn_ds_read_tr16_b64_v4i16((LAS s16x4*)(img + a1));
    return __builtin_shufflevector(lo, hi, 0, 1, 2, 3, 4, 5, 6, 7);
}
__device__ __forceinline__ s16x8 row_frag(const LAS unsigned char* img, int lane, int rb, int ks) {
    return *(const LAS s16x8*)(img + offr(16 * rb + (lane & 15), 4 * ks + (lane >> 4)));
}
__device__ __forceinline__ void gla_pass_a(const Args& a, const Ctx& c) {
    const bf16_t* P = (const bf16_t*)(a.ws + WS_PROJ); const float* ALR = (const float*)(a.ws + WS_ALR);
    float* BC = (float*)(a.ws + WS_BC); bf16_t* DELTA = (bf16_t*)(a.ws + WS_DELTA); float* DEC = (float*)(a.ws + WS_DEC);
    LAS float* ALRl = (LAS float*)c.lds; LAS float* TOT = (LAS float*)(c.lds + 4096);
    LAS unsigned char* KT = c.lds + 8192; LAS unsigned char* VI = c.lds + 16384; LAS bf16_t* Kl = (LAS bf16_t*)(c.lds + 32768);
    const int w = c.wave, d = c.lane;
    const int hh = (c.bid >> 5) & 3;
    float wal[16];
#pragma unroll
    for (int j = 0; j < 16; ++j) wal[j] = a.in[I_WALPHA][j * 256 + hh * 64 + d];
    const float bal = a.in[I_BALPHA][hh * 64 + d];
    f32x4 pa = (f32x4){0.f, 0.f, 0.f, 0.f}; v4u pv[2], pkt;
#define GLA_A_PREFETCH(u_) do { const int b_ = (u_) >> 7, h_ = ((u_) >> 5) & 3, ch_ = (u_) & 31; const size_t r_ = (size_t)b_ * NT + ch_ * 64; \
        if (c.tid < 256) pa = *(const f32x4*)(ALR + (r_ + (c.tid >> 2)) * 16 + (c.tid & 3) * 4); \
        _Pragma("unroll") for (int i = 0; i < 2; ++i) { const int idx = c.tid + 512 * i; pv[i] = *(const v4u*)(P + (r_ + (idx >> 4)) * NPROJ + PV + h_ * 128 + 8 * (idx & 15)); } \
        pkt = *(const v4u*)(P + (r_ + (c.tid >> 3)) * NPROJ + PK + h_ * 64 + 8 * (c.tid & 7)); } while (0)
    if (c.bid < NB * GH * 32) GLA_A_PREFETCH(c.bid);
    for (int unit = c.bid; unit < NB * GH * 32; unit += c.G) {
        const int b = unit >> 7, h = (unit >> 5) & 3, ch = unit & 31; const size_t r0 = (size_t)b * NT + ch * 64;
        if (c.tid < 256) *(LAS f32x4*)(ALRl + (c.tid >> 2) * 16 + (c.tid & 3) * 4) = pa;
#pragma unroll
        for (int i = 0; i < 2; ++i) { const int idx = c.tid + 512 * i; *(LAS v4u*)(VI + offb(idx >> 4, idx & 15)) = pv[i]; }
        *(LAS v4u*)(Kl + (c.tid >> 3) * 64 + 8 * (c.tid & 7)) = pkt;
        __syncthreads();
        if (unit + c.G < NB * GH * 32) GLA_A_PREFETCH(unit + c.G);
        float loc[8]; float run = 0.f;
#pragma unroll
        for (int tt = 0; tt < 8; ++tt) { const int t = 8 * w + tt; float z = bal;
#pragma unroll
            for (int q = 0; q < 4; ++q) { const f32x4 x = *(const LAS f32x4*)(ALRl + t * 16 + 4 * q); z += x.x * wal[4 * q] + x.y * wal[4 * q + 1] + x.z * wal[4 * q + 2] + x.w * wal[4 * q + 3]; }
            run += logsigmoidf_(z) * (1.f / 16.f); loc[tt] = run; }
        TOT[w * 64 + d] = run;
        __syncthreads();
        float pre = 0.f, total = 0.f;
#pragma unroll
        for (int w2 = 0; w2 < 8; ++w2) { const float x = TOT[w2 * 64 + d]; total += x; pre += (w2 < w) ? x : 0.f; }
        float kte[8];
#pragma unroll
        for (int tt = 0; tt < 8; ++tt) { const int t = 8 * w + tt; const float bb = loc[tt] + pre;
            BC[(r0 + t) * 256 + h * 64 + d] = bb;
            kte[tt] = bf2f(Kl[t * 64 + d]) * __expf(total - bb); }
        { v4u o; o.x = pk2(kte[0], kte[1]); o.y = pk2(kte[2], kte[3]); o.z = pk2(kte[4], kte[5]); o.w = pk2(kte[6], kte[7]);
            *(LAS v4u*)(KT + offr(d, w)) = o; }
        if (w == 0) DEC[unit * 64 + d] = __expf(total);
        __syncthreads();
        { const int db = w >> 1, vb0 = 4 * (w & 1);
            f32x4 acc[4];
#pragma unroll
            for (int i = 0; i < 4; ++i) acc[i] = (f32x4){0.f, 0.f, 0.f, 0.f};
#pragma unroll
            for (int ks = 0; ks < 2; ++ks) { const s16x8 af = row_frag(KT, c.lane, db, ks);
#pragma unroll
                for (int i = 0; i < 4; ++i) { const s16x8 bf = tr_frag(VI, c.lane, vb0 + i, ks); acc[i] = __builtin_amdgcn_mfma_f32_16x16x32_bf16(af, bf, acc[i], 0, 0, 0); } }
            __syncthreads();
            LAS bf16_t* DT = (LAS bf16_t*)VI;
#pragma unroll
            for (int i = 0; i < 4; ++i)
#pragma unroll
                for (int r = 0; r < 4; ++r) DT[(16 * db + 4 * (c.lane >> 4) + r) * 128 + 16 * (vb0 + i) + (c.lane & 15)] = (bf16_t)f2bf(acc[i][r]); }
        __syncthreads();
        { const int row = c.tid >> 3, seg = c.tid & 7;
            const LAS v4u* src = (const LAS v4u*)(VI + row * 256 + seg * 32);
            v4u* dst = (v4u*)(DELTA + (size_t)unit * 8192 + row * 128 + seg * 16);
            dst[0] = src[0]; dst[1] = src[1]; }
        __syncthreads();
    }
#undef GLA_A_PREFETCH
}
__device__ __forceinline__ void gla_pass_b(const Args& a, const Ctx& c) {
    const unsigned* DELTA = (const unsigned*)(a.ws + WS_DELTA); const float* DEC = (const float*)(a.ws + WS_DEC); unsigned* SP = (unsigned*)(a.ws + WS_SPREV);
    for (int e = c.gtid; e < NB * GH * 4096; e += c.ngt) { const int bh = __builtin_amdgcn_readfirstlane(e >> 12), d = __builtin_amdgcn_readfirstlane((e >> 6) & 63), vp = e & 63;
        float s0 = 0.f, s1 = 0.f;
        unsigned dw[32]; float dc[32];
#pragma unroll
        for (int j = 0; j < 32; ++j) { const size_t unit = (size_t)bh * 32 + j; dw[j] = DELTA[unit * 4096 + d * 64 + vp]; dc[j] = DEC[unit * 64 + d]; }
#pragma unroll
        for (int j = 0; j < 32; ++j) { const size_t unit = (size_t)bh * 32 + j; SP[unit * 4096 + d * 64 + vp] = pk2(s0, s1); s0 = dc[j] * s0 + bf2f(dw[j] & 0xffffu); s1 = dc[j] * s1 + bf2f(dw[j] >> 16); }
    }
}
__device__ __forceinline__ void gla_pass_c(const Args& a, const Ctx& c) {
    const bf16_t* P = (const bf16_t*)(a.ws + WS_PROJ); const float* BC = (const float*)(a.ws + WS_BC); const bf16_t* SPV = (const bf16_t*)(a.ws + WS_SPREV);
    bf16_t* MI = (bf16_t*)(a.ws + WS_MIXIN);
    LAS unsigned char* VI = c.lds; LAS unsigned char* SI = c.lds + 16384; LAS unsigned char* QD = c.lds + 32768; LAS unsigned char* KI = c.lds + 40960; LAS unsigned char* PI = c.lds + 49152;
    LAS float* OI = (LAS float*)(c.lds + 57344);
    const int w = c.wave, lane = c.lane, g = lane >> 4, cl = lane & 15;
    v4u pv[2], psv[2], pq, pk; f32x4 pb0, pb1;
#define GLA_C_PREFETCH(u_) do { const int b_ = (u_) >> 7, h_ = ((u_) >> 5) & 3, ch_ = (u_) & 31; const size_t r_ = (size_t)b_ * NT + ch_ * 64; \
        _Pragma("unroll") for (int i = 0; i < 2; ++i) { const int idx = c.tid + 512 * i, row = idx >> 4, cc = idx & 15; \
            pv[i] = *(const v4u*)(P + (r_ + row) * NPROJ + PV + h_ * 128 + 8 * cc); psv[i] = *(const v4u*)(SPV + (size_t)(u_) * 8192 + row * 128 + 8 * cc); } \
        { const int t = c.tid >> 3, cc = c.tid & 7; pq = *(const v4u*)(P + (r_ + t) * NPROJ + PQ + h_ * 64 + 8 * cc); pk = *(const v4u*)(P + (r_ + t) * NPROJ + PK + h_ * 64 + 8 * cc); \
            pb0 = *(const f32x4*)(BC + (r_ + t) * 256 + h_ * 64 + 8 * cc); pb1 = *(const f32x4*)(BC + (r_ + t) * 256 + h_ * 64 + 8 * cc + 4); } } while (0)
    if (c.bid < NB * GH * 32) GLA_C_PREFETCH(c.bid);
    for (int unit = c.bid; unit < NB * GH * 32; unit += c.G) {
        const int b = unit >> 7, h = (unit >> 5) & 3, ch = unit & 31; const size_t r0 = (size_t)b * NT + ch * 64;
#pragma unroll
        for (int i = 0; i < 2; ++i) { const int idx = c.tid + 512 * i, row = idx >> 4, cc = idx & 15;
            *(LAS v4u*)(VI + offb(row, cc)) = pv[i];
            *(LAS v4u*)(SI + offb(row, cc)) = psv[i]; }
        { const int t = c.tid >> 3, cc = c.tid & 7;
            const v4u q8 = pq, k8 = pk; const f32x4 b0 = pb0, b1 = pb1;
            const float bb[8] = {b0.x, b0.y, b0.z, b0.w, b1.x, b1.y, b1.z, b1.w};
            const unsigned qw[4] = {q8.x, q8.y, q8.z, q8.w}, kw[4] = {k8.x, k8.y, k8.z, k8.w};
            unsigned qo[4], ko[4];
#pragma unroll
            for (int j = 0; j < 4; ++j) { const float e0 = __expf(bb[2 * j]), e1 = __expf(bb[2 * j + 1]);
                qo[j] = pk2(bf2f(qw[j] & 0xffffu) * 0.125f * e0, bf2f(qw[j] >> 16) * 0.125f * e1);
                ko[j] = pk2(bf2f(kw[j] & 0xffffu) * __builtin_amdgcn_rcpf(e0), bf2f(kw[j] >> 16) * __builtin_amdgcn_rcpf(e1)); }
            *(LAS v4u*)(QD + offr(t, cc)) = (v4u){qo[0], qo[1], qo[2], qo[3]};
            *(LAS v4u*)(KI + offr(t, cc)) = (v4u){ko[0], ko[1], ko[2], ko[3]}; }
        v4u og0, og1; { const bf16_t* ogp = P + (r0 + (c.tid >> 3)) * NPROJ + PG + h * 128 + 16 * (c.tid & 7); og0 = *(const v4u*)ogp; og1 = *(const v4u*)(ogp + 8); }
        __syncthreads();
        if (unit + c.G < NB * GH * 32) GLA_C_PREFETCH(unit + c.G);
        { const int ib = w >> 1;
#pragma unroll
            for (int jj = 0; jj < 2; ++jj) { const int jb = 2 * (w & 1) + jj; f32x4 sc = (f32x4){0.f, 0.f, 0.f, 0.f};
                if (jb <= ib) {
#pragma unroll
                    for (int ks = 0; ks < 2; ++ks) sc = __builtin_amdgcn_mfma_f32_16x16x32_bf16(row_frag(QD, lane, ib, ks), row_frag(KI, lane, jb, ks), sc, 0, 0, 0); }
#pragma unroll
                for (int r = 0; r < 4; ++r) { const int i = 16 * ib + 4 * g + r, j = 16 * jb + cl; const float v = (j <= i) ? sc[r] : 0.f;
                    *(LAS bf16_t*)(PI + offr(i, j >> 3) + 2 * (j & 7)) = (bf16_t)f2bf(v); } } }
        __syncthreads();
        { const int ib = w >> 1, vb0 = 4 * (w & 1);
            f32x4 acc[4];
#pragma unroll
            for (int i = 0; i < 4; ++i) acc[i] = (f32x4){0.f, 0.f, 0.f, 0.f};
#pragma unroll
            for (int ks = 0; ks < 2; ++ks) { const s16x8 ap = row_frag(PI, lane, ib, ks), aq = row_frag(QD, lane, ib, ks);
#pragma unroll
                for (int i = 0; i < 4; ++i) { acc[i] = __builtin_amdgcn_mfma_f32_16x16x32_bf16(ap, tr_frag(VI, lane, vb0 + i, ks), acc[i], 0, 0, 0);
                    acc[i] = __builtin_amdgcn_mfma_f32_16x16x32_bf16(aq, tr_frag(SI, lane, vb0 + i, ks), acc[i], 0, 0, 0); } }
#pragma unroll
            for (int i = 0; i < 4; ++i)
#pragma unroll
                for (int r = 0; r < 4; ++r) OI[(16 * ib + 4 * g + r) * 132 + 16 * (vb0 + i) + cl] = acc[i][r]; }
        __syncthreads();
        { const int t = c.tid >> 3, part = c.tid & 7; float o[16]; float ss = 0.f;
#pragma unroll
            for (int q = 0; q < 4; ++q) { const f32x4 x = *(const LAS f32x4*)(OI + t * 132 + 16 * part + 4 * q); o[4 * q] = x.x; o[4 * q + 1] = x.y; o[4 * q + 2] = x.z; o[4 * q + 3] = x.w;
                ss += (x.x * x.x + x.y * x.y) + (x.z * x.z + x.w * x.w); }
            ss += __shfl_xor(ss, 1); ss += __shfl_xor(ss, 2); ss += __shfl_xor(ss, 4);
            const float rstd = rsqrtf(ss * (1.f / 128.f) + EPS);
            const v4u g0 = og0, g1 = og1;
            const unsigned gw[8] = {g0.x, g0.y, g0.z, g0.w, g1.x, g1.y, g1.z, g1.w};
            unsigned ow[8];
#pragma unroll
            for (int j = 0; j < 8; ++j) { const float ga = bf2f(gw[j] & 0xffffu), gb = bf2f(gw[j] >> 16);
                const float n0 = a.in[I_GLANORM][16 * part + 2 * j], n1 = a.in[I_GLANORM][16 * part + 2 * j + 1];
                ow[j] = pk2(o[2 * j] * rstd * n0 * (ga * sigmoidf_(ga)), o[2 * j + 1] * rstd * n1 * (gb * sigmoidf_(gb))); }
            bf16_t* dst = MI + (r0 + t) * D + h * 128 + 16 * part;
            *(v4u*)dst = (v4u){ow[0], ow[1], ow[2], ow[3]}; *(v4u*)(dst + 8) = (v4u){ow[4], ow[5], ow[6], ow[7]}; }
    }
    __syncthreads();
#undef GLA_C_PREFETCH
}

constexpr int RT_PITCH = 2064, RT_LO = 16 * RT_PITCH, RT_PART = 2 * RT_LO;
__device__ __forceinline__ void ph8_norm2_router(const Args& a, const Ctx& c) {
    const float* mod = (const float*)(a.ws + WS_MOD);
    const bf16_t* MX = (const bf16_t*)(a.ws + WS_MIX);
    bf16_t* HN = (bf16_t*)(a.ws + WS_HN); bf16_t* H1B = (bf16_t*)(a.ws + WS_H1);
    unsigned* cnt = (unsigned*)(a.ws + WS_CTL) + CW_CNT;
    int* RE = (int*)(a.ws + WS_ROUTE_E); float* RW = (float*)(a.ws + WS_ROUTE_W); int* LIST = (int*)(a.ws + WS_LIST);
    s16x8 rwh[4][2], rwl[4][2];
#pragma unroll
    for (int ks = 0; ks < 4; ++ks)
#pragma unroll
        for (int cb = 0; cb < 2; ++cb) { float wv[8];
#pragma unroll
            for (int j = 0; j < 8; ++j) wv[j] = a.in[I_RW][(size_t)(128 * c.wave + 32 * ks + 8 * (c.lane >> 4) + j) * 32 + 16 * cb + (c.lane & 15)];
            unsigned hh[4], ll[4];
#pragma unroll
            for (int j = 0; j < 4; ++j) { hh[j] = pk2(wv[2 * j], wv[2 * j + 1]); ll[j] = pk2(wv[2 * j] - bf2f(hh[j] & 0xffffu), wv[2 * j + 1] - bf2f(hh[j] >> 16)); }
            rwh[ks][cb] = __builtin_bit_cast(s16x8, (v4u){hh[0], hh[1], hh[2], hh[3]}); rwl[ks][cb] = __builtin_bit_cast(s16x8, (v4u){ll[0], ll[1], ll[2], ll[3]}); }
    LAS unsigned* lcnt = (LAS unsigned*)(c.lds + 131072);
    LAS unsigned* lent = (LAS unsigned*)(c.lds + 131072 + 512);
    if (c.tid < 128) lcnt[c.tid] = 0u;
    __syncthreads();
#pragma unroll 1
    for (int it = 0; it < 4; ++it) { const int row0 = 2 * c.gw + 2 * c.ngw * it;
        const int b = row0 / NT;
        f32x4 y[2][4];
        v2u mwb[1][2][4]; f32x4 xvb[1][2][4]; constexpr int cbuf = 0;
#pragma unroll
        for (int r = 0; r < 2; ++r)
#pragma unroll
            for (int j = 0; j < 4; ++j) { const int col = 4 * c.lane + 256 * j; mwb[0][r][j] = __builtin_nontemporal_load((const v2u*)(MX + (size_t)(row0 + r) * D + col));
                xvb[0][r][j] = __builtin_nontemporal_load((const f32x4*)(a.in[I_X] + (size_t)(row0 + r) * D + col)); }
        f32x4 gmv[4], g1v[4], gfv[4], shv[4], scv[4];
#pragma unroll
        for (int j = 0; j < 4; ++j) { const int col = 4 * c.lane + 256 * j; gmv[j] = *(const f32x4*)(a.in[I_MIXPOST] + col); g1v[j] = *(const f32x4*)(mod + b * 6144 + 2048 + col);
            gfv[j] = *(const f32x4*)(a.in[I_FFNPRE] + col); shv[j] = *(const f32x4*)(mod + b * 6144 + 3072 + col); scv[j] = *(const f32x4*)(mod + b * 6144 + 4096 + col) + 1.f; }
#pragma unroll
        for (int r = 0; r < 2; ++r) { const int row = row0 + r;
            f32x4 m[4]; float ss = 0.f;
#pragma unroll
            for (int j = 0; j < 4; ++j) { const v2u w = mwb[cbuf][r][j];
                m[j] = (f32x4){bf2f(w.x & 0xffffu), bf2f(w.x >> 16), bf2f(w.y & 0xffffu), bf2f(w.y >> 16)};
                ss += (m[j].x * m[j].x + m[j].y * m[j].y) + (m[j].z * m[j].z + m[j].w * m[j].w); }
            const float rstd = rsqrtf(wave_sum(ss) * (1.f / D) + EPS);
            float s2 = 0.f;
#pragma unroll
            for (int j = 0; j < 4; ++j) { const int col = 4 * c.lane + 256 * j;
                m[j] = xvb[cbuf][r][j] + g1v[j] * (m[j] * rstd * gmv[j]);
                { v2u o; o.x = pk2(m[j].x, m[j].y); o.y = pk2(m[j].z, m[j].w); *(v2u*)(H1B + (size_t)row * D + col) = o; }
                s2 += (m[j].x * m[j].x + m[j].y * m[j].y) + (m[j].z * m[j].z + m[j].w * m[j].w); }
            const float rstd2 = rsqrtf(wave_sum(s2) * (1.f / D) + EPS);
#pragma unroll
            for (int j = 0; j < 4; ++j) { const int col = 4 * c.lane + 256 * j;
                y[r][j] = m[j] * rstd2 * gfv[j] * scv[j] + shv[j];
                *(unsigned*)((unsigned char*)HN + (size_t)row * D + col) = pk4_fp8(y[r][j].x, y[r][j].y, y[r][j].z, y[r][j].w); } }
#pragma unroll
        for (int r = 0; r < 2; ++r)
#pragma unroll
            for (int j = 0; j < 4; ++j) { const f32x4 v = y[r][j];
                const unsigned h0 = pk2(v.x, v.y), h1 = pk2(v.z, v.w);
                const unsigned l0 = pk2(v.x - bf2f(h0 & 0xffffu), v.y - bf2f(h0 >> 16)), l1 = pk2(v.z - bf2f(h1 & 0xffffu), v.w - bf2f(h1 >> 16));
                const int off = (2 * c.wave + r) * RT_PITCH + (4 * c.lane + 256 * j) * 2;
                *(LAS v2u*)(c.lds + off) = (v2u){h0, h1}; *(LAS v2u*)(c.lds + RT_LO + off) = (v2u){l0, l1}; }
        __syncthreads();
        { f32x4 pacc[2] = {(f32x4){0.f, 0.f, 0.f, 0.f}, (f32x4){0.f, 0.f, 0.f, 0.f}};
#pragma unroll
            for (int ks = 0; ks < 4; ++ks) { const int aoff = (c.lane & 15) * RT_PITCH + (128 * c.wave + 32 * ks + 8 * (c.lane >> 4)) * 2;
                const s16x8 ahi = *(const LAS s16x8*)(c.lds + aoff), alo = *(const LAS s16x8*)(c.lds + RT_LO + aoff);
#pragma unroll
                for (int cb = 0; cb < 2; ++cb) { pacc[cb] = __builtin_amdgcn_mfma_f32_16x16x32_bf16(ahi, rwh[ks][cb], pacc[cb], 0, 0, 0);
                    pacc[cb] = __builtin_amdgcn_mfma_f32_16x16x32_bf16(ahi, rwl[ks][cb], pacc[cb], 0, 0, 0);
                    pacc[cb] = __builtin_amdgcn_mfma_f32_16x16x32_bf16(alo, rwh[ks][cb], pacc[cb], 0, 0, 0); } }
            LAS float* part = (LAS float*)(c.lds + RT_PART) + c.wave * 512;
#pragma unroll
            for (int cb = 0; cb < 2; ++cb)
#pragma unroll
                for (int r = 0; r < 4; ++r) part[(4 * (c.lane >> 4) + r) * 32 + 16 * cb + (c.lane & 15)] = pacc[cb][r]; }
        __syncthreads();
        const int e = c.lane & 31, row = row0 + (c.lane >> 5), l4 = c.lane & 31;
        float val = a.in[I_RB][e];
#pragma unroll
        for (int w2 = 0; w2 < 8; ++w2) val += ((const LAS float*)(c.lds + RT_PART))[w2 * 512 + (c.tid >> 5) * 32 + e];
        int sel_e[4]; float sel_v[4];
#pragma unroll
        for (int k = 0; k < 4; ++k) { float mx = val;
#pragma unroll
            for (int o = 1; o < 32; o <<= 1) mx = fmaxf(mx, __shfl_xor(mx, o));
            const unsigned long long bal = __ballot(val == mx);
            const unsigned half = (unsigned)(c.lane >> 5 ? (bal >> 32) : (bal & 0xffffffffull));
            const int idx = __ffs((int)half) - 1;
            sel_e[k] = idx; sel_v[k] = mx; if (e == idx) val = -3.0e38f; }
        const float e0 = 1.f, e1 = __expf(sel_v[1] - sel_v[0]), e2 = __expf(sel_v[2] - sel_v[0]), e3 = __expf(sel_v[3] - sel_v[0]);
        const float inv = 1.f / (e0 + e1 + e2 + e3);
        if (l4 < 4) { const int ee = l4 == 0 ? sel_e[0] : l4 == 1 ? sel_e[1] : l4 == 2 ? sel_e[2] : sel_e[3];
            const float wv = (l4 == 0 ? e0 : l4 == 1 ? e1 : l4 == 2 ? e2 : e3) * inv;
            const unsigned ls = __hip_atomic_fetch_add((LAS unsigned*)lcnt + ee, 1u, __ATOMIC_RELAXED, __HIP_MEMORY_SCOPE_WORKGROUP);
            const unsigned en = __hip_atomic_fetch_add((LAS unsigned*)lcnt + 32, 1u, __ATOMIC_RELAXED, __HIP_MEMORY_SCOPE_WORKGROUP);
            lent[en & 511u] = (unsigned)row * 4u + (unsigned)l4; lent[512 + (en & 511u)] = (unsigned)ee | (ls << 8); RW[row * 4 + l4] = wv; }
    }
    __syncthreads();
    if (c.tid < 32) lcnt[64 + c.tid] = atomicAdd(cnt + c.tid * 64, lcnt[c.tid]);
    __syncthreads();
    { const unsigned nent = lcnt[32];
        for (unsigned t = c.tid; t < nent; t += NTHR) { const unsigned rk = lent[t], es = lent[512 + t], ee = es & 255u, slot = lcnt[64 + ee] + (es >> 8);
            RE[rk] = (int)(ee | (slot << 8)); LIST[ee * LISTCAP + slot] = (int)(rk >> 2); } }
    __syncthreads();
}

__device__ __forceinline__ void build_pstart(const Args& a, const Ctx& c, LAS int* ps, LAS int* cn) {
    if (c.tid < 64) {
        const unsigned* cnt = (const unsigned*)(a.ws + WS_CTL) + CW_CNT;
        const int n = c.tid < NE ? (int)__hip_atomic_load(cnt + c.tid * 64, __ATOMIC_RELAXED, __HIP_MEMORY_SCOPE_AGENT) : 0;
        const int pad = ((n + 255) >> 8) << 8; int inc = pad;
#pragma unroll
        for (int o = 1; o < 32; o <<= 1) { const int t = __shfl_up(inc, o); if (c.tid >= o) inc += t; }
        if (c.tid < NE) { ps[c.tid] = inc - pad; cn[c.tid] = n; }
        if (c.tid == NE - 1) ps[NE] = inc; }
    __syncthreads();
}
template <bool GATHER> __device__ __forceinline__ void exp_tables(const Args& a, const Ctx& c, pg8::ExpSched& S) {
    LAS int* ps = (LAS int*)(c.lds + pg8::XT_PS); LAS int* cn = ps + 33; LAS unsigned char* te = (LAS unsigned char*)(c.lds + pg8::XT_PS + 260);
    build_pstart(a, c, ps, cn);
    const int nT = ps[NE] >> 8;
    for (int t = c.tid; t < nT; t += NTHR) { int e = 0; for (int q = 1; q < NE; ++q) e = (t * 256 >= ps[q]) ? q : e; te[t] = (unsigned char)e; }
    __syncthreads();
    S.nT = nT; S.lds = c.lds; S.G = c.G; S.c = c.bid; S.ident = GATHER ? 0 : 1;
    { const int* LIST = (const int*)(a.ws + WS_LIST); LAS unsigned short* tk = (LAS unsigned short*)(c.lds + pg8::XT_TOK); LAS float* bt = (LAS float*)(c.lds + pg8::XT_BIAS);
        constexpr int MAXU = 10;
        int tokv[MAXU]; float biasv[MAXU];
        if (c.tid < 256) {
#pragma unroll
            for (int i = 0; i < MAXU; ++i) { pg8::Unit u; const bool ok = S.next(i, u); tokv[i] = 0; biasv[i] = 0.f;
                if (ok) { if (GATHER) { const int slot = u.pm * 256 - ps[u.e] + c.tid; if (slot < cn[u.e]) tokv[i] = LIST[u.e * LISTCAP + slot];
                        biasv[i] = a.in[I_BGU][u.e * 2048 + (c.tid >> 7) * 1024 + u.pn * 128 + (c.tid & 127)]; }
                    else biasv[i] = a.in[I_BDN][u.e * 1024 + u.pn * 256 + c.tid]; } }
#pragma unroll
            for (int i = 0; i < MAXU; ++i) { if (GATHER) tk[i * 256 + c.tid] = (unsigned short)tokv[i]; bt[i * 256 + c.tid] = biasv[i]; }
            if (!GATHER) tk[c.tid] = (unsigned short)c.tid; }
        __syncthreads(); }
}
__device__ __forceinline__ void ph10_exp1(const Args& a, const Ctx& c) {
    pg8::ExpSched S; S.A = (const char*)(a.ws + WS_HN); S.W = (const char*)(a.ws + WS_GU_T); S.nN = 8; S.ldaB = D; S.ldbB = D; S.estride = 2048u * 1024u;
    exp_tables<true>(a, c, S);
    pg8::EpiSwiglu E{(unsigned char*)(a.ws + WS_HACT), (const LAS float*)(c.lds + pg8::XT_BIAS)};
    pg8::gemm_phase<pg8::EpiSwiglu, pg8::ExpSched, true, true>(c.lds, D / 128, S, E);
}
__device__ __forceinline__ void ph11_exp2(const Args& a, const Ctx& c) {
    pg8::ExpSched S; S.A = (const char*)(a.ws + WS_HACT); S.W = (const char*)(a.ws + WS_DN_T); S.nN = 4; S.ldaB = DFF; S.ldbB = DFF; S.estride = 1024u * 1024u;
    exp_tables<false>(a, c, S);
    pg8::EpiDown E{(unsigned char*)(a.ws + WS_YEXP), (const LAS float*)(c.lds + pg8::XT_BIAS)};
    pg8::gemm_phase<pg8::EpiDown, pg8::ExpSched, true, true, true, true>(c.lds, DFF / 128, S, E);
}

__device__ __forceinline__ f32x4 fp8x4_to_f32(unsigned w) { const f32x2_t lo = __builtin_amdgcn_cvt_pk_f32_fp8((int)w, false), hi = __builtin_amdgcn_cvt_pk_f32_fp8((int)w, true); return (f32x4){lo.x, lo.y, hi.x, hi.y}; }
__device__ __forceinline__ void ph12_final(const Args& a, const Ctx& c) {
    LAS int* ps = (LAS int*)c.lds; LAS int* cn = ps + 64;
    build_pstart(a, c, ps, cn);
    const float* mod = (const float*)(a.ws + WS_MOD);
    const unsigned char* YE = (const unsigned char*)(a.ws + WS_YEXP); const bf16_t* H1B = (const bf16_t*)(a.ws + WS_H1);
    const int* RE = (const int*)(a.ws + WS_ROUTE_E); const float* RW = (const float*)(a.ws + WS_ROUTE_W);
    int4 reA[4][2]; f32x4 rwA[4][2];
#pragma unroll
    for (int it = 0; it < 4; ++it)
#pragma unroll
        for (int r = 0; r < 2; ++r) { const int row = 2 * c.gw + 2 * c.ngw * it + r; const int rc = row < NTOK ? row : 0;
            reA[it][r] = *(const int4*)(RE + rc * 4); rwA[it][r] = *(const f32x4*)(RW + rc * 4); }
#pragma unroll
    for (int it = 0; it < 4; ++it) { const int row0 = 2 * c.gw + 2 * c.ngw * it; if (row0 >= NTOK) break;
        const int b = row0 / NT;
        int4 re[2]; f32x4 rw[2];
#pragma unroll
        for (int r = 0; r < 2; ++r) { re[r] = reA[it][r]; rw[r] = rwA[it][r]; }
        v2u hw[2][4];
#pragma unroll
        for (int r = 0; r < 2; ++r)
#pragma unroll
            for (int j = 0; j < 4; ++j) hw[r][j] = __builtin_nontemporal_load((const v2u*)(H1B + (size_t)(row0 + r) * D + 4 * c.lane + 256 * j));
        f32x4 f[2][4];
#pragma unroll
        for (int r = 0; r < 2; ++r) { const int rr[4] = {re[r].x, re[r].y, re[r].z, re[r].w}; const float ww[4] = {rw[r].x, rw[r].y, rw[r].z, rw[r].w};
            unsigned yw[4][4];
#pragma unroll
            for (int k = 0; k < 4; ++k) { const size_t pos = (size_t)(ps[rr[k] & 255] + (rr[k] >> 8));
#pragma unroll
                for (int j = 0; j < 4; ++j) yw[k][j] = __builtin_nontemporal_load((const unsigned*)(YE + pos * D + 4 * c.lane + 256 * j)); }
#pragma unroll
            for (int j = 0; j < 4; ++j) { f[r][j] = fp8x4_to_f32(yw[0][j]) * ww[0];
#pragma unroll
                for (int k = 1; k < 4; ++k) f[r][j] += fp8x4_to_f32(yw[k][j]) * ww[k]; } }
        f32x4 gfv[4], g2v[4];
#pragma unroll
        for (int j = 0; j < 4; ++j) { const int col = 4 * c.lane + 256 * j; gfv[j] = *(const f32x4*)(a.in[I_FFNPOST] + col); g2v[j] = *(const f32x4*)(mod + b * 6144 + 5120 + col); }
#pragma unroll
        for (int r = 0; r < 2; ++r) { float sf = 0.f;
#pragma unroll
            for (int j = 0; j < 4; ++j) sf += (f[r][j].x * f[r][j].x + f[r][j].y * f[r][j].y) + (f[r][j].z * f[r][j].z + f[r][j].w * f[r][j].w);
            const float rf = rsqrtf(wave_sum(sf) * (1.f / (D * Y8_SCALE * Y8_SCALE)) + EPS) * (1.f / Y8_SCALE);
#pragma unroll
            for (int j = 0; j < 4; ++j) { const int col = 4 * c.lane + 256 * j;
                const f32x4 gf = gfv[j], g2 = g2v[j];
                const f32x4 h = (f32x4){bf2f(hw[r][j].x & 0xffffu), bf2f(hw[r][j].x >> 16), bf2f(hw[r][j].y & 0xffffu), bf2f(hw[r][j].y >> 16)};
                __builtin_nontemporal_store(h + g2 * (f[r][j] * rf * gf), (f32x4*)(a.out + (size_t)(row0 + r) * D + col)); } }
    }
}

constexpr int NPHASE = 13;
__global__ void __launch_bounds__(NTHR, 2) mk_fwd(Args a) {
    extern __shared__ __attribute__((aligned(16))) unsigned char lds_raw[];
    Ctx c;
    c.lds = (LAS unsigned char*)lds_raw;
    c.tid = threadIdx.x; c.lane = c.tid & 63; c.wave = __builtin_amdgcn_readfirstlane(c.tid >> 6);
    c.bid = blockIdx.x; c.G = gridDim.x; c.gw = c.bid * NWAVES + c.wave; c.ngw = c.G * NWAVES; c.gtid = c.bid * NTHR + c.tid; c.ngt = c.G * NTHR;
    volatile LAS unsigned* MISC = (volatile LAS unsigned*)(c.lds + MISC_OFF);
    if (c.tid < 32) MISC[c.tid] = 0u;
    __syncthreads();
    const bool one = (a.ph_hi - a.ph_lo) > 1;
    XcdBarrier bar; bar.bar = (unsigned*)(a.ws + WS_CTL) + CW_BAR; bar.x = 0; bar.st = MISC + 8;
    if (one) bar = xcd_barrier_post((unsigned*)(a.ws + WS_CTL) + CW_BAR, MISC + 8);
    const int lo = a.ph_lo, hi = a.ph_hi;
#define IN(k) (lo <= (k) && (k) < hi)
#define SEAM(k) do { if (IN(k) && IN((k) + 1)) { if ((k) <= 8) xcd_barrier_conv(bar, a, c, (k)); else xcd_barrier(bar); } else __syncthreads(); } while (0)
    if (IN(0)) { ph0_prologue(a, c); SEAM(0); }
    if (IN(1)) { ph1_norm1(a, c); s5_build_mats(a, c); SEAM(1); }
    if (IN(2)) { ph2_gemm1(a, c); SEAM(2); }
    if (IN(3)) { gla_pass_a(a, c); s5_dx_gemm(a, c);
        if (c.bid < 128) { for (int wi = WI_P3 + c.bid * 8 + c.wave; wi < WI_P5; wi += 1024) wconv_item(a, c.lds + c.wave * 5120, wi, c.lane); __syncthreads(); }
        SEAM(3); }
    if (IN(4)) { gla_pass_b(a, c); s5_scan(a, c); SEAM(4); }
    if (IN(5)) { gla_pass_c(a, c); s5_y_gemm(a, c);
        if (c.bid < 128) { for (int wi = WI_P5 + c.bid * 8 + c.wave; wi < WI_P6; wi += 1024) wconv_item(a, c.lds + c.wave * 5120, wi, c.lane); __syncthreads(); }
        SEAM(5); }
    if (IN(6)) { ph6_glu(a, c);
        if (c.bid >= 128) { for (int wi = WI_P6 + (c.bid - 128) * 8 + c.wave; wi < WI_END; wi += 1024) wconv_item(a, c.lds + c.wave * 5120, wi, c.lane); __syncthreads(); }
        SEAM(6); }
    if (IN(7)) { ph7_wout(a, c); SEAM(7); }
    if (IN(8)) { ph8_norm2_router(a, c); if (IN(10)) xcd_barrier_conv(bar, a, c, 8); else __syncthreads(); }
    if (IN(10)) { ph10_exp1(a, c); SEAM(10); }
    if (IN(11)) { ph11_exp2(a, c); SEAM(11); }
    if (IN(12)) { ph12_final(a, c); }
#undef IN
#undef SEAM
}

extern "C" void kernel_launch(void* const* d_in, const int* in_sizes, int n_in, void* d_out, int out_size, void* d_ws, size_t ws_size, hipStream_t stream) {
    static int grid = 0;
    if (grid == 0) {
        if (n_in != 29 || in_sizes[0] != NTOK * D || out_size != NTOK * D || ws_size < WS_END) {
            fprintf(stderr, "kernel_launch: unexpected shapes (n_in %d, in0 %d, out %d, ws %zu < %zu)\n", n_in, n_in > 0 ? in_sizes[0] : -1, out_size, ws_size, (size_t)WS_END); grid = -1; return; }
        int dev = 0, cus = 0, per_cu = 0;
        if (hipGetDevice(&dev) != hipSuccess || hipDeviceGetAttribute(&cus, hipDeviceAttributeMultiprocessorCount, dev) != hipSuccess) { grid = -1; return; }
        if (hipFuncSetAttribute((const void*)mk_fwd, hipFuncAttributeMaxDynamicSharedMemorySize, LDS_BYTES) != hipSuccess) { fprintf(stderr, "kernel_launch: hipFuncSetAttribute failed\n"); grid = -1; return; }
        if (hipOccupancyMaxActiveBlocksPerMultiprocessor(&per_cu, (const void*)mk_fwd, NTHR, LDS_BYTES) != hipSuccess || per_cu < 1)
            fprintf(stderr, "kernel_launch: occupancy query reports %d\n", per_cu);
        (void)hipGetLastError();
        grid = 256;
        if (cus != 256) fprintf(stderr, "kernel_launch: built for a 256-CU device, found %d CUs\n", cus);
    }
    if (grid < 0) return;
    (void)hipMemsetAsync((char*)d_ws + WS_CTL, 0, CTL_BYTES, stream);
    Args a{};
    for (int i = 0; i < 29; ++i) a.in[i] = (const float*)d_in[i];
    a.out = (float*)d_out; a.ws = (unsigned char*)d_ws;
    a.ph_lo = 0; a.ph_hi = NPHASE;
    hipLaunchKernelGGL(mk_fwd, dim3(grid), dim3(NTHR), LDS_BYTES, stream, a);
}
```

```cpp
#include <hip/hip_runtime.h>
#include <cstdio>
#include <cstdint>

#define LAS __attribute__((address_space(3)))
typedef unsigned short bf16_t;
typedef unsigned v4u __attribute__((ext_vector_type(4)));
typedef unsigned v2u __attribute__((ext_vector_type(2)));
typedef float f32x4 __attribute__((ext_vector_type(4)));
typedef __bf16 bf16x2 __attribute__((ext_vector_type(2)));
typedef short s16x4 __attribute__((ext_vector_type(4)));
typedef short s16x8 __attribute__((ext_vector_type(8)));

constexpr int NB = 8, NT = 2048, D = 1024, NTOK = NB * NT;
constexpr int NIN = 2064, NPROJ = 2048;
constexpr int GH = 4, DK = 64, DV = 128;
constexpr int SG = 32, SP = 64, SC = 16;
constexpr int NE = 32, DFF = 1024;
constexpr int LISTCAP = 16384, MAXROWS = 65536 + NE * 256;
constexpr float EPS = 1e-6f;
constexpr int PQ = 0, PK = 256, PV = 512, PG = 1024, PU = 1536;

constexpr size_t MiB = 1u << 20;
constexpr size_t WS_CTL = 0, CTL_BYTES = 64 * 1024;
constexpr size_t WS_MOD = 1 * MiB;
constexpr size_t WS_S5AB = 2 * MiB, WS_S5BB = 2 * MiB + 65536;
constexpr size_t WS_WIN_T = 3 * MiB, WS_GLU_T = 7 * MiB, WS_WOUT_T = 8 * MiB, WS_ALR = 10 * MiB;
constexpr size_t WS_ROUTE_E = 11 * MiB, WS_ROUTE_W = 11 * MiB + 512 * 1024, WS_LIST = 12 * MiB;
constexpr size_t WS_HN = 16 * MiB, WS_PROJ = 48 * MiB, WS_MIXIN = 112 * MiB, WS_Y5 = 144 * MiB, WS_MIX = 160 * MiB, WS_H1 = 192 * MiB;
constexpr size_t WS_DELTA = 256 * MiB, WS_SPREV = 288 * MiB;
constexpr size_t WS_GU_T = 320 * MiB, WS_DN_T = 448 * MiB, WS_HACT = 512 * MiB, WS_YEXP = 656 * MiB;
constexpr size_t WS_SE = 800 * MiB, WS_SMF = 804 * MiB, WS_UX = 810 * MiB, WS_DX = 834 * MiB, WS_BC = 850 * MiB, WS_DEC = 866 * MiB, WS_END = 868 * MiB;
constexpr size_t WS_APOW = 14 * MiB, WS_A256 = 14 * MiB + 512 * 1024;
constexpr int CW_CNT = 8192;
constexpr int CW_BAR = 4096;

constexpr int NWAVES = 8, NTHR = 512;
constexpr int LDS_BYTES = 163840;
constexpr int MISC_OFF = 131072 + 8192;

__device__ __forceinline__ float bf2f(unsigned v) { return __uint_as_float(v << 16); }
__device__ __forceinline__ unsigned f2bf(float f) { unsigned u = __float_as_uint(f); return (u + 0x7fffu + ((u >> 16) & 1u)) >> 16; }
typedef float f32x2_t __attribute__((ext_vector_type(2)));
__device__ __forceinline__ unsigned pk2(float lo, float hi) { const f32x2_t v = {lo, hi}; return __builtin_bit_cast(unsigned, __builtin_convertvector(v, bf16x2)); }
__device__ __forceinline__ float wave_sum(float v) {
#pragma unroll
    for (int o = 1; o < 64; o <<= 1) v += __shfl_xor(v, o);
    return v;
}
__device__ __forceinline__ float sigmoidf_(float x) { return __builtin_amdgcn_rcpf(1.f + __builtin_amdgcn_exp2f(-1.4426950408889634f * x)); }
__device__ __forceinline__ float logsigmoidf_(float z) { return fminf(z, 0.f) - 0.6931471805599453f * __builtin_amdgcn_logf(1.f + __builtin_amdgcn_exp2f(-1.4426950408889634f * fabsf(z))); }
__device__ __forceinline__ float gelu_tanh(float y) { return y * sigmoidf_(1.5957691216057308f * (y + 0.044715f * y * y * y)); }

__device__ __forceinline__ float sat8(float x) { return __builtin_amdgcn_fmed3f(x, -448.f, 448.f); }
__device__ __forceinline__ unsigned pk4_fp8(float a, float b, float c, float d) { int p = __builtin_amdgcn_cvt_pk_fp8_f32(sat8(a), sat8(b), 0, false); p = __builtin_amdgcn_cvt_pk_fp8_f32(sat8(c), sat8(d), p, true); return (unsigned)p; }
constexpr float W8_SCALE = 64.f, ACT8_SCALE = 4.f, Y8_SCALE = 8.f;
constexpr int SC_ONE = 0x7f7f7f7f, SC_W8 = 0x79797979, SC_ACT8 = 0x7d7d7d7d;

#define XB_TMO      128
#define XB_XCNT(j)  (256  + 64 * (j))
#define XB_XSUB(j)  (1280 + 64 * (j))
#define XB_XGEN(j)  (2304 + 64 * (j))
#define XB_TOP      3328
#define XB_TOPGEN   3392
#define XCD_BAR_WORDS 3456
#define XB_SPIN_CAP (1u << 18)

__device__ __forceinline__ unsigned xb_ld(unsigned* p)              { return __hip_atomic_load(p, __ATOMIC_RELAXED, __HIP_MEMORY_SCOPE_AGENT); }
__device__ __forceinline__ unsigned xb_add(unsigned* p, unsigned v) { return __hip_atomic_fetch_add(p, v, __ATOMIC_RELAXED, __HIP_MEMORY_SCOPE_AGENT); }
__device__ __forceinline__ unsigned xb_xcc_id() { return (unsigned)__builtin_amdgcn_s_getreg((3 << 11) | 20) & 0xFu; }
#define XB_SPIN(cond, bar) do { unsigned _sp = 0; while (cond) { __builtin_amdgcn_s_sleep(1); \
    if ((++_sp & 255u) == 0u) { if (xb_ld(&(bar)[XB_TMO])) break; if (_sp > XB_SPIN_CAP) { atomicAdd(&(bar)[XB_TMO], 1u); break; } } } } while (0)

struct XcdBarrier {
    unsigned* bar; unsigned x;
    volatile LAS unsigned* st;
};
__device__ __forceinline__ XcdBarrier xcd_barrier_post(unsigned* bar, volatile LAS unsigned* st) {
    XcdBarrier b; b.bar = bar; b.x = xb_xcc_id(); b.st = st;
    if (threadIdx.x == 0) (void)xb_add(&bar[XB_XCNT(b.x)], 1u);
    return b;
}
__device__ __forceinline__ void xcd_barrier_complete(unsigned* bar, unsigned x, unsigned& nloc, unsigned& nx) {
    const unsigned G = gridDim.x * gridDim.y * gridDim.z;
    unsigned sum, cnt, mine, sp = 0u;
    for (;;) {
        sum = 0u; cnt = 0u; mine = 0u;
#pragma unroll
        for (unsigned j = 0; j < 16; ++j) { const unsigned c = xb_ld(&bar[XB_XCNT(j)]); sum += c; cnt += (c > 0u) ? 1u : 0u; mine = (j == x) ? c : mine; }
        if (sum == G) break;
        __builtin_amdgcn_s_sleep(1);
        if ((++sp & 255u) == 0u) { if (xb_ld(&bar[XB_TMO])) break; if (sp > XB_SPIN_CAP) { atomicAdd(&bar[XB_TMO], 1u); break; } }
    }
    nloc = mine > 0u ? mine : 1u; nx = cnt > 0u ? cnt : 1u;
}
__device__ __forceinline__ void xcd_barrier(const XcdBarrier& b) {
    asm volatile("s_waitcnt vmcnt(0)" ::: "memory");
    __syncthreads();
    if (threadIdx.x == 0) {
        unsigned* bar = b.bar;
        __builtin_amdgcn_s_waitcnt(0);
        unsigned nloc = b.st[0], nx = b.st[1];
        if (nloc == 0u) { xcd_barrier_complete(bar, b.x, nloc, nx); b.st[0] = nloc; b.st[1] = nx; }
        const unsigned old = xb_add(&bar[XB_XSUB(b.x)], 1u);
        const unsigned gen = old / nloc;
        if (old + 1u == (gen + 1u) * nloc) {
            __builtin_amdgcn_fence(__ATOMIC_RELEASE, "agent");
            asm volatile("s_waitcnt vmcnt(0)" ::: "memory");
            const unsigned og = xb_add(&bar[XB_TOP], 1u);
            const unsigned tg = og / nx;
            if (og + 1u == (tg + 1u) * nx) xb_add(&bar[XB_TOPGEN], 1u);
            else XB_SPIN(xb_ld(&bar[XB_TOPGEN]) == tg, bar);
            __builtin_amdgcn_fence(__ATOMIC_ACQUIRE, "agent");
            xb_add(&bar[XB_XGEN(b.x)], 1u);
            asm volatile("s_waitcnt vmcnt(0)" ::: "memory");
        } else {
            __builtin_amdgcn_fence(__ATOMIC_ACQUIRE, "agent");
            XB_SPIN(xb_ld(&bar[XB_XGEN(b.x)]) == gen, bar);
            asm volatile("s_waitcnt vmcnt(0)" ::: "memory");
        }
    }
    __syncthreads();
}


namespace pg8 {
typedef short bf16x8 __attribute__((ext_vector_type(8)));
typedef unsigned u32x4 __attribute__((ext_vector_type(4)));
constexpr int BM = 256, BK = 64, HALF = 128, HTB = HALF * BK * 2, STAGE_BYTES = 8 * HTB, NXCD = 8, WGM = 4;
__device__ __forceinline__ int lds_byte(int r, int c) { const int st = (r >> 4) * 2 + (c >> 5), rr = r & 15, cc = c & 31, ob = rr * 64 + cc * 2; return st * 1024 + (ob ^ (((ob >> 9) & 1) << 5)); }
__device__ __forceinline__ void stage_rc(int b, int& R, int& C) { const int st = b / 1024, sb = b % 1024, swz = sb ^ (((sb >> 9) & 1) << 5); R = (st >> 1) * 16 + swz / 64; C = (st & 1) * 32 + (swz % 64) / 2; }
__device__ __forceinline__ int perm32(int rho) { const int n = rho >> 4, i = rho & 15; return 8 * (i >> 2) + 4 * n + (i & 3); }
__device__ __forceinline__ unsigned cvt_pk_bf16(float lo, float hi) { unsigned r; asm volatile("v_cvt_pk_bf16_f32 %0, %1, %2" : "=v"(r) : "v"(lo), "v"(hi)); return r; }

typedef int v8i_t __attribute__((ext_vector_type(8)));
typedef int v4i_t __attribute__((ext_vector_type(4)));
template <int H> __device__ __forceinline__ bf16x8 half8(v8i_t v) { const v4i_t h = H ? __builtin_shufflevector(v, v, 4, 5, 6, 7) : __builtin_shufflevector(v, v, 0, 1, 2, 3); return __builtin_bit_cast(bf16x8, h); }
__device__ __forceinline__ unsigned ufl(unsigned v) { return (unsigned)__builtin_amdgcn_readfirstlane((int)v); }
struct Unit { int pm, pn, e, ui, hmask, rp; unsigned ao, bo; };

__device__ __forceinline__ void acc_zero(f32x4 (&acc)[2][2][4][2]) {
#pragma unroll
    for (int a = 0; a < 2; ++a)
#pragma unroll
        for (int b = 0; b < 2; ++b)
#pragma unroll
            for (int m = 0; m < 4; ++m)
#pragma unroll
                for (int n = 0; n < 2; ++n) acc[a][b][m][n] = (f32x4){0.f, 0.f, 0.f, 0.f};
}
__device__ __forceinline__ bool order_map_l(long L, int nM, int nN, int& pm, int& pn) {
    const int nwg = nM * nN; if (L >= nwg) return false;
    int wgid = (int)L; { const int q = nwg / NXCD, r = nwg % NXCD, xcd = wgid % NXCD, off = wgid / NXCD; wgid = (xcd < r ? xcd * (q + 1) : r * (q + 1) + (xcd - r) * q) + off; }
    const int nig = WGM * nN, gid = wgid / nig, fm = gid * WGM, gsz = (nM - fm) < WGM ? (nM - fm) : WGM;
    pm = fm + ((wgid % nig) % gsz); pn = (wgid % nig) / gsz; return true;
}
__device__ __forceinline__ bool order_map(int i, int G, int c, int nM, int nN, int& pm, int& pn) { return order_map_l((long)i * G + c, nM, nN, pm, pn); }
struct DenseSched {
    const char* A; const char* Bt; int nM, nN, K, G, c, ldaB, ldbB;
    __device__ __forceinline__ void init(const bf16_t* A_, const bf16_t* Bt_, int M, int N, int K_, int G_, int c_) { A = (const char*)A_; Bt = (const char*)Bt_; nM = M / BM; nN = N / BM; K = K_; G = G_; c = c_; ldaB = K_ * 2; ldbB = K_ * 2; }
    __device__ __forceinline__ bool next(int i, Unit& u) const { int pm, pn; if (!order_map(i, G, c, nM, nN, pm, pn)) return false;
        u.pm = pm; u.pn = pn; u.e = 0; u.ui = i; u.hmask = 3; u.rp = (pm + pn) & 1; u.ao = (unsigned)pm * BM * ldaB; u.bo = (unsigned)pn * BM * ldbB; return true; }
    __device__ __forceinline__ const LAS unsigned short* tok(int) const { return nullptr; }
    __device__ __forceinline__ const char* abuf() const { return A; }
    __device__ __forceinline__ const char* bbuf() const { return Bt; }
};

template <class Epi, class Sched, bool GATHER, bool FP8 = false, bool ALIGN = true, bool GBASE = false>
__device__ __forceinline__ void gemm_phase(LAS unsigned char* lds, const int nt, const Sched& S, const Epi& E) {
    const int ldaB = S.ldaB, ldbB = S.ldbB;
    const __amdgpu_buffer_rsrc_t rsA = __builtin_amdgcn_make_buffer_rsrc((void*)S.abuf(), (short)0, 0x7ffffff0, 0x00020000);
    const __amdgpu_buffer_rsrc_t rsB = __builtin_amdgcn_make_buffer_rsrc((void*)S.bbuf(), (short)0, 0x7ffffff0, 0x00020000);
    const int tid = threadIdx.x, wid = __builtin_amdgcn_readfirstlane(tid >> 6), lane = tid & 63, wr = wid >> 2, wc = wid & 3, fr = lane & 15, fq = lane >> 4;
    int voffA[2], voffB[2];
#pragma unroll
    for (int i = 0; i < 2; ++i) { int R, C; stage_rc(tid * 16 + i * 8192, R, C); const int Rb = (R & ~31) + perm32(R & 31);
        voffA[i] = GATHER ? (C * 2) : (R * ldaB + C * 2); voffB[i] = Rb * ldbB + C * 2; }
    int vg0[2], vg1[2];
    const unsigned kstep = 128u;
    const unsigned hstepA = (unsigned)HALF * ldaB, hstep = (unsigned)HALF * ldbB;
    const unsigned ldsw = (unsigned)wid * 1024u;
    const int aoff = lds_byte(wr * 64 + fr, fq * 8), boff = lds_byte(wc * 32 + fr, fq * 8);
#define PG8_SA(b, h) (((b) * 2 + (h)) * HTB)
#define PG8_SB(b, h) ((4 + (b) * 2 + (h)) * HTB)
#define PG8_STAGE(bufoff, rs, soff, voff) do { _Pragma("unroll") for (int _i = 0; _i < 2; ++_i) \
        __builtin_amdgcn_raw_ptr_buffer_load_lds(rs, (LAS void*)(lds + (bufoff) + ldsw + _i * 8192), 16, (voff)[_i], (int)(soff), 0, 0); } while (0)
#define PG8_STAGE_A(bufoff, uoff, kb, h) do { if constexpr (GATHER) { const unsigned _so = GBASE ? (uoff) + (kb) : (kb); if ((h) == 0) PG8_STAGE(bufoff, rsA, _so, vg0); else PG8_STAGE(bufoff, rsA, _so, vg1); } \
        else PG8_STAGE(bufoff, rsA, (uoff) + (kb) + (h) * hstepA, voffA); } while (0)
#define PG8_LDA(dst, b, h) do { _Pragma("unroll") for (int m = 0; m < 4; ++m) { const v4i_t _lo = *(const LAS v4i_t*)(lds + PG8_SA(b, h) + aoff + m * 2048), _hi = *(const LAS v4i_t*)(lds + PG8_SA(b, h) + aoff + m * 2048 + 1024); \
        dst[m] = __builtin_shufflevector(_lo, _hi, 0, 1, 2, 3, 4, 5, 6, 7); } } while (0)
#define PG8_LDB(dst, b, h) do { _Pragma("unroll") for (int n = 0; n < 2; ++n) { const v4i_t _lo = *(const LAS v4i_t*)(lds + PG8_SB(b, h) + boff + n * 2048), _hi = *(const LAS v4i_t*)(lds + PG8_SB(b, h) + boff + n * 2048 + 1024); \
        dst[n] = __builtin_shufflevector(_lo, _hi, 0, 1, 2, 3, 4, 5, 6, 7); } } while (0)
#define PG8_MMA(ai, bj, At, Bt) do { if (act) { __builtin_amdgcn_s_setprio(1); _Pragma("unroll") for (int m = 0; m < 4; ++m) _Pragma("unroll") for (int n = 0; n < 2; ++n) { \
        if constexpr (FP8) acc[ai][bj][m][n] = __builtin_amdgcn_mfma_scale_f32_16x16x128_f8f6f4(Bt[n], At[m], acc[ai][bj][m][n], 0, 0, 0, E.scale_b, 0, E.scale_a); \
        else { acc[ai][bj][m][n] = __builtin_amdgcn_mfma_f32_16x16x32_bf16(half8<0>(Bt[n]), half8<0>(At[m]), acc[ai][bj][m][n], 0, 0, 0); \
               acc[ai][bj][m][n] = __builtin_amdgcn_mfma_f32_16x16x32_bf16(half8<1>(Bt[n]), half8<1>(At[m]), acc[ai][bj][m][n], 0, 0, 0); } } \
        __builtin_amdgcn_s_setprio(0); } } while (0)
#define PG8_WAIT_V(n) asm volatile("s_waitcnt vmcnt(" #n ")" ::: "memory")
#define PG8_WAIT_L(n) asm volatile("s_waitcnt lgkmcnt(" #n ")" ::: "memory")
#define PG8_BAR __builtin_amdgcn_s_barrier()
#define PG8_SCHED __builtin_amdgcn_sched_barrier(0)
#define PG8_TROW(_i) (16 * ((wid + 8 * (_i)) >> 1) + (lane >> 2))
#define PG8_TOKOFF(dst0, dst1, tk) do { _Pragma("unroll") for (int _i = 0; _i < 2; ++_i) { dst0[_i] = (int)(tk)[PG8_TROW(_i)] * ldaB + voffA[0]; dst1[_i] = (int)(tk)[HALF + PG8_TROW(_i)] * ldaB + voffA[0]; } } while (0)
    Unit cur, nxt; int ui = 0;
    if (!S.next(0, cur)) return;
    f32x4 acc[2][2][4][2];
    E.init(acc, cur, wc, fq);
    v8i_t At[4], B0[2], B1[2];
    unsigned cA = ufl(cur.ao), cB = ufl(cur.bo);
    int crot = __builtin_amdgcn_readfirstlane(cur.rp) * (nt >> 1);
#define PG8_KOF(t_, r_) ((unsigned)(((t_) + (r_)) % nt) * kstep)
    bool act = ((cur.hmask >> wr) & 1) != 0;
    if constexpr (GATHER) { const LAS unsigned short* tk = S.tok(0); PG8_TOKOFF(vg0, vg1, tk); } else { vg0[0] = vg0[1] = vg1[0] = vg1[1] = 0; }
    { const unsigned q0 = PG8_KOF(0, crot), q1 = PG8_KOF(1, crot);
    PG8_STAGE(PG8_SB(0, 0), rsB, cB + q0, voffB); PG8_STAGE(PG8_SB(0, 1), rsB, cB + hstep + q0, voffB); PG8_STAGE_A(PG8_SA(0, 0), cA, q0, 0); PG8_STAGE_A(PG8_SA(0, 1), cA, q0, 1);
    if (wr == 1) PG8_BAR;
    PG8_WAIT_V(2); PG8_BAR;
    PG8_STAGE(PG8_SB(1, 0), rsB, cB + q1, voffB); PG8_STAGE_A(PG8_SA(1, 0), cA, q1, 0); PG8_STAGE(PG8_SB(1, 1), rsB, cB + hstep + q1, voffB); }
    PG8_WAIT_V(6); PG8_BAR;
    for (;;) {
        const bool has_next = S.next(ui + 1, nxt);
        const unsigned nA = ufl(has_next ? nxt.ao : cA), nB = ufl(has_next ? nxt.bo : cB);
        const int nrot = has_next ? __builtin_amdgcn_readfirstlane(nxt.rp) * (nt >> 1) : crot;
#pragma clang loop unroll(disable)
        for (int t = 0; t < nt; t += 2) {
            const bool last = (t == nt - 2);
            const unsigned k1 = PG8_KOF(t + 1, crot);
            const unsigned a2 = last ? nA : cA, k2 = last ? PG8_KOF(0, nrot) : PG8_KOF(t + 2, crot), b2 = (last ? nB : cB) + k2;
            const unsigned k3 = last ? PG8_KOF(1, nrot) : PG8_KOF(t + 3, crot), b3 = (last ? nB : cB) + k3;
            if constexpr (GATHER) { if (last && has_next) { const LAS unsigned short* tk = S.tok(ui + 1);
#pragma unroll
                for (int _i = 0; _i < 2; ++_i) vg0[_i] = (int)tk[PG8_TROW(_i)] * ldaB + voffA[0]; } }
            PG8_LDB(B0, 0, 0); PG8_LDB(B1, 0, 1); PG8_SCHED; PG8_LDA(At, 0, 0); PG8_STAGE_A(PG8_SA(1, 1), cA, k1, 1);
            PG8_WAIT_V(8); PG8_WAIT_L(0); PG8_BAR; PG8_MMA(0, 0, At, B0); PG8_MMA(0, 1, At, B1); PG8_BAR; PG8_SCHED;
            if constexpr (GATHER) { if (last && has_next) { const LAS unsigned short* tk = S.tok(ui + 1);
#pragma unroll
                for (int _i = 0; _i < 2; ++_i) vg1[_i] = (int)tk[HALF + PG8_TROW(_i)] * ldaB + voffA[0]; } }
            PG8_LDA(At, 0, 1); PG8_STAGE(PG8_SB(0, 0), rsB, b2, voffB); PG8_STAGE(PG8_SB(0, 1), rsB, b2 + hstep, voffB); PG8_STAGE_A(PG8_SA(0, 0), a2, k2, 0);
            PG8_WAIT_V(8); PG8_WAIT_L(0); PG8_BAR; PG8_MMA(1, 0, At, B0); PG8_MMA(1, 1, At, B1); PG8_BAR; PG8_SCHED;
            PG8_LDB(B0, 1, 0); PG8_LDB(B1, 1, 1); PG8_SCHED; PG8_LDA(At, 1, 0); PG8_STAGE_A(PG8_SA(0, 1), a2, k2, 1);
            PG8_WAIT_V(8); PG8_WAIT_L(0); PG8_BAR; PG8_MMA(0, 0, At, B0); PG8_MMA(0, 1, At, B1); PG8_BAR; PG8_SCHED;
            PG8_LDA(At, 1, 1); PG8_STAGE(PG8_SB(1, 0), rsB, b3, voffB); PG8_STAGE(PG8_SB(1, 1), rsB, b3 + hstep, voffB); PG8_STAGE_A(PG8_SA(1, 0), a2, k3, 0);
            PG8_WAIT_V(8); PG8_WAIT_L(0); PG8_BAR; PG8_MMA(1, 0, At, B0); PG8_MMA(1, 1, At, B1); PG8_BAR; PG8_SCHED;
        }
        if constexpr (ALIGN) { if (wr == 0) PG8_BAR; }
        if (act) E(acc, cur, wr, wc, fr, fq);
        if (!has_next) break;
        E.init(acc, nxt, wc, fq);
        cur = nxt; cA = nA; cB = nB; crot = nrot; ++ui; act = ((cur.hmask >> wr) & 1) != 0;
        if constexpr (ALIGN) { if (wr == 1) PG8_BAR; }
    }
    PG8_WAIT_V(0);
    if constexpr (!ALIGN) { if (wr == 0) PG8_BAR; }
    PG8_BAR;
#undef PG8_SA
#undef PG8_SB
#undef PG8_STAGE
#undef PG8_STAGE_A
#undef PG8_LDA
#undef PG8_LDB
#undef PG8_MMA
#undef PG8_WAIT_V
#undef PG8_WAIT_L
#undef PG8_BAR
#undef PG8_SCHED
#undef PG8_TOKOFF
#undef PG8_TROW
#undef PG8_KOF
}

struct EpiStore {
    static constexpr int scale_a = 0x7f7f7f7f, scale_b = 0x7f7f7f7f;
    __device__ __forceinline__ void init(f32x4 (&acc)[2][2][4][2], const Unit&, int, int) const { acc_zero(acc); }
    bf16_t* O; int ldc;
    __device__ __forceinline__ void operator()(const f32x4 (&acc)[2][2][4][2], const Unit& u, int wr, int wc, int fr, int fq) const {
        const int row0 = u.pm * BM + wr * 64 + fr, col0 = u.pn * BM + wc * 32 + 8 * fq;
#pragma unroll
        for (int ai = 0; ai < 2; ++ai)
#pragma unroll
            for (int m = 0; m < 4; ++m) { bf16_t* rowp = O + (size_t)(row0 + ai * HALF + m * 16) * ldc + col0;
#pragma unroll
                for (int bj = 0; bj < 2; ++bj) { const f32x4 v0 = acc[ai][bj][m][0], v1 = acc[ai][bj][m][1];
                    u32x4 w; w.x = cvt_pk_bf16(v0[0], v0[1]); w.y = cvt_pk_bf16(v0[2], v0[3]); w.z = cvt_pk_bf16(v1[0], v1[1]); w.w = cvt_pk_bf16(v1[2], v1[3]);
                    *(u32x4*)(rowp + bj * HALF) = w; } }
    }
};
struct EpiGlu {
    static constexpr int scale_a = 0x7f7f7f7f, scale_b = 0x7f7f7f7f;
    __device__ __forceinline__ void init(f32x4 (&acc)[2][2][4][2], const Unit&, int, int) const { acc_zero(acc); }
    const bf16_t* Y5; bf16_t* O; const float* bias;
    __device__ __forceinline__ void operator()(const f32x4 (&acc)[2][2][4][2], const Unit& u, int wr, int wc, int fr, int fq) const {
        const int row0 = u.pm * BM + wr * 64 + fr, col0 = u.pn * BM + wc * 32 + 8 * fq;
        f32x4 bv[2][2];
#pragma unroll
        for (int bj = 0; bj < 2; ++bj)
#pragma unroll
            for (int n = 0; n < 2; ++n) bv[bj][n] = *(const f32x4*)(bias + col0 + bj * HALF + 4 * n);
#pragma unroll
        for (int ai = 0; ai < 2; ++ai) {
            u32x4 yv[4][2];
#pragma unroll
            for (int m = 0; m < 4; ++m)
#pragma unroll
                for (int bj = 0; bj < 2; ++bj) yv[m][bj] = *(const u32x4*)(Y5 + (size_t)(row0 + ai * HALF + m * 16) * 512 + col0 + bj * HALF);
#pragma unroll
            for (int m = 0; m < 4; ++m) { const int row = row0 + ai * HALF + m * 16;
#pragma unroll
                for (int bj = 0; bj < 2; ++bj) { const f32x4 z0 = acc[ai][bj][m][0] + bv[bj][0], z1 = acc[ai][bj][m][1] + bv[bj][1];
                    const u32x4 y = yv[m][bj];
                    float o[8];
                    o[0] = bf2f(y.x & 0xffffu) * sigmoidf_(z0[0]); o[1] = bf2f(y.x >> 16) * sigmoidf_(z0[1]); o[2] = bf2f(y.y & 0xffffu) * sigmoidf_(z0[2]); o[3] = bf2f(y.y >> 16) * sigmoidf_(z0[3]);
                    o[4] = bf2f(y.z & 0xffffu) * sigmoidf_(z1[0]); o[5] = bf2f(y.z >> 16) * sigmoidf_(z1[1]); o[6] = bf2f(y.w & 0xffffu) * sigmoidf_(z1[2]); o[7] = bf2f(y.w >> 16) * sigmoidf_(z1[3]);
                    u32x4 w; w.x = cvt_pk_bf16(o[0], o[1]); w.y = cvt_pk_bf16(o[2], o[3]); w.z = cvt_pk_bf16(o[4], o[5]); w.w = cvt_pk_bf16(o[6], o[7]);
                    *(u32x4*)(O + (size_t)row * 1024 + 512 + col0 + bj * HALF) = w; } } }
    }
};
constexpr int XT_TOK = 131072;
constexpr int XT_PS = 139264 + 128;
constexpr int XT_BIAS = 147456;
struct ExpSched {
    const char* A; const char* W; LAS unsigned char* lds; int nT, nN, G, c, ldaB, ldbB; unsigned estride;
    __device__ __forceinline__ bool next(int i, Unit& u) const { int pm, pn; const int nwg = nT * nN, R = nwg / G, rem = nwg - R * G; long L = (long)i * G + c; int hm = 3;
        if (i == R && 2 * rem <= G) { if (c >= 2 * rem) return false; L = (long)R * G + (c >> 1); hm = 1 << (c & 1); }
        if (!order_map_l(L, nT, nN, pm, pn)) return false;
        const int e = __builtin_amdgcn_readfirstlane((int)*(const LAS unsigned char*)(lds + XT_PS + 260 + pm));
        u.pm = pm; u.pn = pn; u.e = e; u.ui = i; u.hmask = hm; u.rp = (pm + pn) & 1; u.ao = (unsigned)pm * BM * ldaB; u.bo = (unsigned)e * estride + (unsigned)pn * BM * ldbB; return true; }
    int ident;
    __device__ __forceinline__ const LAS unsigned short* tok(int i) const { return (const LAS unsigned short*)(lds + XT_TOK) + (ident ? 0 : i * 256); }
    __device__ __forceinline__ const char* abuf() const { return A; }
    __device__ __forceinline__ const char* bbuf() const { return W; }
};
struct EpiSwiglu {
    static constexpr int scale_a = SC_ONE, scale_b = SC_W8;
    unsigned char* O; const LAS float* bias;
    __device__ __forceinline__ void init(f32x4 (&acc)[2][2][4][2], const Unit& u, int wc, int fq) const {
#pragma unroll
        for (int bj = 0; bj < 2; ++bj)
#pragma unroll
            for (int n = 0; n < 2; ++n) { const f32x4 bv = *(const LAS f32x4*)(bias + u.ui * 256 + bj * HALF + wc * 32 + 8 * fq + 4 * n);
#pragma unroll
                for (int ai = 0; ai < 2; ++ai)
#pragma unroll
                    for (int m = 0; m < 4; ++m) acc[ai][bj][m][n] = bv; }
    }
    __device__ __forceinline__ void operator()(const f32x4 (&acc)[2][2][4][2], const Unit& u, int wr, int wc, int fr, int fq) const {
        const int row0 = u.pm * BM + wr * 64 + fr, col0 = u.pn * HALF + wc * 32 + 8 * fq;
#pragma unroll
        for (int ai = 0; ai < 2; ++ai)
#pragma unroll
            for (int m = 0; m < 4; ++m) { const int row = row0 + ai * HALF + m * 16; float o[8];
#pragma unroll
                for (int n = 0; n < 2; ++n) { const f32x4 g4 = acc[ai][0][m][n], u4 = acc[ai][1][m][n];
#pragma unroll
                    for (int i = 0; i < 4; ++i) { const float g = fminf(g4[i], 7.f), up = __builtin_amdgcn_fmed3f(u4[i], -7.f, 7.f);
                        const float sg = g * __builtin_amdgcn_rcpf(1.f + __builtin_amdgcn_exp2f(-2.4554669595930157f * g));
                        o[4 * n + i] = fmaf(up, ACT8_SCALE, ACT8_SCALE) * sg; } }
                v2u w; w.x = (unsigned)__builtin_amdgcn_cvt_pk_fp8_f32(o[2], o[3], __builtin_amdgcn_cvt_pk_fp8_f32(o[0], o[1], 0, false), true);
                w.y = (unsigned)__builtin_amdgcn_cvt_pk_fp8_f32(o[6], o[7], __builtin_amdgcn_cvt_pk_fp8_f32(o[4], o[5], 0, false), true);
                *(v2u*)(O + (size_t)row * 1024 + col0) = w; }
    }
};
__device__ __forceinline__ v2u xchg16(v2u v) { v2u r; r.x = (unsigned)__builtin_amdgcn_ds_swizzle((int)v.x, 0x401f); r.y = (unsigned)__builtin_amdgcn_ds_swizzle((int)v.y, 0x401f); return r; }
struct EpiDown {
    static constexpr int scale_a = SC_ACT8, scale_b = SC_W8;
    unsigned char* O; const LAS float* bias;
    __device__ __forceinline__ void init(f32x4 (&acc)[2][2][4][2], const Unit& u, int wc, int fq) const {
#pragma unroll
        for (int bj = 0; bj < 2; ++bj)
#pragma unroll
            for (int n = 0; n < 2; ++n) { const f32x4 bv = *(const LAS f32x4*)(bias + u.ui * 256 + bj * HALF + wc * 32 + 8 * fq + 4 * n);
#pragma unroll
                for (int ai = 0; ai < 2; ++ai)
#pragma unroll
                    for (int m = 0; m < 4; ++m) acc[ai][bj][m][n] = bv; }
    }
    __device__ __forceinline__ void operator()(const f32x4 (&acc)[2][2][4][2], const Unit& u, int wr, int wc, int fr, int fq) const {
        const int row0 = u.pm * BM + wr * 64 + fr, col0 = u.pn * BM + wc * 32 + 8 * fq; const bool odd = (fq & 1) != 0;
        unsigned char* base = O + (size_t)row0 * 1024 + (odd ? col0 - 8 + HALF : col0);
#pragma unroll
        for (int ai = 0; ai < 2; ++ai)
#pragma unroll
            for (int m = 0; m < 4; ++m) { v2u w[2];
#pragma unroll
                for (int bj = 0; bj < 2; ++bj) { const f32x4 v0 = acc[ai][bj][m][0] * Y8_SCALE, v1 = acc[ai][bj][m][1] * Y8_SCALE;
                    w[bj].x = pk4_fp8(v0[0], v0[1], v0[2], v0[3]); w[bj].y = pk4_fp8(v1[0], v1[1], v1[2], v1[3]); }
                const v2u got = xchg16(odd ? w[0] : w[1]);
                const v4u out = odd ? (v4u){got.x, got.y, w[1].x, w[1].y} : (v4u){w[0].x, w[0].y, got.x, got.y};
                *(v4u*)(base + (size_t)(ai * HALF + m * 16) * 1024) = out; }
    }
};
struct S5Sched {
    const char* UX; const char* Mt; unsigned mstride; int c, ldaB, ldbB;
    __device__ __forceinline__ bool next(int i, Unit& u) const { const int L = c - 128; if (i > 0 || L < 0) return false;
        const int pm = (L >> 3) & 3, g = (L & 7) + 8 * (L >> 5);
        u.pm = pm; u.pn = 0; u.e = g; u.ui = 0; u.hmask = 3; u.rp = 0; u.ao = (unsigned)(g * 1024 + pm * 256) * 768u; u.bo = (unsigned)g * mstride; return true; }
    __device__ __forceinline__ const LAS unsigned short* tok(int) const { return nullptr; }
    __device__ __forceinline__ const char* abuf() const { return UX; }
    __device__ __forceinline__ const char* bbuf() const { return Mt; }
};
struct EpiDX {
    static constexpr int scale_a = SC_ONE, scale_b = SC_ONE;
    __device__ __forceinline__ void init(f32x4 (&acc)[2][2][4][2], const Unit&, int, int) const { acc_zero(acc); }
    float* O;
    __device__ __forceinline__ void operator()(const f32x4 (&acc)[2][2][4][2], const Unit& u, int wr, int wc, int fr, int fq) const {
        const int row0 = u.e * 1024 + u.pm * BM + wr * 64 + fr, col0 = wc * 32 + 8 * fq;
#pragma unroll
        for (int ai = 0; ai < 2; ++ai)
#pragma unroll
            for (int m = 0; m < 4; ++m) { float* rowp = O + (size_t)(row0 + ai * HALF + m * 16) * 128 + col0;
                *(f32x4*)rowp = acc[ai][0][m][0]; *(f32x4*)(rowp + 4) = acc[ai][0][m][1]; }
    }
};
struct EpiS5Y {
    static constexpr int scale_a = SC_ONE, scale_b = SC_ONE;
    __device__ __forceinline__ void init(f32x4 (&acc)[2][2][4][2], const Unit&, int, int) const { acc_zero(acc); }
    bf16_t* Y5;
    __device__ __forceinline__ void operator()(const f32x4 (&acc)[2][2][4][2], const Unit& u, int wr, int wc, int fr, int fq) const {
        const int g = u.e, r0 = u.pm * BM + wr * 64 + fr;
#pragma unroll
        for (int bj = 0; bj < 2; ++bj) { const int col = bj * HALF + wc * 32 + 8 * fq, t = col >> 4, h0 = col & 15;
#pragma unroll
            for (int ai = 0; ai < 2; ++ai)
#pragma unroll
                for (int m = 0; m < 4; ++m) { const int r = r0 + ai * HALF + m * 16;
                    const f32x4 v0 = acc[ai][bj][m][0], v1 = acc[ai][bj][m][1];
                    u32x4 w; w.x = cvt_pk_bf16(gelu_tanh(v0[0]), gelu_tanh(v0[1])); w.y = cvt_pk_bf16(gelu_tanh(v0[2]), gelu_tanh(v0[3]));
                    w.z = cvt_pk_bf16(gelu_tanh(v1[0]), gelu_tanh(v1[1])); w.w = cvt_pk_bf16(gelu_tanh(v1[2]), gelu_tanh(v1[3]));
                    *(u32x4*)(Y5 + ((size_t)(r * 16 + t) * 512 + g * 16 + h0)) = w; } }
    }
};
struct EpiProj {
    static constexpr int scale_a = SC_ONE, scale_b = SC_ONE;
    __device__ __forceinline__ void init(f32x4 (&acc)[2][2][4][2], const Unit&, int, int) const { acc_zero(acc); }
    bf16_t* O; bf16_t* UX;
    __device__ __forceinline__ void operator()(const f32x4 (&acc)[2][2][4][2], const Unit& u, int wr, int wc, int fr, int fq) const {
        const int row0 = u.pm * BM + wr * 64 + fr, col0 = u.pn * BM + wc * 32 + 8 * fq;
#pragma unroll
        for (int ai = 0; ai < 2; ++ai)
#pragma unroll
            for (int m = 0; m < 4; ++m) { const int row = row0 + ai * HALF + m * 16;
#pragma unroll
                for (int bj = 0; bj < 2; ++bj) { const f32x4 v0 = acc[ai][bj][m][0], v1 = acc[ai][bj][m][1]; const int col = col0 + bj * HALF;
                    u32x4 w; w.x = cvt_pk_bf16(v0[0], v0[1]); w.y = cvt_pk_bf16(v0[2], v0[3]); w.z = cvt_pk_bf16(v1[0], v1[1]); w.w = cvt_pk_bf16(v1[2], v1[3]);
                    if (col < 1536) *(u32x4*)(O + (size_t)row * 2048 + col) = w;
                    else { const int cu = col - 1536, g = cu >> 4, h0 = cu & 15; *(u32x4*)(UX + ((size_t)(g * 1024 + (row >> 4)) * 384 + (row & 15) * 16 + h0)) = w; } } }
    }
};
}

struct Args { const float* in[29]; float* out; unsigned char* ws; int ph_lo, ph_hi; };
enum { I_X = 0, I_C, I_ADAW, I_ADAB, I_MIXPRE, I_MIXPOST, I_FFNPRE, I_FFNPOST, I_WIN, I_WALPHA, I_BALPHA, I_GLANORM,
       I_LRE, I_LIM, I_LOGDT, I_BRE, I_BIM, I_CRE, I_CIM, I_SD, I_GLUW, I_GLUB, I_WOUT, I_RW, I_RB, I_WGU, I_BGU, I_WDN, I_BDN };

struct Ctx { int tid, lane, wave, bid, G, gw, ngw, gtid, ngt; LAS unsigned char* lds; };

template <int MODE> __device__ __forceinline__ int rowmap(int n) {
    if (MODE == 1) { return n < 1536 ? n : (n < 1552 ? -1 : n - 16); }
    if (MODE == 2) { const int jj = n & 1023, up = n >> 10; return 256 * (jj >> 7) + 128 * up + (jj & 127); }
    return n;
}
template <int MODE> __device__ __forceinline__ void transpose_item(const float* W, int K, int N, int kb, int nb, bf16_t* dst, int lane) {
    const int n = nb * 64 + lane, nn = n < N ? n : N - 1;
    const float* src = W + (size_t)(kb * 64) * N + nn;
    float v[64];
#pragma unroll
    for (int i = 0; i < 64; ++i) v[i] = src[(size_t)i * N];
    const int row = n < N ? rowmap<MODE>(n) : -1;
    if (row >= 0) {
        bf16_t* p = dst + (size_t)row * K + kb * 64;
#pragma unroll
        for (int c = 0; c < 8; ++c) { v4u o; o.x = pk2(v[8 * c], v[8 * c + 1]); o.y = pk2(v[8 * c + 2], v[8 * c + 3]); o.z = pk2(v[8 * c + 4], v[8 * c + 5]); o.w = pk2(v[8 * c + 6], v[8 * c + 7]);
            *(v4u*)(p + 8 * c) = o; }
    }
}
struct XItem { const float* W; unsigned char* dst; int N, kt, n0, mode; };
__device__ __forceinline__ XItem xitem(const Args& a, int it) {
    XItem x;
    if (it < 2048) { const int e = it >> 6, r = it & 63; x.W = a.in[I_WGU] + (size_t)e * 1024 * 2048; x.dst = (unsigned char*)(a.ws + WS_GU_T) + (size_t)e * 2048 * 1024; x.N = 2048; x.kt = r >> 3; x.n0 = (r & 7) * 256; x.mode = 2; }
    else { const int i2 = it - 2048, e = i2 >> 5, r = i2 & 31; x.W = a.in[I_WDN] + (size_t)e * 1024 * 1024; x.dst = (unsigned char*)(a.ws + WS_DN_T) + (size_t)e * 1024 * 1024; x.N = 1024; x.kt = r >> 2; x.n0 = (r & 3) * 256; x.mode = 0; }
    return x;
}
constexpr int WI_P0 = 2048, WI_BAR = 1792, WI_NBAR = 9, WI_P3 = WI_P0 + WI_BAR * WI_NBAR, WI_P5 = WI_P3 + 1024, WI_P6 = WI_P5 + 3072, WI_END = 24576;
__device__ __forceinline__ void wconv_item(const Args& a, LAS unsigned char* T, int wi, int lane) {
    const XItem x = xitem(a, wi >> 3); const int n0 = x.n0 + 32 * (wi & 7), r8 = lane >> 3, c4 = lane & 7;
    f32x4 v[16];
#pragma unroll
    for (int i = 0; i < 16; ++i) v[i] = __builtin_nontemporal_load((const f32x4*)(x.W + (size_t)(x.kt * 128 + 16 * r8 + i) * x.N + n0 + 4 * c4));
#pragma unroll
    for (int j = 0; j < 4; ++j) { v4u o;
        o.x = pk4_fp8(v[0][j] * W8_SCALE, v[1][j] * W8_SCALE, v[2][j] * W8_SCALE, v[3][j] * W8_SCALE); o.y = pk4_fp8(v[4][j] * W8_SCALE, v[5][j] * W8_SCALE, v[6][j] * W8_SCALE, v[7][j] * W8_SCALE);
        o.z = pk4_fp8(v[8][j] * W8_SCALE, v[9][j] * W8_SCALE, v[10][j] * W8_SCALE, v[11][j] * W8_SCALE); o.w = pk4_fp8(v[12][j] * W8_SCALE, v[13][j] * W8_SCALE, v[14][j] * W8_SCALE, v[15][j] * W8_SCALE);
        *(LAS v4u*)(T + (4 * c4 + j) * 144 + 16 * r8) = o; }
    asm volatile("s_waitcnt lgkmcnt(0)" ::: "memory");
#pragma unroll
    for (int q = 0; q < 4; ++q) { const int idx = lane + 64 * q, n = idx >> 3, ch = idx & 7;
        const int row = x.mode == 2 ? rowmap<2>(n0 + n) : n0 + n;
        *(v4u*)(x.dst + (size_t)row * 1024 + x.kt * 128 + 16 * ch) = *(const LAS v4u*)(T + n * 144 + 16 * ch); }
    asm volatile("s_waitcnt lgkmcnt(0)" ::: "memory");
}
__device__ __forceinline__ void xcd_barrier_conv(const XcdBarrier& b, const Args& a, const Ctx& c, int bi) {
    asm volatile("s_waitcnt vmcnt(0)" ::: "memory");
    __syncthreads();
    if (c.wave == 0) {
      if (threadIdx.x == 0) {
        unsigned* bar = b.bar;
        __builtin_amdgcn_s_waitcnt(0);
        unsigned nloc = b.st[0], nx = b.st[1];
        if (nloc == 0u) { xcd_barrier_complete(bar, b.x, nloc, nx); b.st[0] = nloc; b.st[1] = nx; }
        const unsigned old = xb_add(&bar[XB_XSUB(b.x)], 1u);
        const unsigned gen = old / nloc;
        if (old + 1u == (gen + 1u) * nloc) {
            __builtin_amdgcn_fence(__ATOMIC_RELEASE, "agent");
            asm volatile("s_waitcnt vmcnt(0)" ::: "memory");
            const unsigned og = xb_add(&bar[XB_TOP], 1u);
            const unsigned tg = og / nx;
            if (og + 1u == (tg + 1u) * nx) xb_add(&bar[XB_TOPGEN], 1u);
            else XB_SPIN(xb_ld(&bar[XB_TOPGEN]) == tg, bar);
            __builtin_amdgcn_fence(__ATOMIC_ACQUIRE, "agent");
            xb_add(&bar[XB_XGEN(b.x)], 1u);
            asm volatile("s_waitcnt vmcnt(0)" ::: "memory");
        } else {
            __builtin_amdgcn_fence(__ATOMIC_ACQUIRE, "agent");
            XB_SPIN(xb_ld(&bar[XB_XGEN(b.x)]) == gen, bar);
            asm volatile("s_waitcnt vmcnt(0)" ::: "memory");
        }
      }
    } else if (bi >= 0 && bi < WI_NBAR) {
        wconv_item(a, c.lds + c.wave * 5120, WI_P0 + WI_BAR * bi + c.bid * 7 + (c.wave - 1), c.lane);
    }
    __syncthreads();
}
__device__ __forceinline__ void ph0_prologue(const Args& a, const Ctx& c) {
    if (c.bid < 192) {
        LAS float* sc = (LAS float*)c.lds;
        LAS float* part = (LAS float*)(c.lds + 32768);
        const float* cin = a.in[I_C];
        for (int i = c.tid; i < 8 * 1024; i += NTHR) { const int b = i >> 10, k = i & 1023; const float x = cin[i]; sc[k * 8 + b] = x * sigmoidf_(x); }
        const int cg = c.tid & 7, rg = c.tid >> 3, n0 = c.bid * 32;
        f32x4 w[16];
#pragma unroll
        for (int s2 = 0; s2 < 16; ++s2) w[s2] = __builtin_nontemporal_load((const f32x4*)(a.in[I_ADAW] + (size_t)(rg + 64 * s2) * 6144 + n0 + 4 * cg));
        __syncthreads();
        f32x4 acc[8];
#pragma unroll
        for (int b = 0; b < 8; ++b) acc[b] = (f32x4){0.f, 0.f, 0.f, 0.f};
#pragma unroll
        for (int s2 = 0; s2 < 16; ++s2) { const int k = rg + 64 * s2; const f32x4 s0 = *(const LAS f32x4*)(sc + k * 8), s1 = *(const LAS f32x4*)(sc + k * 8 + 4);
            acc[0] += w[s2] * s0.x; acc[1] += w[s2] * s0.y; acc[2] += w[s2] * s0.z; acc[3] += w[s2] * s0.w;
            acc[4] += w[s2] * s1.x; acc[5] += w[s2] * s1.y; acc[6] += w[s2] * s1.z; acc[7] += w[s2] * s1.w; }
#pragma unroll
        for (int b = 0; b < 8; ++b) *(LAS f32x4*)(part + (rg * 8 + b) * 32 + 4 * cg) = acc[b];
        __syncthreads();
        if (c.tid < 256) { const int b = c.tid >> 5, cl = c.tid & 31; float sum = a.in[I_ADAB][n0 + cl];
            for (int r2 = 0; r2 < 64; ++r2) sum += part[(r2 * 8 + b) * 32 + cl];
            ((float*)(a.ws + WS_MOD))[b * 6144 + n0 + cl] = sum; }
        __syncthreads();
    }
    if (c.gtid < SG * SP) {
        const int g = c.gtid / SP;
        const double lr = a.in[I_LRE][c.gtid], li = a.in[I_LIM][c.gtid], dt = exp((double)a.in[I_LOGDT][g]);
        const double mag = exp(lr * dt), abr = mag * cos(li * dt), abi = mag * sin(li * dt), den = lr * lr + li * li;
        const double fr = ((abr - 1.0) * lr + abi * li) / den, fi = (abi * lr - (abr - 1.0) * li) / den;
        float* AB = (float*)(a.ws + WS_S5AB); AB[c.gtid * 2] = (float)abr; AB[c.gtid * 2 + 1] = (float)abi;
        { float* AP = (float*)(a.ws + WS_APOW); double pr = 1.0, pi = 0.0;
            for (int n = 0; n <= 16; ++n) { AP[((g * 17 + n) * 64 + (c.gtid & 63)) * 2] = (float)pr; AP[((g * 17 + n) * 64 + (c.gtid & 63)) * 2 + 1] = (float)pi;
                const double tr = pr * abr - pi * abi, ti = pr * abi + pi * abr; pr = tr; pi = ti; }
            double sr = abr, si = abi;
            for (int q = 0; q < 8; ++q) { const double tr = sr * sr - si * si, ti = 2.0 * sr * si; sr = tr; si = ti; }
            float* A2 = (float*)(a.ws + WS_A256); A2[c.gtid * 2] = (float)sr; A2[c.gtid * 2 + 1] = (float)si; }
        float* BB = (float*)(a.ws + WS_S5BB);
        for (int h = 0; h < SC; ++h) { const double br = a.in[I_BRE][c.gtid * SC + h], bi = a.in[I_BIM][c.gtid * SC + h];
            BB[(c.gtid * SC + h) * 2] = (float)(fr * br - fi * bi); BB[(c.gtid * SC + h) * 2 + 1] = (float)(fr * bi + fi * br); }
    }
    { constexpr int IT_WIN = 16 * 33, IT_GLU = 8 * 8, IT_WOUT = 16 * 16, NITEMS = IT_WIN + IT_GLU + IT_WOUT;
        for (int it = (c.bid >= 192 ? (c.bid - 192) * NWAVES + c.wave : NITEMS); it < NITEMS; it += 64 * NWAVES) { int r = it;
            if (r < IT_WIN) { transpose_item<1>(a.in[I_WIN], 1024, NIN, r / 33, r % 33, (bf16_t*)(a.ws + WS_WIN_T), c.lane); continue; } r -= IT_WIN;
            if (r < IT_GLU) { transpose_item<0>(a.in[I_GLUW], 512, 512, r / 8, r % 8, (bf16_t*)(a.ws + WS_GLU_T), c.lane); continue; } r -= IT_GLU;
            transpose_item<0>(a.in[I_WOUT], 1024, 1024, r / 16, r % 16, (bf16_t*)(a.ws + WS_WOUT_T), c.lane); } }
    for (int wi = c.gw; wi < WI_P0; wi += c.ngw) wconv_item(a, c.lds + c.wave * 5120, wi, c.lane);
    __syncthreads();
}

__device__ __forceinline__ void ph1_norm1(const Args& a, const Ctx& c) {
    const float* mod = (const float*)(a.ws + WS_MOD);
    bf16_t* HN = (bf16_t*)(a.ws + WS_HN); float* ALR = (float*)(a.ws + WS_ALR);
    constexpr int PITCH = 2064, LO = 16 * PITCH, PART = 2 * LO;
    s16x8 wh[4], wl[4];
#pragma unroll
    for (int ks = 0; ks < 4; ++ks) { float wv[8];
#pragma unroll
        for (int j = 0; j < 8; ++j) wv[j] = a.in[I_WIN][(size_t)(128 * c.wave + 32 * ks + 8 * (c.lane >> 4) + j) * NIN + 1536 + (c.lane & 15)];
        unsigned hh[4], ll[4];
#pragma unroll
        for (int j = 0; j < 4; ++j) { hh[j] = pk2(wv[2 * j], wv[2 * j + 1]); ll[j] = pk2(wv[2 * j] - bf2f(hh[j] & 0xffffu), wv[2 * j + 1] - bf2f(hh[j] >> 16)); }
        wh[ks] = __builtin_bit_cast(s16x8, (v4u){hh[0], hh[1], hh[2], hh[3]}); wl[ks] = __builtin_bit_cast(s16x8, (v4u){ll[0], ll[1], ll[2], ll[3]}); }
    f32x4 xb[2][2][4];
#define P1_LOAD(buf, it_) do { const int r0_ = 2 * c.gw + 2 * c.ngw * (it_); _Pragma("unroll") for (int r = 0; r < 2; ++r) _Pragma("unroll") for (int j = 0; j < 4; ++j) \
        xb[buf][r][j] = __builtin_nontemporal_load((const f32x4*)(a.in[I_X] + (size_t)(r0_ + r) * D) + c.lane + 64 * j); } while (0)
    P1_LOAD(0, 0);
#pragma unroll
    for (int it = 0; it < 4; ++it) { const int row0 = 2 * c.gw + 2 * c.ngw * it, cbuf = it & 1;
        const int b = row0 / NT;
        f32x4 gv[4], shv[4], scv[4];
#pragma unroll
        for (int j = 0; j < 4; ++j) { const int col = 4 * c.lane + 256 * j; gv[j] = *(const f32x4*)(a.in[I_MIXPRE] + col); shv[j] = *(const f32x4*)(mod + b * 6144 + col); scv[j] = *(const f32x4*)(mod + b * 6144 + 1024 + col) + 1.f; }
        if (it + 1 < 4) P1_LOAD((it + 1) & 1, it + 1);
#pragma unroll
        for (int r = 0; r < 2; ++r) { float ss = 0.f;
#pragma unroll
            for (int j = 0; j < 4; ++j) { const f32x4 v = xb[cbuf][r][j]; ss += (v.x * v.x + v.y * v.y) + (v.z * v.z + v.w * v.w); }
            const float rstd = rsqrtf(wave_sum(ss) * (1.f / D) + EPS);
#pragma unroll
            for (int j = 0; j < 4; ++j) { const int col = 4 * c.lane + 256 * j;
                const f32x4 v = xb[cbuf][r][j] * rstd * gv[j] * scv[j] + shv[j];
                const unsigned h0 = pk2(v.x, v.y), h1 = pk2(v.z, v.w);
                *(v2u*)(HN + (size_t)(row0 + r) * D + col) = (v2u){h0, h1};
                const unsigned l0 = pk2(v.x - bf2f(h0 & 0xffffu), v.y - bf2f(h0 >> 16)), l1 = pk2(v.z - bf2f(h1 & 0xffffu), v.w - bf2f(h1 >> 16));
                const int off = (2 * c.wave + r) * PITCH + col * 2;
                *(LAS v2u*)(c.lds + off) = (v2u){h0, h1}; *(LAS v2u*)(c.lds + LO + off) = (v2u){l0, l1}; } }
        __syncthreads();
        { f32x4 pacc = (f32x4){0.f, 0.f, 0.f, 0.f};
#pragma unroll
            for (int ks = 0; ks < 4; ++ks) { const int aoff = (c.lane & 15) * PITCH + (128 * c.wave + 32 * ks + 8 * (c.lane >> 4)) * 2;
                const s16x8 ahi = *(const LAS s16x8*)(c.lds + aoff), alo = *(const LAS s16x8*)(c.lds + LO + aoff);
                pacc = __builtin_amdgcn_mfma_f32_16x16x32_bf16(ahi, wh[ks], pacc, 0, 0, 0);
                pacc = __builtin_amdgcn_mfma_f32_16x16x32_bf16(ahi, wl[ks], pacc, 0, 0, 0);
                pacc = __builtin_amdgcn_mfma_f32_16x16x32_bf16(alo, wh[ks], pacc, 0, 0, 0); }
            LAS float* part = (LAS float*)(c.lds + PART) + c.wave * 256;
#pragma unroll
            for (int r = 0; r < 4; ++r) part[(4 * (c.lane >> 4) + r) * 16 + (c.lane & 15)] = pacc[r]; }
        __syncthreads();
        if (c.tid < 256) { float sum = 0.f;
#pragma unroll
            for (int w2 = 0; w2 < 8; ++w2) sum += ((const LAS float*)(c.lds + PART))[w2 * 256 + c.tid];
            ALR[((size_t)(16 * c.bid + 2 * c.ngw * it) * 16) + c.tid] = sum; }
    }
#undef P1_LOAD
    __syncthreads();
}

__device__ __forceinline__ float s5_e_val(const float* AP, const float* BB, int g, int row, int col) {
    if (row >= 128) return 0.f;
    const int p = row & 63, im = row >> 6, s_ = col >> 4, h = col & 15;
    const float ar = AP[((g * 17 + 15 - s_) * 64 + p) * 2], ai = AP[((g * 17 + 15 - s_) * 64 + p) * 2 + 1];
    const float br = BB[((g * 64 + p) * 16 + h) * 2], bi = BB[((g * 64 + p) * 16 + h) * 2 + 1];
    return im ? (ar * bi + ai * br) : (ar * br - ai * bi);
}
__device__ __forceinline__ float s5_f_val(const float* AP, const float* CR, const float* CI, int g, int t, int h, int col) {
    const int p = (col - 256) & 63, im = (col - 256) >> 6;
    const float ar = AP[((g * 17 + t + 1) * 64 + p) * 2], ai = AP[((g * 17 + t + 1) * 64 + p) * 2 + 1];
    const float cr = CR[(g * 16 + h) * 64 + p], ci = CI[(g * 16 + h) * 64 + p];
    return im ? -(cr * ai + ci * ar) : (cr * ar - ci * ai);
}
__device__ __forceinline__ void s5_build_mats(const Args& a, const Ctx& c) {
    const float* AP = (const float*)(a.ws + WS_APOW); const float* BB = (const float*)(a.ws + WS_S5BB);
    unsigned* E2 = (unsigned*)(a.ws + WS_SE); unsigned* MF2 = (unsigned*)(a.ws + WS_SMF); bf16_t* MF = (bf16_t*)(a.ws + WS_SMF);
    for (int q0 = c.gtid; q0 < SG * 256 * 128; q0 += 4 * c.ngt) { unsigned w[4];
#pragma unroll
        for (int j = 0; j < 4; ++j) { const int q = q0 + j * c.ngt, qq = q < SG * 256 * 128 ? q : 0, g = qq >> 15, row = (qq >> 7) & 255, col = (qq & 127) * 2;
            w[j] = pk2(s5_e_val(AP, BB, g, row, col), s5_e_val(AP, BB, g, row, col + 1)); }
#pragma unroll
        for (int j = 0; j < 4; ++j) { const int q = q0 + j * c.ngt; if (q < SG * 256 * 128) E2[q] = w[j]; } }
    for (int q0 = c.gtid; q0 < SG * 256 * 192; q0 += 4 * c.ngt) { unsigned w[4]; bool st[4];
#pragma unroll
        for (int j = 0; j < 4; ++j) { const int q = q0 + j * c.ngt, qq = q < SG * 256 * 192 ? q : 0, g = qq / (256 * 192), rem = qq % (256 * 192), row = rem / 192, col = (rem % 192) * 2, t = row >> 4, h = row & 15;
            if (col < 256) { w[j] = 0u; st[j] = (col >> 4) > t; }
            else { w[j] = pk2(s5_f_val(AP, a.in[I_CRE], a.in[I_CIM], g, t, h, col), s5_f_val(AP, a.in[I_CRE], a.in[I_CIM], g, t, h, col + 1)); st[j] = true; }
            st[j] = st[j] && (q < SG * 256 * 192); }
#pragma unroll
        for (int j = 0; j < 4; ++j) if (st[j]) MF2[q0 + j * c.ngt] = w[j]; }
    for (int idx = c.gtid; idx < SG * 16 * 256; idx += c.ngt) { const int g = idx >> 12, tau = (idx >> 8) & 15, h = (idx >> 4) & 15, h2 = idx & 15;
        float sum = 0.f;
#pragma unroll 16
        for (int p = 0; p < 64; ++p) { const float ar = AP[((g * 17 + tau) * 64 + p) * 2], ai = AP[((g * 17 + tau) * 64 + p) * 2 + 1];
            const float br = BB[((g * 64 + p) * 16 + h2) * 2], bi = BB[((g * 64 + p) * 16 + h2) * 2 + 1];
            const float cr = a.in[I_CRE][(g * 16 + h) * 64 + p], ci = a.in[I_CIM][(g * 16 + h) * 64 + p];
            const float zr = ar * br - ai * bi, zi = ar * bi + ai * br;
            sum += cr * zr - ci * zi; }
        if (tau == 0 && h == h2) sum += a.in[I_SD][g * 16 + h];
        const bf16_t kv = (bf16_t)f2bf(sum);
        for (int t = tau; t < 16; ++t) MF[((size_t)g * 256 + t * 16 + h) * 384 + (t - tau) * 16 + h2] = kv; }
}

__device__ __forceinline__ void ph2_gemm1(const Args& a, const Ctx& c) {
    pg8::DenseSched S; S.init((const bf16_t*)(a.ws + WS_HN), (const bf16_t*)(a.ws + WS_WIN_T), NTOK, NPROJ, D, c.G, c.bid);
    pg8::EpiProj E{(bf16_t*)(a.ws + WS_PROJ), (bf16_t*)(a.ws + WS_UX)};
    pg8::gemm_phase<pg8::EpiProj, pg8::DenseSched, false>(c.lds, D / 64, S, E);
}
__device__ __forceinline__ void ph6_glu(const Args& a, const Ctx& c) {
    pg8::DenseSched S; S.init((const bf16_t*)(a.ws + WS_Y5), (const bf16_t*)(a.ws + WS_GLU_T), NTOK, 512, 512, c.G, c.bid);
    pg8::EpiGlu E{(const bf16_t*)(a.ws + WS_Y5), (bf16_t*)(a.ws + WS_MIXIN), a.in[I_GLUB]};
    pg8::gemm_phase<pg8::EpiGlu, pg8::DenseSched, false>(c.lds, 512 / 64, S, E);
}
__device__ __forceinline__ void ph7_wout(const Args& a, const Ctx& c) {
    pg8::DenseSched S; S.init((const bf16_t*)(a.ws + WS_MIXIN), (const bf16_t*)(a.ws + WS_WOUT_T), NTOK, D, D, c.G, c.bid);
    pg8::EpiStore E{(bf16_t*)(a.ws + WS_MIX), D};
    pg8::gemm_phase<pg8::EpiStore, pg8::DenseSched, false>(c.lds, D / 64, S, E);
}


__device__ __forceinline__ void s5_dx_gemm(const Args& a, const Ctx& c) {
    pg8::S5Sched S{(const char*)(a.ws + WS_UX), (const char*)(a.ws + WS_SE), 256u * 256u * 2u, c.bid, 768, 512};
    pg8::EpiDX E{(float*)(a.ws + WS_DX)};
    pg8::gemm_phase<pg8::EpiDX, pg8::S5Sched, false>(c.lds, 256 / 64, S, E);
}
__device__ __forceinline__ void s5_y_gemm(const Args& a, const Ctx& c) {
    pg8::S5Sched S{(const char*)(a.ws + WS_UX), (const char*)(a.ws + WS_SMF), 256u * 384u * 2u, c.bid, 768, 768};
    pg8::EpiS5Y E{(bf16_t*)(a.ws + WS_Y5)};
    pg8::gemm_phase<pg8::EpiS5Y, pg8::S5Sched, false>(c.lds, 384 / 64, S, E);
}
__device__ __forceinline__ void s5_scan(const Args& a, const Ctx& c) {
    const float* AP = (const float*)(a.ws + WS_APOW); const float* A2 = (const float*)(a.ws + WS_A256);
    const float* DX = (const float*)(a.ws + WS_DX); bf16_t* UX = (bf16_t*)(a.ws + WS_UX);
    LAS float* ES = (LAS float*)c.lds;
    for (int bg = c.bid; bg < NB * SG; bg += c.G) { const int b = bg >> 5, g = bg & 31, seg = c.wave, p = c.lane;
        const float ar = AP[((g * 17 + 16) * 64 + p) * 2], ai = AP[((g * 17 + 16) * 64 + p) * 2 + 1];
        const float mr = A2[(g * 64 + p) * 2], mi = A2[(g * 64 + p) * 2 + 1];
        float dr[16], di[16];
        const size_t r0 = (size_t)g * 1024 + b * 128 + seg * 16;
#pragma unroll
        for (int j = 0; j < 16; ++j) { dr[j] = DX[(r0 + j) * 128 + p]; di[j] = DX[(r0 + j) * 128 + 64 + p]; }
        float xr = 0.f, xi = 0.f;
#pragma unroll
        for (int j = 0; j < 16; ++j) { const float nr = ar * xr - ai * xi + dr[j], ni = ar * xi + ai * xr + di[j]; xr = nr; xi = ni; }
        ES[(seg * 64 + p) * 2] = xr; ES[(seg * 64 + p) * 2 + 1] = xi;
        __syncthreads();
        float cr = 0.f, ci = 0.f;
        for (int s2 = 0; s2 < seg; ++s2) { const float er = ES[(s2 * 64 + p) * 2], ei = ES[(s2 * 64 + p) * 2 + 1];
            const float nr = mr * cr - mi * ci + er, ni = mr * ci + mi * cr + ei; cr = nr; ci = ni; }
        xr = cr; xi = ci;
#pragma unroll
        for (int j = 0; j < 16; ++j) { UX[(r0 + j) * 384 + 256 + p] = (bf16_t)f2bf(xr); UX[(r0 + j) * 384 + 320 + p] = (bf16_t)f2bf(xi);
            const float nr = ar * xr - ai * xi + dr[j], ni = ar * xi + ai * xr + di[j]; xr = nr; xi = ni; }
        __syncthreads();
    }
}

__device__ __forceinline__ unsigned offb(unsigned row, unsigned ch) { return 256u * row + 16u * (ch ^ (((row & 3u) << 2) | ((row >> 2) & 3u))); }
__device__ __forceinline__ unsigned offr(unsigned row, unsigned ch) { return 128u * row + 16u * (ch ^ (row & 7u)); }
__device__ __forceinline__ s16x8 tr_frag(const LAS unsigned char* img, int lane, int cb, int ks) {
    const unsigned g = lane >> 4, q = (lane & 15) >> 2, pp = lane & 3;
    const unsigned a0 = offb(32 * ks + 8 * g + q, 2 * cb + (pp >> 1)) + 8 * (pp & 1), a1 = offb(32 * ks + 8 * g + 4 + q, 2 * cb + (pp >> 1)) + 8 * (pp & 1);
    const s16x4 lo = __builtin_amdgcn_ds_read_tr16_b64_v4i16((LAS s16x4*)(img + a0)), hi = __builtin_amdgcn_ds_read_tr16_b64_v4i16((LAS s16x4*)(img + a1));
    return __builtin_shufflevector(lo, hi, 0, 1, 2, 3, 4, 5, 6, 7);
}
__device__ __forceinline__ s16x8 row_frag(const LAS unsigned char* img, int lane, int rb, int ks) {
    return *(const LAS s16x8*)(img + offr(16 * rb + (lane & 15), 4 * ks + (lane >> 4)));
}
__device__ __forceinline__ void gla_pass_a(const Args& a, const Ctx& c) {
    const bf16_t* P = (const bf16_t*)(a.ws + WS_PROJ); const float* ALR = (const float*)(a.ws + WS_ALR);
    float* BC = (float*)(a.ws + WS_BC); bf16_t* DELTA = (bf16_t*)(a.ws + WS_DELTA); float* DEC = (float*)(a.ws + WS_DEC);
    LAS float* ALRl = (LAS float*)c.lds; LAS float* TOT = (LAS float*)(c.lds + 4096);
    LAS unsigned char* KT = c.lds + 8192; LAS unsigned char* VI = c.lds + 16384; LAS bf16_t* Kl = (LAS bf16_t*)(c.lds + 32768);
    const int w = c.wave, d = c.lane;
    const int hh = (c.bid >> 5) & 3;
    float wal[16];
#pragma unroll
    for (int j = 0; j < 16; ++j) wal[j] = a.in[I_WALPHA][j * 256 + hh * 64 + d];
    const float bal = a.in[I_BALPHA][hh * 64 + d];
    f32x4 pa = (f32x4){0.f, 0.f, 0.f, 0.f}; v4u pv[2], pkt;
#define GLA_A_PREFETCH(u_) do { const int b_ = (u_) >> 7, h_ = ((u_) >> 5) & 3, ch_ = (u_) & 31; const size_t r_ = (size_t)b_ * NT + ch_ * 64; \
        if (c.tid < 256) pa = *(const f32x4*)(ALR + (r_ + (c.tid >> 2)) * 16 + (c.tid & 3) * 4); \
        _Pragma("unroll") for (int i = 0; i < 2; ++i) { const int idx = c.tid + 512 * i; pv[i] = *(const v4u*)(P + (r_ + (idx >> 4)) * NPROJ + PV + h_ * 128 + 8 * (idx & 15)); } \
        pkt = *(const v4u*)(P + (r_ + (c.tid >> 3)) * NPROJ + PK + h_ * 64 + 8 * (c.tid & 7)); } while (0)
    if (c.bid < NB * GH * 32) GLA_A_PREFETCH(c.bid);
    for (int unit = c.bid; unit < NB * GH * 32; unit += c.G) {
        const int b = unit >> 7, h = (unit >> 5) & 3, ch = unit & 31; const size_t r0 = (size_t)b * NT + ch * 64;
        if (c.tid < 256) *(LAS f32x4*)(ALRl + (c.tid >> 2) * 16 + (c.tid & 3) * 4) = pa;
#pragma unroll
        for (int i = 0; i < 2; ++i) { const int idx = c.tid + 512 * i; *(LAS v4u*)(VI + offb(idx >> 4, idx & 15)) = pv[i]; }
        *(LAS v4u*)(Kl + (c.tid >> 3) * 64 + 8 * (c.tid & 7)) = pkt;
        __syncthreads();
        if (unit + c.G < NB * GH * 32) GLA_A_PREFETCH(unit + c.G);
        float loc[8]; float run = 0.f;
#pragma unroll
        for (int tt = 0; tt < 8; ++tt) { const int t = 8 * w + tt; float z = bal;
#pragma unroll
            for (int q = 0; q < 4; ++q) { const f32x4 x = *(const LAS f32x4*)(ALRl + t * 16 + 4 * q); z += x.x * wal[4 * q] + x.y * wal[4 * q + 1] + x.z * wal[4 * q + 2] + x.w * wal[4 * q + 3]; }
            run += logsigmoidf_(z) * (1.f / 16.f); loc[tt] = run; }
        TOT[w * 64 + d] = run;
        __syncthreads();
        float pre = 0.f, total = 0.f;
#pragma unroll
        for (int w2 = 0; w2 < 8; ++w2) { const float x = TOT[w2 * 64 + d]; total += x; pre += (w2 < w) ? x : 0.f; }
        float kte[8];
#pragma unroll
        for (int tt = 0; tt < 8; ++tt) { const int t = 8 * w + tt; const float bb = loc[tt] + pre;
            BC[(r0 + t) * 256 + h * 64 + d] = bb;
            kte[tt] = bf2f(Kl[t * 64 + d]) * __expf(total - bb); }
        { v4u o; o.x = pk2(kte[0], kte[1]); o.y = pk2(kte[2], kte[3]); o.z = pk2(kte[4], kte[5]); o.w = pk2(kte[6], kte[7]);
            *(LAS v4u*)(KT + offr(d, w)) = o; }
        if (w == 0) DEC[unit * 64 + d] = __expf(total);
        __syncthreads();
        { const int db = w >> 1, vb0 = 4 * (w & 1);
            f32x4 acc[4];
#pragma unroll
            for (int i = 0; i < 4; ++i) acc[i] = (f32x4){0.f, 0.f, 0.f, 0.f};
#pragma unroll
            for (int ks = 0; ks < 2; ++ks) { const s16x8 af = row_frag(KT, c.lane, db, ks);
#pragma unroll
                for (int i = 0; i < 4; ++i) { const s16x8 bf = tr_frag(VI, c.lane, vb0 + i, ks); acc[i] = __builtin_amdgcn_mfma_f32_16x16x32_bf16(af, bf, acc[i], 0, 0, 0); } }
            __syncthreads();
            LAS bf16_t* DT = (LAS bf16_t*)VI;
#pragma unroll
            for (int i = 0; i < 4; ++i)
#pragma unroll
                for (int r = 0; r < 4; ++r) DT[(16 * db + 4 * (c.lane >> 4) + r) * 128 + 16 * (vb0 + i) + (c.lane & 15)] = (bf16_t)f2bf(acc[i][r]); }
        __syncthreads();
        { const int row = c.tid >> 3, seg = c.tid & 7;
            const LAS v4u* src = (const LAS v4u*)(VI + row * 256 + seg * 32);
            v4u* dst = (v4u*)(DELTA + (size_t)unit * 8192 + row * 128 + seg * 16);
            dst[0] = src[0]; dst[1] = src[1]; }
        __syncthreads();
    }
#undef GLA_A_PREFETCH
}
__device__ __forceinline__ void gla_pass_b(const Args& a, const Ctx& c) {
    const unsigned* DELTA = (const unsigned*)(a.ws + WS_DELTA); const float* DEC = (const float*)(a.ws + WS_DEC); unsigned* SP = (unsigned*)(a.ws + WS_SPREV);
    for (int e = c.gtid; e < NB * GH * 4096; e += c.ngt) { const int bh = __builtin_amdgcn_readfirstlane(e >> 12), d = __builtin_amdgcn_readfirstlane((e >> 6) & 63), vp = e & 63;
        float s0 = 0.f, s1 = 0.f;
        unsigned dw[32]; float dc[32];
#pragma unroll
        for (int j = 0; j < 32; ++j) { const size_t unit = (size_t)bh * 32 + j; dw[j] = DELTA[unit * 4096 + d * 64 + vp]; dc[j] = DEC[unit * 64 + d]; }
#pragma unroll
        for (int j = 0; j < 32; ++j) { const size_t unit = (size_t)bh * 32 + j; SP[unit * 4096 + d * 64 + vp] = pk2(s0, s1); s0 = dc[j] * s0 + bf2f(dw[j] & 0xffffu); s1 = dc[j] * s1 + bf2f(dw[j] >> 16); }
    }
}
__device__ __forceinline__ void gla_pass_c(const Args& a, const Ctx& c) {
    const bf16_t* P = (const bf16_t*)(a.ws + WS_PROJ); const float* BC = (const float*)(a.ws + WS_BC); const bf16_t* SPV = (const bf16_t*)(a.ws + WS_SPREV);
    bf16_t* MI = (bf16_t*)(a.ws + WS_MIXIN);
    LAS unsigned char* VI = c.lds; LAS unsigned char* SI = c.lds + 16384; LAS unsigned char* QD = c.lds + 32768; LAS unsigned char* KI = c.lds + 40960; LAS unsigned char* PI = c.lds + 49152;
    LAS float* OI = (LAS float*)(c.lds + 57344);
    const int w = c.wave, lane = c.lane, g = lane >> 4, cl = lane & 15;
    v4u pv[2], psv[2], pq, pk; f32x4 pb0, pb1;
#define GLA_C_PREFETCH(u_) do { const int b_ = (u_) >> 7, h_ = ((u_) >> 5) & 3, ch_ = (u_) & 31; const size_t r_ = (size_t)b_ * NT + ch_ * 64; \
        _Pragma("unroll") for (int i = 0; i < 2; ++i) { const int idx = c.tid + 512 * i, row = idx >> 4, cc = idx & 15; \
            pv[i] = *(const v4u*)(P + (r_ + row) * NPROJ + PV + h_ * 128 + 8 * cc); psv[i] = *(const v4u*)(SPV + (size_t)(u_) * 8192 + row * 128 + 8 * cc); } \
        { const int t = c.tid >> 3, cc = c.tid & 7; pq = *(const v4u*)(P + (r_ + t) * NPROJ + PQ + h_ * 64 + 8 * cc); pk = *(const v4u*)(P + (r_ + t) * NPROJ + PK + h_ * 64 + 8 * cc); \
            pb0 = *(const f32x4*)(BC + (r_ + t) * 256 + h_ * 64 + 8 * cc); pb1 = *(const f32x4*)(BC + (r_ + t) * 256 + h_ * 64 + 8 * cc + 4); } } while (0)
    if (c.bid < NB * GH * 32) GLA_C_PREFETCH(c.bid);
    for (int unit = c.bid; unit < NB * GH * 32; unit += c.G) {
        const int b = unit >> 7, h = (unit >> 5) & 3, ch = unit & 31; const size_t r0 = (size_t)b * NT + ch * 64;
#pragma unroll
        for (int i = 0; i < 2; ++i) { const int idx = c.tid + 512 * i, row = idx >> 4, cc = idx & 15;
            *(LAS v4u*)(VI + offb(row, cc)) = pv[i];
            *(LAS v4u*)(SI + offb(row, cc)) = psv[i]; }
        { const int t = c.tid >> 3, cc = c.tid & 7;
            const v4u q8 = pq, k8 = pk; const f32x4 b0 = pb0, b1 = pb1;
            const float bb[8] = {b0.x, b0.y, b0.z, b0.w, b1.x, b1.y, b1.z, b1.w};
            const unsigned qw[4] = {q8.x, q8.y, q8.z, q8.w}, kw[4] = {k8.x, k8.y, k8.z, k8.w};
            unsigned qo[4], ko[4];
#pragma unroll
            for (int j = 0; j < 4; ++j) { const float e0 = __expf(bb[2 * j]), e1 = __expf(bb[2 * j + 1]);
                qo[j] = pk2(bf2f(qw[j] & 0xffffu) * 0.125f * e0, bf2f(qw[j] >> 16) * 0.125f * e1);
                ko[j] = pk2(bf2f(kw[j] & 0xffffu) * __builtin_amdgcn_rcpf(e0), bf2f(kw[j] >> 16) * __builtin_amdgcn_rcpf(e1)); }
            *(LAS v4u*)(QD + offr(t, cc)) = (v4u){qo[0], qo[1], qo[2], qo[3]};
            *(LAS v4u*)(KI + offr(t, cc)) = (v4u){ko[0], ko[1], ko[2], ko[3]}; }
        v4u og0, og1; { const bf16_t* ogp = P + (r0 + (c.tid >> 3)) * NPROJ + PG + h * 128 + 16 * (c.tid & 7); og0 = *(const v4u*)ogp; og1 = *(const v4u*)(ogp + 8); }
        __syncthreads();
        if (unit + c.G < NB * GH * 32) GLA_C_PREFETCH(unit + c.G);
        { const int ib = w >> 1;
#pragma unroll
            for (int jj = 0; jj < 2; ++jj) { const int jb = 2 * (w & 1) + jj; f32x4 sc = (f32x4){0.f, 0.f, 0.f, 0.f};
                if (jb <= ib) {
#pragma unroll
                    for (int ks = 0; ks < 2; ++ks) sc = __builtin_amdgcn_mfma_f32_16x16x32_bf16(row_frag(QD, lane, ib, ks), row_frag(KI, lane, jb, ks), sc, 0, 0, 0); }
#pragma unroll
                for (int r = 0; r < 4; ++r) { const int i = 16 * ib + 4 * g + r, j = 16 * jb + cl; const float v = (j <= i) ? sc[r] : 0.f;
                    *(LAS bf16_t*)(PI + offr(i, j >> 3) + 2 * (j & 7)) = (bf16_t)f2bf(v); } } }
        __syncthreads();
        { const int ib = w >> 1, vb0 = 4 * (w & 1);
            f32x4 acc[4];
#pragma unroll
            for (int i = 0; i < 4; ++i) acc[i] = (f32x4){0.f, 0.f, 0.f, 0.f};
#pragma unroll
            for (int ks = 0; ks < 2; ++ks) { const s16x8 ap = row_frag(PI, lane, ib, ks), aq = row_frag(QD, lane, ib, ks);
#pragma unroll
                for (int i = 0; i < 4; ++i) { acc[i] = __builtin_amdgcn_mfma_f32_16x16x32_bf16(ap, tr_frag(VI, lane, vb0 + i, ks), acc[i], 0, 0, 0);
                    acc[i] = __builtin_amdgcn_mfma_f32_16x16x32_bf16(aq, tr_frag(SI, lane, vb0 + i, ks), acc[i], 0, 0, 0); } }
#pragma unroll
            for (int i = 0; i < 4; ++i)
#pragma unroll
                for (int r = 0; r < 4; ++r) OI[(16 * ib + 4 * g + r) * 132 + 16 * (vb0 + i) + cl] = acc[i][r]; }
        __syncthreads();
        { const int t = c.tid >> 3, part = c.tid & 7; float o[16]; float ss = 0.f;
#pragma unroll
            for (int q = 0; q < 4; ++q) { const f32x4 x = *(const LAS f32x4*)(OI + t * 132 + 16 * part + 4 * q); o[4 * q] = x.x; o[4 * q + 1] = x.y; o[4 * q + 2] = x.z; o[4 * q + 3] = x.w;
                ss += (x.x * x.x + x.y * x.y) + (x.z * x.z + x.w * x.w); }
            ss += __shfl_xor(ss, 1); ss += __shfl_xor(ss, 2); ss += __shfl_xor(ss, 4);
            const float rstd = rsqrtf(ss * (1.f / 128.f) + EPS);
            const v4u g0 = og0, g1 = og1;
            const unsigned gw[8] = {g0.x, g0.y, g0.z, g0.w, g1.x, g1.y, g1.z, g1.w};
            unsigned ow[8];
#pragma unroll
            for (int j = 0; j < 8; ++j) { const float ga = bf2f(gw[j] & 0xffffu), gb = bf2f(gw[j] >> 16);
                const float n0 = a.in[I_GLANORM][16 * part + 2 * j], n1 = a.in[I_GLANORM][16 * part + 2 * j + 1];
                ow[j] = pk2(o[2 * j] * rstd * n0 * (ga * sigmoidf_(ga)), o[2 * j + 1] * rstd * n1 * (gb * sigmoidf_(gb))); }
            bf16_t* dst = MI + (r0 + t) * D + h * 128 + 16 * part;
            *(v4u*)dst = (v4u){ow[0], ow[1], ow[2], ow[3]}; *(v4u*)(dst + 8) = (v4u){ow[4], ow[5], ow[6], ow[7]}; }
    }
    __syncthreads();
#undef GLA_C_PREFETCH
}

constexpr int RT_PITCH = 2064, RT_LO = 16 * RT_PITCH, RT_PART = 2 * RT_LO;
__device__ __forceinline__ void ph8_norm2_router(const Args& a, const Ctx& c) {
    const float* mod = (const float*)(a.ws + WS_MOD);
    const bf16_t* MX = (const bf16_t*)(a.ws + WS_MIX);
    bf16_t* HN = (bf16_t*)(a.ws + WS_HN); bf16_t* H1B = (bf16_t*)(a.ws + WS_H1);
    unsigned* cnt = (unsigned*)(a.ws + WS_CTL) + CW_CNT;
    int* RE = (int*)(a.ws + WS_ROUTE_E); float* RW = (float*)(a.ws + WS_ROUTE_W); int* LIST = (int*)(a.ws + WS_LIST);
    s16x8 rwh[4][2], rwl[4][2];
#pragma unroll
    for (int ks = 0; ks < 4; ++ks)
#pragma unroll
        for (int cb = 0; cb < 2; ++cb) { float wv[8];
#pragma unroll
            for (int j = 0; j < 8; ++j) wv[j] = a.in[I_RW][(size_t)(128 * c.wave + 32 * ks + 8 * (c.lane >> 4) + j) * 32 + 16 * cb + (c.lane & 15)];
            unsigned hh[4], ll[4];
#pragma unroll
            for (int j = 0; j < 4; ++j) { hh[j] = pk2(wv[2 * j], wv[2 * j + 1]); ll[j] = pk2(wv[2 * j] - bf2f(hh[j] & 0xffffu), wv[2 * j + 1] - bf2f(hh[j] >> 16)); }
            rwh[ks][cb] = __builtin_bit_cast(s16x8, (v4u){hh[0], hh[1], hh[2], hh[3]}); rwl[ks][cb] = __builtin_bit_cast(s16x8, (v4u){ll[0], ll[1], ll[2], ll[3]}); }
    LAS unsigned* lcnt = (LAS unsigned*)(c.lds + 131072);
    LAS unsigned* lent = (LAS unsigned*)(c.lds + 131072 + 512);
    if (c.tid < 128) lcnt[c.tid] = 0u;
    __syncthreads();
#pragma unroll 1
    for (int it = 0; it < 4; ++it) { const int row0 = 2 * c.gw + 2 * c.ngw * it;
        const int b = row0 / NT;
        f32x4 y[2][4];
        v2u mwb[1][2][4]; f32x4 xvb[1][2][4]; constexpr int cbuf = 0;
#pragma unroll
        for (int r = 0; r < 2; ++r)
#pragma unroll
            for (int j = 0; j < 4; ++j) { const int col = 4 * c.lane + 256 * j; mwb[0][r][j] = __builtin_nontemporal_load((const v2u*)(MX + (size_t)(row0 + r) * D + col));
                xvb[0][r][j] = __builtin_nontemporal_load((const f32x4*)(a.in[I_X] + (size_t)(row0 + r) * D + col)); }
        f32x4 gmv[4], g1v[4], gfv[4], shv[4], scv[4];
#pragma unroll
        for (int j = 0; j < 4; ++j) { const int col = 4 * c.lane + 256 * j; gmv[j] = *(const f32x4*)(a.in[I_MIXPOST] + col); g1v[j] = *(const f32x4*)(mod + b * 6144 + 2048 + col);
            gfv[j] = *(const f32x4*)(a.in[I_FFNPRE] + col); shv[j] = *(const f32x4*)(mod + b * 6144 + 3072 + col); scv[j] = *(const f32x4*)(mod + b * 6144 + 4096 + col) + 1.f; }
#pragma unroll
        for (int r = 0; r < 2; ++r) { const int row = row0 + r;
            f32x4 m[4]; float ss = 0.f;
#pragma unroll
            for (int j = 0; j < 4; ++j) { const v2u w = mwb[cbuf][r][j];
                m[j] = (f32x4){bf2f(w.x & 0xffffu), bf2f(w.x >> 16), bf2f(w.y & 0xffffu), bf2f(w.y >> 16)};
                ss += (m[j].x * m[j].x + m[j].y * m[j].y) + (m[j].z * m[j].z + m[j].w * m[j].w); }
            const float rstd = rsqrtf(wave_sum(ss) * (1.f / D) + EPS);
            float s2 = 0.f;
#pragma unroll
            for (int j = 0; j < 4; ++j) { const int col = 4 * c.lane + 256 * j;
                m[j] = xvb[cbuf][r][j] + g1v[j] * (m[j] * rstd * gmv[j]);
                { v2u o; o.x = pk2(m[j].x, m[j].y); o.y = pk2(m[j].z, m[j].w); *(v2u*)(H1B + (size_t)row * D + col) = o; }
                s2 += (m[j].x * m[j].x + m[j].y * m[j].y) + (m[j].z * m[j].z + m[j].w * m[j].w); }
            const float rstd2 = rsqrtf(wave_sum(s2) * (1.f / D) + EPS);
#pragma unroll
            for (int j = 0; j < 4; ++j) { const int col = 4 * c.lane + 256 * j;
                y[r][j] = m[j] * rstd2 * gfv[j] * scv[j] + shv[j];
                *(unsigned*)((unsigned char*)HN + (size_t)row * D + col) = pk4_fp8(y[r][j].x, y[r][j].y, y[r][j].z, y[r][j].w); } }
#pragma unroll
        for (int r = 0; r < 2; ++r)
#pragma unroll
            for (int j = 0; j < 4; ++j) { const f32x4 v = y[r][j];
                const unsigned h0 = pk2(v.x, v.y), h1 = pk2(v.z, v.w);
                const unsigned l0 = pk2(v.x - bf2f(h0 & 0xffffu), v.y - bf2f(h0 >> 16)), l1 = pk2(v.z - bf2f(h1 & 0xffffu), v.w - bf2f(h1 >> 16));
                const int off = (2 * c.wave + r) * RT_PITCH + (4 * c.lane + 256 * j) * 2;
                *(LAS v2u*)(c.lds + off) = (v2u){h0, h1}; *(LAS v2u*)(c.lds + RT_LO + off) = (v2u){l0, l1}; }
        __syncthreads();
        { f32x4 pacc[2] = {(f32x4){0.f, 0.f, 0.f, 0.f}, (f32x4){0.f, 0.f, 0.f, 0.f}};
#pragma unroll
            for (int ks = 0; ks < 4; ++ks) { const int aoff = (c.lane & 15) * RT_PITCH + (128 * c.wave + 32 * ks + 8 * (c.lane >> 4)) * 2;
                const s16x8 ahi = *(const LAS s16x8*)(c.lds + aoff), alo = *(const LAS s16x8*)(c.lds + RT_LO + aoff);
#pragma unroll
                for (int cb = 0; cb < 2; ++cb) { pacc[cb] = __builtin_amdgcn_mfma_f32_16x16x32_bf16(ahi, rwh[ks][cb], pacc[cb], 0, 0, 0);
                    pacc[cb] = __builtin_amdgcn_mfma_f32_16x16x32_bf16(ahi, rwl[ks][cb], pacc[cb], 0, 0, 0);
                    pacc[cb] = __builtin_amdgcn_mfma_f32_16x16x32_bf16(alo, rwh[ks][cb], pacc[cb], 0, 0, 0); } }
            LAS float* part = (LAS float*)(c.lds + RT_PART) + c.wave * 512;
#pragma unroll
            for (int cb = 0; cb < 2; ++cb)
#pragma unroll
                for (int r = 0; r < 4; ++r) part[(4 * (c.lane >> 4) + r) * 32 + 16 * cb + (c.lane & 15)] = pacc[cb][r]; }
        __syncthreads();
        const int e = c.lane & 31, row = row0 + (c.lane >> 5), l4 = c.lane & 31;
        float val = a.in[I_RB][e];
#pragma unroll
        for (int w2 = 0; w2 < 8; ++w2) val += ((const LAS float*)(c.lds + RT_PART))[w2 * 512 + (c.tid >> 5) * 32 + e];
        int sel_e[4]; float sel_v[4];
#pragma unroll
        for (int k = 0; k < 4; ++k) { float mx = val;
#pragma unroll
            for (int o = 1; o < 32; o <<= 1) mx = fmaxf(mx, __shfl_xor(mx, o));
            const unsigned long long bal = __ballot(val == mx);
            const unsigned half = (unsigned)(c.lane >> 5 ? (bal >> 32) : (bal & 0xffffffffull));
            const int idx = __ffs((int)half) - 1;
            sel_e[k] = idx; sel_v[k] = mx; if (e == idx) val = -3.0e38f; }
        const float e0 = 1.f, e1 = __expf(sel_v[1] - sel_v[0]), e2 = __expf(sel_v[2] - sel_v[0]), e3 = __expf(sel_v[3] - sel_v[0]);
        const float inv = 1.f / (e0 + e1 + e2 + e3);
        if (l4 < 4) { const int ee = l4 == 0 ? sel_e[0] : l4 == 1 ? sel_e[1] : l4 == 2 ? sel_e[2] : sel_e[3];
            const float wv = (l4 == 0 ? e0 : l4 == 1 ? e1 : l4 == 2 ? e2 : e3) * inv;
            const unsigned ls = __hip_atomic_fetch_add((LAS unsigned*)lcnt + ee, 1u, __ATOMIC_RELAXED, __HIP_MEMORY_SCOPE_WORKGROUP);
            const unsigned en = __hip_atomic_fetch_add((LAS unsigned*)lcnt + 32, 1u, __ATOMIC_RELAXED, __HIP_MEMORY_SCOPE_WORKGROUP);
            lent[en & 511u] = (unsigned)row * 4u + (unsigned)l4; lent[512 + (en & 511u)] = (unsigned)ee | (ls << 8); RW[row * 4 + l4] = wv; }
    }
    __syncthreads();
    if (c.tid < 32) lcnt[64 + c.tid] = atomicAdd(cnt + c.tid * 64, lcnt[c.tid]);
    __syncthreads();
    { const unsigned nent = lcnt[32];
        for (unsigned t = c.tid; t < nent; t += NTHR) { const unsigned rk = lent[t], es = lent[512 + t], ee = es & 255u, slot = lcnt[64 + ee] + (es >> 8);
            RE[rk] = (int)(ee | (slot << 8)); LIST[ee * LISTCAP + slot] = (int)(rk >> 2); } }
    __syncthreads();
}

__device__ __forceinline__ void build_pstart(const Args& a, const Ctx& c, LAS int* ps, LAS int* cn) {
    if (c.tid < 64) {
        const unsigned* cnt = (const unsigned*)(a.ws + WS_CTL) + CW_CNT;
        const int n = c.tid < NE ? (int)__hip_atomic_load(cnt + c.tid * 64, __ATOMIC_RELAXED, __HIP_MEMORY_SCOPE_AGENT) : 0;
        const int pad = ((n + 255) >> 8) << 8; int inc = pad;
#pragma unroll
        for (int o = 1; o < 32; o <<= 1) { const int t = __shfl_up(inc, o); if (c.tid >= o) inc += t; }
        if (c.tid < NE) { ps[c.tid] = inc - pad; cn[c.tid] = n; }
        if (c.tid == NE - 1) ps[NE] = inc; }
    __syncthreads();
}
template <bool GATHER> __device__ __forceinline__ void exp_tables(const Args& a, const Ctx& c, pg8::ExpSched& S) {
    LAS int* ps = (LAS int*)(c.lds + pg8::XT_PS); LAS int* cn = ps + 33; LAS unsigned char* te = (LAS unsigned char*)(c.lds + pg8::XT_PS + 260);
    build_pstart(a, c, ps, cn);
    const int nT = ps[NE] >> 8;
    for (int t = c.tid; t < nT; t += NTHR) { int e = 0; for (int q = 1; q < NE; ++q) e = (t * 256 >= ps[q]) ? q : e; te[t] = (unsigned char)e; }
    __syncthreads();
    S.nT = nT; S.lds = c.lds; S.G = c.G; S.c = c.bid; S.ident = GATHER ? 0 : 1;
    { const int* LIST = (const int*)(a.ws + WS_LIST); LAS unsigned short* tk = (LAS unsigned short*)(c.lds + pg8::XT_TOK); LAS float* bt = (LAS float*)(c.lds + pg8::XT_BIAS);
        constexpr int MAXU = 10;
        int tokv[MAXU]; float biasv[MAXU];
        if (c.tid < 256) {
#pragma unroll
            for (int i = 0; i < MAXU; ++i) { pg8::Unit u; const bool ok = S.next(i, u); tokv[i] = 0; biasv[i] = 0.f;
                if (ok) { if (GATHER) { const int slot = u.pm * 256 - ps[u.e] + c.tid; if (slot < cn[u.e]) tokv[i] = LIST[u.e * LISTCAP + slot];
                        biasv[i] = a.in[I_BGU][u.e * 2048 + (c.tid >> 7) * 1024 + u.pn * 128 + (c.tid & 127)]; }
                    else biasv[i] = a.in[I_BDN][u.e * 1024 + u.pn * 256 + c.tid]; } }
#pragma unroll
            for (int i = 0; i < MAXU; ++i) { if (GATHER) tk[i * 256 + c.tid] = (unsigned short)tokv[i]; bt[i * 256 + c.tid] = biasv[i]; }
            if (!GATHER) tk[c.tid] = (unsigned short)c.tid; }
        __syncthreads(); }
}
__device__ __forceinline__ void ph10_exp1(const Args& a, const Ctx& c) {
    pg8::ExpSched S; S.A = (const char*)(a.ws + WS_HN); S.W = (const char*)(a.ws + WS_GU_T); S.nN = 8; S.ldaB = D; S.ldbB = D; S.estride = 2048u * 1024u;
    exp_tables<true>(a, c, S);
    pg8::EpiSwiglu E{(unsigned char*)(a.ws + WS_HACT), (const LAS float*)(c.lds + pg8::XT_BIAS)};
    pg8::gemm_phase<pg8::EpiSwiglu, pg8::ExpSched, true, true>(c.lds, D / 128, S, E);
}
__device__ __forceinline__ void ph11_exp2(const Args& a, const Ctx& c) {
    pg8::ExpSched S; S.A = (const char*)(a.ws + WS_HACT); S.W = (const char*)(a.ws + WS_DN_T); S.nN = 4; S.ldaB = DFF; S.ldbB = DFF; S.estride = 1024u * 1024u;
    exp_tables<false>(a, c, S);
    pg8::EpiDown E{(unsigned char*)(a.ws + WS_YEXP), (const LAS float*)(c.lds + pg8::XT_BIAS)};
    pg8::gemm_phase<pg8::EpiDown, pg8::ExpSched, true, true, true, true>(c.lds, DFF / 128, S, E);
}

__device__ __forceinline__ f32x4 fp8x4_to_f32(unsigned w) { const f32x2_t lo = __builtin_amdgcn_cvt_pk_f32_fp8((int)w, false), hi = __builtin_amdgcn_cvt_pk_f32_fp8((int)w, true); return (f32x4){lo.x, lo.y, hi.x, hi.y}; }
__device__ __forceinline__ void ph12_final(const Args& a, const Ctx& c) {
    LAS int* ps = (LAS int*)c.lds; LAS int* cn = ps + 64;
    build_pstart(a, c, ps, cn);
    const float* mod = (const float*)(a.ws + WS_MOD);
    const unsigned char* YE = (const unsigned char*)(a.ws + WS_YEXP); const bf16_t* H1B = (const bf16_t*)(a.ws + WS_H1);
    const int* RE = (const int*)(a.ws + WS_ROUTE_E); const float* RW = (const float*)(a.ws + WS_ROUTE_W);
    int4 reA[4][2]; f32x4 rwA[4][2];
#pragma unroll
    for (int it = 0; it < 4; ++it)
#pragma unroll
        for (int r = 0; r < 2; ++r) { const int row = 2 * c.gw + 2 * c.ngw * it + r; const int rc = row < NTOK ? row : 0;
            reA[it][r] = *(const int4*)(RE + rc * 4); rwA[it][r] = *(const f32x4*)(RW + rc * 4); }
#pragma unroll
    for (int it = 0; it < 4; ++it) { const int row0 = 2 * c.gw + 2 * c.ngw * it; if (row0 >= NTOK) break;
        const int b = row0 / NT;
        int4 re[2]; f32x4 rw[2];
#pragma unroll
        for (int r = 0; r < 2; ++r) { re[r] = reA[it][r]; rw[r] = rwA[it][r]; }
        v2u hw[2][4];
#pragma unroll
        for (int r = 0; r < 2; ++r)
#pragma unroll
            for (int j = 0; j < 4; ++j) hw[r][j] = __builtin_nontemporal_load((const v2u*)(H1B + (size_t)(row0 + r) * D + 4 * c.lane + 256 * j));
        f32x4 f[2][4];
#pragma unroll
        for (int r = 0; r < 2; ++r) { const int rr[4] = {re[r].x, re[r].y, re[r].z, re[r].w}; const float ww[4] = {rw[r].x, rw[r].y, rw[r].z, rw[r].w};
            unsigned yw[4][4];
#pragma unroll
            for (int k = 0; k < 4; ++k) { const size_t pos = (size_t)(ps[rr[k] & 255] + (rr[k] >> 8));
#pragma unroll
                for (int j = 0; j < 4; ++j) yw[k][j] = __builtin_nontemporal_load((const unsigned*)(YE + pos * D + 4 * c.lane + 256 * j)); }
#pragma unroll
            for (int j = 0; j < 4; ++j) { f[r][j] = fp8x4_to_f32(yw[0][j]) * ww[0];
#pragma unroll
                for (int k = 1; k < 4; ++k) f[r][j] += fp8x4_to_f32(yw[k][j]) * ww[k]; } }
        f32x4 gfv[4], g2v[4];
#pragma unroll
        for (int j = 0; j < 4; ++j) { const int col = 4 * c.lane + 256 * j; gfv[j] = *(const f32x4*)(a.in[I_FFNPOST] + col); g2v[j] = *(const f32x4*)(mod + b * 6144 + 5120 + col); }
#pragma unroll
        for (int r = 0; r < 2; ++r) { float sf = 0.f;
#pragma unroll
            for (int j = 0; j < 4; ++j) sf += (f[r][j].x * f[r][j].x + f[r][j].y * f[r][j].y) + (f[r][j].z * f[r][j].z + f[r][j].w * f[r][j].w);
            const float rf = rsqrtf(wave_sum(sf) * (1.f / (D * Y8_SCALE * Y8_SCALE)) + EPS) * (1.f / Y8_SCALE);
#pragma unroll
            for (int j = 0; j < 4; ++j) { const int col = 4 * c.lane + 256 * j;
                const f32x4 gf = gfv[j], g2 = g2v[j];
                const f32x4 h = (f32x4){bf2f(hw[r][j].x & 0xffffu), bf2f(hw[r][j].x >> 16), bf2f(hw[r][j].y & 0xffffu), bf2f(hw[r][j].y >> 16)};
                __builtin_nontemporal_store(h + g2 * (f[r][j] * rf * gf), (f32x4*)(a.out + (size_t)(row0 + r) * D + col)); } }
    }
}

constexpr int NPHASE = 13;
__global__ void __launch_bounds__(NTHR, 2) mk_fwd(Args a) {
    extern __shared__ __attribute__((aligned(16))) unsigned char lds_raw[];
    Ctx c;
    c.lds = (LAS unsigned char*)lds_raw;
    c.tid = threadIdx.x; c.lane = c.tid & 63; c.wave = __builtin_amdgcn_readfirstlane(c.tid >> 6);
    c.bid = blockIdx.x; c.G = gridDim.x; c.gw = c.bid * NWAVES + c.wave; c.ngw = c.G * NWAVES; c.gtid = c.bid * NTHR + c.tid; c.ngt = c.G * NTHR;
    volatile LAS unsigned* MISC = (volatile LAS unsigned*)(c.lds + MISC_OFF);
    if (c.tid < 32) MISC[c.tid] = 0u;
    __syncthreads();
    const bool one = (a.ph_hi - a.ph_lo) > 1;
    XcdBarrier bar; bar.bar = (unsigned*)(a.ws + WS_CTL) + CW_BAR; bar.x = 0; bar.st = MISC + 8;
    if (one) bar = xcd_barrier_post((unsigned*)(a.ws + WS_CTL) + CW_BAR, MISC + 8);
    const int lo = a.ph_lo, hi = a.ph_hi;
#define IN(k) (lo <= (k) && (k) < hi)
#define SEAM(k) do { if (IN(k) && IN((k) + 1)) { if ((k) <= 8) xcd_barrier_conv(bar, a, c, (k)); else xcd_barrier(bar); } else __syncthreads(); } while (0)
    if (IN(0)) { ph0_prologue(a, c); SEAM(0); }
    if (IN(1)) { ph1_norm1(a, c); s5_build_mats(a, c); SEAM(1); }
    if (IN(2)) { ph2_gemm1(a, c); SEAM(2); }
    if (IN(3)) { gla_pass_a(a, c); s5_dx_gemm(a, c);
        if (c.bid < 128) { for (int wi = WI_P3 + c.bid * 8 + c.wave; wi < WI_P5; wi += 1024) wconv_item(a, c.lds + c.wave * 5120, wi, c.lane); __syncthreads(); }
        SEAM(3); }
    if (IN(4)) { gla_pass_b(a, c); s5_scan(a, c); SEAM(4); }
    if (IN(5)) { gla_pass_c(a, c); s5_y_gemm(a, c);
        if (c.bid < 128) { for (int wi = WI_P5 + c.bid * 8 + c.wave; wi < WI_P6; wi += 1024) wconv_item(a, c.lds + c.wave * 5120, wi, c.lane); __syncthreads(); }
        SEAM(5); }
    if (IN(6)) { ph6_glu(a, c);
        if (c.bid >= 128) { for (int wi = WI_P6 + (c.bid - 128) * 8 + c.wave; wi < WI_END; wi += 1024) wconv_item(a, c.lds + c.wave * 5120, wi, c.lane); __syncthreads(); }
        SEAM(6); }
    if (IN(7)) { ph7_wout(a, c); SEAM(7); }
    if (IN(8)) { ph8_norm2_router(a, c); if (IN(10)) xcd_barrier_conv(bar, a, c, 8); else __syncthreads(); }
    if (IN(10)) { ph10_exp1(a, c); SEAM(10); }
    if (IN(11)) { ph11_exp2(a, c); SEAM(11); }
    if (IN(12)) { ph12_final(a, c); }
#undef IN
#undef SEAM
}

extern "C" void kernel_launch(void* const* d_in, const int* in_sizes, int n_in, void* d_out, int out_size, void* d_ws, size_t ws_size, hipStream_t stream) {
    static int grid = 0;
    if (grid == 0) {
        if (n_in != 29 || in_sizes[0] != NTOK * D || out_size != NTOK * D || ws_size < WS_END) {
            fprintf(stderr, "kernel_launch: unexpected shapes (n_in %d, in0 %d, out %d, ws %zu < %zu)\n", n_in, n_in > 0 ? in_sizes[0] : -1, out_size, ws_size, (size_t)WS_END); grid = -1; return; }
        int dev = 0, cus = 0, per_cu = 0;
        if (hipGetDevice(&dev) != hipSuccess || hipDeviceGetAttribute(&cus, hipDeviceAttributeMultiprocessorCount, dev) != hipSuccess) { grid = -1; return; }
        if (hipFuncSetAttribute((const void*)mk_fwd, hipFuncAttributeMaxDynamicSharedMemorySize, LDS_BYTES) != hipSuccess) { fprintf(stderr, "kernel_launch: hipFuncSetAttribute failed\n"); grid = -1; return; }
        if (hipOccupancyMaxActiveBlocksPerMultiprocessor(&per_cu, (const void*)mk_fwd, NTHR, LDS_BYTES) != hipSuccess || per_cu < 1)
            fprintf(stderr, "kernel_launch: occupancy query reports %d\n", per_cu);
        (void)hipGetLastError();
        grid = 256;
        if (cus != 256) fprintf(stderr, "kernel_launch: built for a 256-CU device, found %d CUs\n", cus);
    }
    if (grid < 0) return;
    (void)hipMemsetAsync((char*)d_ws + WS_CTL, 0, CTL_BYTES, stream);
    Args a{};
    for (int i = 0; i < 29; ++i) a.in[i] = (const float*)d_in[i];
    a.out = (float*)d_out; a.ws = (unsigned char*)d_ws;
    a.ph_lo = 0; a.ph_hi = NPHASE;
    hipLaunchKernelGGL(mk_fwd, dim3(grid), dim3(NTHR), LDS_BYTES, stream, a);
}
```

```cpp
#include <hip/hip_runtime.h>
#include <cstdio>
#include <cstdint>

#define LAS __attribute__((address_space(3)))
typedef unsigned short bf16_t;
typedef unsigned v4u __attribute__((ext_vector_type(4)));
typedef unsigned v2u __attribute__((ext_vector_type(2)));
typedef float f32x4 __attribute__((ext_vector_type(4)));
typedef __bf16 bf16x2 __attribute__((ext_vector_type(2)));
typedef short s16x4 __attribute__((ext_vector_type(4)));
typedef short s16x8 __attribute__((ext_vector_type(8)));

constexpr int NB = 8, NT = 2048, D = 1024, NTOK = NB * NT;
constexpr int NIN = 2064, NPROJ = 2048;
constexpr int GH = 4, DK = 64, DV = 128;
constexpr int SG = 32, SP = 64, SC = 16;
constexpr int NE = 32, DFF = 1024;
constexpr int LISTCAP = 16384, MAXROWS = 65536 + NE * 256;
constexpr float EPS = 1e-6f;
constexpr int PQ = 0, PK = 256, PV = 512, PG = 1024, PU = 1536;

constexpr size_t MiB = 1u << 20;
constexpr size_t WS_CTL = 0, CTL_BYTES = 64 * 1024;
constexpr size_t WS_MOD = 1 * MiB;
constexpr size_t WS_S5AB = 2 * MiB, WS_S5BB = 2 * MiB + 65536;
constexpr size_t WS_WIN_T = 3 * MiB, WS_GLU_T = 7 * MiB, WS_WOUT_T = 8 * MiB, WS_ALR = 10 * MiB;
constexpr size_t WS_ROUTE_E = 11 * MiB, WS_ROUTE_W = 11 * MiB + 512 * 1024, WS_LIST = 12 * MiB;
constexpr size_t WS_HN = 16 * MiB, WS_PROJ = 48 * MiB, WS_MIXIN = 112 * MiB, WS_Y5 = 144 * MiB, WS_MIX = 160 * MiB, WS_H1 = 192 * MiB;
constexpr size_t WS_DELTA = 256 * MiB, WS_SPREV = 288 * MiB;
constexpr size_t WS_GU_T = 320 * MiB, WS_DN_T = 448 * MiB, WS_HACT = 512 * MiB, WS_YEXP = 656 * MiB;
constexpr size_t WS_SE = 800 * MiB, WS_SMF = 804 * MiB, WS_UX = 810 * MiB, WS_DX = 834 * MiB, WS_BC = 850 * MiB, WS_DEC = 866 * MiB, WS_END = 868 * MiB;
constexpr size_t WS_APOW = 14 * MiB, WS_A256 = 14 * MiB + 512 * 1024;
constexpr int CW_CNT = 8192;
constexpr int CW_BAR = 4096;

constexpr int NWAVES = 8, NTHR = 512;
constexpr int LDS_BYTES = 163840;
constexpr int MISC_OFF = 131072 + 8192;

__device__ __forceinline__ float bf2f(unsigned v) { return __uint_as_float(v << 16); }
__device__ __forceinline__ unsigned f2bf(float f) { unsigned u = __float_as_uint(f); return (u + 0x7fffu + ((u >> 16) & 1u)) >> 16; }
typedef float f32x2_t __attribute__((ext_vector_type(2)));
__device__ __forceinline__ unsigned pk2(float lo, float hi) { const f32x2_t v = {lo, hi}; return __builtin_bit_cast(unsigned, __builtin_convertvector(v, bf16x2)); }
__device__ __forceinline__ float wave_sum(float v) {
#pragma unroll
    for (int o = 1; o < 64; o <<= 1) v += __shfl_xor(v, o);
    return v;
}
__device__ __forceinline__ float sigmoidf_(float x) { return __builtin_amdgcn_rcpf(1.f + __builtin_amdgcn_exp2f(-1.4426950408889634f * x)); }
__device__ __forceinline__ float logsigmoidf_(float z) { return fminf(z, 0.f) - 0.6931471805599453f * __builtin_amdgcn_logf(1.f + __builtin_amdgcn_exp2f(-1.4426950408889634f * fabsf(z))); }
__device__ __forceinline__ float gelu_tanh(float y) { return y * sigmoidf_(1.5957691216057308f * (y + 0.044715f * y * y * y)); }

__device__ __forceinline__ float sat8(float x) { return __builtin_amdgcn_fmed3f(x, -448.f, 448.f); }
__device__ __forceinline__ unsigned pk4_fp8(float a, float b, float c, float d) { int p = __builtin_amdgcn_cvt_pk_fp8_f32(sat8(a), sat8(b), 0, false); p = __builtin_amdgcn_cvt_pk_fp8_f32(sat8(c), sat8(d), p, true); return (unsigned)p; }
constexpr float W8_SCALE = 64.f, ACT8_SCALE = 4.f, Y8_SCALE = 8.f;
constexpr int SC_ONE = 0x7f7f7f7f, SC_W8 = 0x79797979, SC_ACT8 = 0x7d7d7d7d;

#define XB_TMO      128
#define XB_XCNT(j)  (256  + 64 * (j))
#define XB_XSUB(j)  (1280 + 64 * (j))
#define XB_XGEN(j)  (2304 + 64 * (j))
#define XB_TOP      3328
#define XB_TOPGEN   3392
#define XCD_BAR_WORDS 3456
#define XB_SPIN_CAP (1u << 18)

__device__ __forceinline__ unsigned xb_ld(unsigned* p)              { return __hip_atomic_load(p, __ATOMIC_RELAXED, __HIP_MEMORY_SCOPE_AGENT); }
__device__ __forceinline__ unsigned xb_add(unsigned* p, unsigned v) { return __hip_atomic_fetch_add(p, v, __ATOMIC_RELAXED, __HIP_MEMORY_SCOPE_AGENT); }
__device__ __forceinline__ unsigned xb_xcc_id() { return (unsigned)__builtin_amdgcn_s_getreg((3 << 11) | 20) & 0xFu; }
#define XB_SPIN(cond, bar) do { unsigned _sp = 0; while (cond) { __builtin_amdgcn_s_sleep(1); \
    if ((++_sp & 255u) == 0u) { if (xb_ld(&(bar)[XB_TMO])) break; if (_sp > XB_SPIN_CAP) { atomicAdd(&(bar)[XB_TMO], 1u); break; } } } } while (0)

struct XcdBarrier {
    unsigned* bar; unsigned x;
    volatile LAS unsigned* st;
};
__device__ __forceinline__ XcdBarrier xcd_barrier_post(unsigned* bar, volatile LAS unsigned* st) {
    XcdBarrier b; b.bar = bar; b.x = xb_xcc_id(); b.st = st;
    if (threadIdx.x == 0) (void)xb_add(&bar[XB_XCNT(b.x)], 1u);
    return b;
}
__device__ __forceinline__ void xcd_barrier_complete(unsigned* bar, unsigned x, unsigned& nloc, unsigned& nx) {
    const unsigned G = gridDim.x * gridDim.y * gridDim.z;
    unsigned sum, cnt, mine, sp = 0u;
    for (;;) {
        sum = 0u; cnt = 0u; mine = 0u;
#pragma unroll
        for (unsigned j = 0; j < 16; ++j) { const unsigned c = xb_ld(&bar[XB_XCNT(j)]); sum += c; cnt += (c > 0u) ? 1u : 0u; mine = (j == x) ? c : mine; }
        if (sum == G) break;
        __builtin_amdgcn_s_sleep(1);
        if ((++sp & 255u) == 0u) { if (xb_ld(&bar[XB_TMO])) break; if (sp > XB_SPIN_CAP) { atomicAdd(&bar[XB_TMO], 1u); break; } }
    }
    nloc = mine > 0u ? mine : 1u; nx = cnt > 0u ? cnt : 1u;
}
__device__ __forceinline__ void xcd_barrier(const XcdBarrier& b) {
    asm volatile("s_waitcnt vmcnt(0)" ::: "memory");
    __syncthreads();
    if (threadIdx.x == 0) {
        unsigned* bar = b.bar;
        __builtin_amdgcn_s_waitcnt(0);
        unsigned nloc = b.st[0], nx = b.st[1];
        if (nloc == 0u) { xcd_barrier_complete(bar, b.x, nloc, nx); b.st[0] = nloc; b.st[1] = nx; }
        const unsigned old = xb_add(&bar[XB_XSUB(b.x)], 1u);
        const unsigned gen = old / nloc;
        if (old + 1u == (gen + 1u) * nloc) {
            __builtin_amdgcn_fence(__ATOMIC_RELEASE, "agent");
            asm volatile("s_waitcnt vmcnt(0)" ::: "memory");
            const unsigned og = xb_add(&bar[XB_TOP], 1u);
            const unsigned tg = og / nx;
            if (og + 1u == (tg + 1u) * nx) xb_add(&bar[XB_TOPGEN], 1u);
            else XB_SPIN(xb_ld(&bar[XB_TOPGEN]) == tg, bar);
            __builtin_amdgcn_fence(__ATOMIC_ACQUIRE, "agent");
            xb_add(&bar[XB_XGEN(b.x)], 1u);
            asm volatile("s_waitcnt vmcnt(0)" ::: "memory");
        } else {
            __builtin_amdgcn_fence(__ATOMIC_ACQUIRE, "agent");
            XB_SPIN(xb_ld(&bar[XB_XGEN(b.x)]) == gen, bar);
            asm volatile("s_waitcnt vmcnt(0)" ::: "memory");
        }
    }
    __syncthreads();
}


namespace pg8 {
typedef short bf16x8 __attribute__((ext_vector_type(8)));
typedef unsigned u32x4 __attribute__((ext_vector_type(4)));
constexpr int BM = 256, BK = 64, HALF = 128, HTB = HALF * BK * 2, STAGE_BYTES = 8 * HTB, NXCD = 8, WGM = 4;
__device__ __forceinline__ int lds_byte(int r, int c) { const int st = (r >> 4) * 2 + (c >> 5), rr = r & 15, cc = c & 31, ob = rr * 64 + cc * 2; return st * 1024 + (ob ^ (((ob >> 9) & 1) << 5)); }
__device__ __forceinline__ void stage_rc(int b, int& R, int& C) { const int st = b / 1024, sb = b % 1024, swz = sb ^ (((sb >> 9) & 1) << 5); R = (st >> 1) * 16 + swz / 64; C = (st & 1) * 32 + (swz % 64) / 2; }
__device__ __forceinline__ int perm32(int rho) { const int n = rho >> 4, i = rho & 15; return 8 * (i >> 2) + 4 * n + (i & 3); }
__device__ __forceinline__ unsigned cvt_pk_bf16(float lo, float hi) { unsigned r; asm volatile("v_cvt_pk_bf16_f32 %0, %1, %2" : "=v"(r) : "v"(lo), "v"(hi)); return r; }

typedef int v8i_t __attribute__((ext_vector_type(8)));
typedef int v4i_t __attribute__((ext_vector_type(4)));
template <int H> __device__ __forceinline__ bf16x8 half8(v8i_t v) { const v4i_t h = H ? __builtin_shufflevector(v, v, 4, 5, 6, 7) : __builtin_shufflevector(v, v, 0, 1, 2, 3); return __builtin_bit_cast(bf16x8, h); }
__device__ __forceinline__ unsigned ufl(unsigned v) { return (unsigned)__builtin_amdgcn_readfirstlane((int)v); }
struct Unit { int pm, pn, e, ui, hmask, rp; unsigned ao, bo; };

__device__ __forceinline__ void acc_zero(f32x4 (&acc)[2][2][4][2]) {
#pragma unroll
    for (int a = 0; a < 2; ++a)
#pragma unroll
        for (int b = 0; b < 2; ++b)
#pragma unroll
            for (int m = 0; m < 4; ++m)
#pragma unroll
                for (int n = 0; n < 2; ++n) acc[a][b][m][n] = (f32x4){0.f, 0.f, 0.f, 0.f};
}
__device__ __forceinline__ bool order_map_l(long L, int nM, int nN, int& pm, int& pn) {
    const int nwg = nM * nN; if (L >= nwg) return false;
    int wgid = (int)L; { const int q = nwg / NXCD, r = nwg % NXCD, xcd = wgid % NXCD, off = wgid / NXCD; wgid = (xcd < r ? xcd * (q + 1) : r * (q + 1) + (xcd - r) * q) + off; }
    const int nig = WGM * nN, gid = wgid / nig, fm = gid * WGM, gsz = (nM - fm) < WGM ? (nM - fm) : WGM;
    pm = fm + ((wgid % nig) % gsz); pn = (wgid % nig) / gsz; return true;
}
__device__ __forceinline__ bool order_map(int i, int G, int c, int nM, int nN, int& pm, int& pn) { return order_map_l((long)i * G + c, nM, nN, pm, pn); }
struct DenseSched {
    const char* A; const char* Bt; int nM, nN, K, G, c, ldaB, ldbB;
    __device__ __forceinline__ void init(const bf16_t* A_, const bf16_t* Bt_, int M, int N, int K_, int G_, int c_) { A = (const char*)A_; Bt = (const char*)Bt_; nM = M / BM; nN = N / BM; K = K_; G = G_; c = c_; ldaB = K_ * 2; ldbB = K_ * 2; }
    __device__ __forceinline__ bool next(int i, Unit& u) const { int pm, pn; if (!order_map(i, G, c, nM, nN, pm, pn)) return false;
        u.pm = pm; u.pn = pn; u.e = 0; u.ui = i; u.hmask = 3; u.rp = (pm + pn) & 1; u.ao = (unsigned)pm * BM * ldaB; u.bo = (unsigned)pn * BM * ldbB; return true; }
    __device__ __forceinline__ const LAS unsigned short* tok(int) const { return nullptr; }
    __device__ __forceinline__ const char* abuf() const { return A; }
    __device__ __forceinline__ const char* bbuf() const { return Bt; }
};

template <class Epi, class Sched, bool GATHER, bool FP8 = false, bool ALIGN = true, bool GBASE = false>
__device__ __forceinline__ void gemm_phase(LAS unsigned char* lds, const int nt, const Sched& S, const Epi& E) {
    const int ldaB = S.ldaB, ldbB = S.ldbB;
    const __amdgpu_buffer_rsrc_t rsA = __builtin_amdgcn_make_buffer_rsrc((void*)S.abuf(), (short)0, 0x7ffffff0, 0x00020000);
    const __amdgpu_buffer_rsrc_t rsB = __builtin_amdgcn_make_buffer_rsrc((void*)S.bbuf(), (short)0, 0x7ffffff0, 0x00020000);
    const int tid = threadIdx.x, wid = __builtin_amdgcn_readfirstlane(tid >> 6), lane = tid & 63, wr = wid >> 2, wc = wid & 3, fr = lane & 15, fq = lane >> 4;
    int voffA[2], voffB[2];
#pragma unroll
    for (int i = 0; i < 2; ++i) { int R, C; stage_rc(tid * 16 + i * 8192, R, C); const int Rb = (R & ~31) + perm32(R & 31);
        voffA[i] = GATHER ? (C * 2) : (R * ldaB + C * 2); voffB[i] = Rb * ldbB + C * 2; }
    int vg0[2], vg1[2];
    const unsigned kstep = 128u;
    const unsigned hstepA = (unsigned)HALF * ldaB, hstep = (unsigned)HALF * ldbB;
    const unsigned ldsw = (unsigned)wid * 1024u;
    const int aoff = lds_byte(wr * 64 + fr, fq * 8), boff = lds_byte(wc * 32 + fr, fq * 8);
#define PG8_SA(b, h) (((b) * 2 + (h)) * HTB)
#define PG8_SB(b, h) ((4 + (b) * 2 + (h)) * HTB)
#define PG8_STAGE(bufoff, rs, soff, voff) do { _Pragma("unroll") for (int _i = 0; _i < 2; ++_i) \
        __builtin_amdgcn_raw_ptr_buffer_load_lds(rs, (LAS void*)(lds + (bufoff) + ldsw + _i * 8192), 16, (voff)[_i], (int)(soff), 0, 0); } while (0)
#define PG8_STAGE_A(bufoff, uoff, kb, h) do { if constexpr (GATHER) { const unsigned _so = GBASE ? (uoff) + (kb) : (kb); if ((h) == 0) PG8_STAGE(bufoff, rsA, _so, vg0); else PG8_STAGE(bufoff, rsA, _so, vg1); } \
        else PG8_STAGE(bufoff, rsA, (uoff) + (kb) + (h) * hstepA, voffA); } while (0)
#define PG8_LDA(dst, b, h) do { _Pragma("unroll") for (int m = 0; m < 4; ++m) { const v4i_t _lo = *(const LAS v4i_t*)(lds + PG8_SA(b, h) + aoff + m * 2048), _hi = *(const LAS v4i_t*)(lds + PG8_SA(b, h) + aoff + m * 2048 + 1024); \
        dst[m] = __builtin_shufflevector(_lo, _hi, 0, 1, 2, 3, 4, 5, 6, 7); } } while (0)
#define PG8_LDB(dst, b, h) do { _Pragma("unroll") for (int n = 0; n < 2; ++n) { const v4i_t _lo = *(const LAS v4i_t*)(lds + PG8_SB(b, h) + boff + n * 2048), _hi = *(const LAS v4i_t*)(lds + PG8_SB(b, h) + boff + n * 2048 + 1024); \
        dst[n] = __builtin_shufflevector(_lo, _hi, 0, 1, 2, 3, 4, 5, 6, 7); } } while (0)
#define PG8_MMA(ai, bj, At, Bt) do { if (act) { __builtin_amdgcn_s_setprio(1); _Pragma("unroll") for (int m = 0; m < 4; ++m) _Pragma("unroll") for (int n = 0; n < 2; ++n) { \
        if constexpr (FP8) acc[ai][bj][m][n] = __builtin_amdgcn_mfma_scale_f32_16x16x128_f8f6f4(Bt[n], At[m], acc[ai][bj][m][n], 0, 0, 0, E.scale_b, 0, E.scale_a); \
        else { acc[ai][bj][m][n] = __builtin_amdgcn_mfma_f32_16x16x32_bf16(half8<0>(Bt[n]), half8<0>(At[m]), acc[ai][bj][m][n], 0, 0, 0); \
               acc[ai][bj][m][n] = __builtin_amdgcn_mfma_f32_16x16x32_bf16(half8<1>(Bt[n]), half8<1>(At[m]), acc[ai][bj][m][n], 0, 0, 0); } } \
        __builtin_amdgcn_s_setprio(0); } } while (0)
#define PG8_WAIT_V(n) asm volatile("s_waitcnt vmcnt(" #n ")" ::: "memory")
#define PG8_WAIT_L(n) asm volatile("s_waitcnt lgkmcnt(" #n ")" ::: "memory")
#define PG8_BAR __builtin_amdgcn_s_barrier()
#define PG8_SCHED __builtin_amdgcn_sched_barrier(0)
#define PG8_TROW(_i) (16 * ((wid + 8 * (_i)) >> 1) + (lane >> 2))
#define PG8_TOKOFF(dst0, dst1, tk) do { _Pragma("unroll") for (int _i = 0; _i < 2; ++_i) { dst0[_i] = (int)(tk)[PG8_TROW(_i)] * ldaB + voffA[0]; dst1[_i] = (int)(tk)[HALF + PG8_TROW(_i)] * ldaB + voffA[0]; } } while (0)
    Unit cur, nxt; int ui = 0;
    if (!S.next(0, cur)) return;
    f32x4 acc[2][2][4][2];
    E.init(acc, cur, wc, fq);
    v8i_t At[4], B0[2], B1[2];
    unsigned cA = ufl(cur.ao), cB = ufl(cur.bo);
    int crot = __builtin_amdgcn_readfirstlane(cur.rp) * (nt >> 1);
#define PG8_KOF(t_, r_) ((unsigned)(((t_) + (r_)) % nt) * kstep)
    bool act = ((cur.hmask >> wr) & 1) != 0;
    if constexpr (GATHER) { const LAS unsigned short* tk = S.tok(0); PG8_TOKOFF(vg0, vg1, tk); } else { vg0[0] = vg0[1] = vg1[0] = vg1[1] = 0; }
    { const unsigned q0 = PG8_KOF(0, crot), q1 = PG8_KOF(1, crot);
    PG8_STAGE(PG8_SB(0, 0), rsB, cB + q0, voffB); PG8_STAGE(PG8_SB(0, 1), rsB, cB + hstep + q0, voffB); PG8_STAGE_A(PG8_SA(0, 0), cA, q0, 0); PG8_STAGE_A(PG8_SA(0, 1), cA, q0, 1);
    if (wr == 1) PG8_BAR;
    PG8_WAIT_V(2); PG8_BAR;
    PG8_STAGE(PG8_SB(1, 0), rsB, cB + q1, voffB); PG8_STAGE_A(PG8_SA(1, 0), cA, q1, 0); PG8_STAGE(PG8_SB(1, 1), rsB, cB + hstep + q1, voffB); }
    PG8_WAIT_V(6); PG8_BAR;
    for (;;) {
        const bool has_next = S.next(ui + 1, nxt);
        const unsigned nA = ufl(has_next ? nxt.ao : cA), nB = ufl(has_next ? nxt.bo : cB);
        const int nrot = has_next ? __builtin_amdgcn_readfirstlane(nxt.rp) * (nt >> 1) : crot;
#pragma clang loop unroll(disable)
        for (int t = 0; t < nt; t += 2) {
            const bool last = (t == nt - 2);
            const unsigned k1 = PG8_KOF(t + 1, crot);
            const unsigned a2 = last ? nA : cA, k2 = last ? PG8_KOF(0, nrot) : PG8_KOF(t + 2, crot), b2 = (last ? nB : cB) + k2;
            const unsigned k3 = last ? PG8_KOF(1, nrot) : PG8_KOF(t + 3, crot), b3 = (last ? nB : cB) + k3;
            if constexpr (GATHER) { if (last && has_next) { const LAS unsigned short* tk = S.tok(ui + 1);
#pragma unroll
                for (int _i = 0; _i < 2; ++_i) vg0[_i] = (int)tk[PG8_TROW(_i)] * ldaB + voffA[0]; } }
            PG8_LDB(B0, 0, 0); PG8_LDB(B1, 0, 1); PG8_SCHED; PG8_LDA(At, 0, 0); PG8_STAGE_A(PG8_SA(1, 1), cA, k1, 1);
            PG8_WAIT_V(8); PG8_WAIT_L(0); PG8_BAR; PG8_MMA(0, 0, At, B0); PG8_MMA(0, 1, At, B1); PG8_BAR; PG8_SCHED;
            if constexpr (GATHER) { if (last && has_next) { const LAS unsigned short* tk = S.tok(ui + 1);
#pragma unroll
                for (int _i = 0; _i < 2; ++_i) vg1[_i] = (int)tk[HALF + PG8_TROW(_i)] * ldaB + voffA[0]; } }
            PG8_LDA(At, 0, 1); PG8_STAGE(PG8_SB(0, 0), rsB, b2, voffB); PG8_STAGE(PG8_SB(0, 1), rsB, b2 + hstep, voffB); PG8_STAGE_A(PG8_SA(0, 0), a2, k2, 0);
            PG8_WAIT_V(8); PG8_WAIT_L(0); PG8_BAR; PG8_MMA(1, 0, At, B0); PG8_MMA(1, 1, At, B1); PG8_BAR; PG8_SCHED;
            PG8_LDB(B0, 1, 0); PG8_LDB(B1, 1, 1); PG8_SCHED; PG8_LDA(At, 1, 0); PG8_STAGE_A(PG8_SA(0, 1), a2, k2, 1);
            PG8_WAIT_V(8); PG8_WAIT_L(0); PG8_BAR; PG8_MMA(0, 0, At, B0); PG8_MMA(0, 1, At, B1); PG8_BAR; PG8_SCHED;
            PG8_LDA(At, 1, 1); PG8_STAGE(PG8_SB(1, 0), rsB, b3, voffB); PG8_STAGE(PG8_SB(1, 1), rsB, b3 + hstep, voffB); PG8_STAGE_A(PG8_SA(1, 0), a2, k3, 0);
            PG8_WAIT_V(8); PG8_WAIT_L(0); PG8_BAR; PG8_MMA(1, 0, At, B0); PG8_MMA(1, 1, At, B1); PG8_BAR; PG8_SCHED;
        }
        if constexpr (ALIGN) { if (wr == 0) PG8_BAR; }
        if (act) E(acc, cur, wr, wc, fr, fq);
        if (!has_next) break;
        E.init(acc, nxt, wc, fq);
        cur = nxt; cA = nA; cB = nB; crot = nrot; ++ui; act = ((cur.hmask >> wr) & 1) != 0;
        if constexpr (ALIGN) { if (wr == 1) PG8_BAR; }
    }
    PG8_WAIT_V(0);
    if constexpr (!ALIGN) { if (wr == 0) PG8_BAR; }
    PG8_BAR;
#undef PG8_SA
#undef PG8_SB
#undef PG8_STAGE
#undef PG8_STAGE_A
#undef PG8_LDA
#undef PG8_LDB
#undef PG8_MMA
#undef PG8_WAIT_V
#undef PG8_WAIT_L
#undef PG8_BAR
#undef PG8_SCHED
#undef PG8_TOKOFF
#undef PG8_TROW
#undef PG8_KOF
}

struct EpiStore {
    static constexpr int scale_a = 0x7f7f7f7f, scale_b = 0x7f7f7f7f;
    __device__ __forceinline__ void init(f32x4 (&acc)[2][2][4][2], const Unit&, int, int) const { acc_zero(acc); }
    bf16_t* O; int ldc;
    __device__ __forceinline__ void operator()(const f32x4 (&acc)[2][2][4][2], const Unit& u, int wr, int wc, int fr, int fq) const {
        const int row0 = u.pm * BM + wr * 64 + fr, col0 = u.pn * BM + wc * 32 + 8 * fq;
#pragma unroll
        for (int ai = 0; ai < 2; ++ai)
#pragma unroll
            for (int m = 0; m < 4; ++m) { bf16_t* rowp = O + (size_t)(row0 + ai * HALF + m * 16) * ldc + col0;
#pragma unroll
                for (int bj = 0; bj < 2; ++bj) { const f32x4 v0 = acc[ai][bj][m][0], v1 = acc[ai][bj][m][1];
                    u32x4 w; w.x = cvt_pk_bf16(v0[0], v0[1]); w.y = cvt_pk_bf16(v0[2], v0[3]); w.z = cvt_pk_bf16(v1[0], v1[1]); w.w = cvt_pk_bf16(v1[2], v1[3]);
                    *(u32x4*)(rowp + bj * HALF) = w; } }
    }
};
struct EpiGlu {
    static constexpr int scale_a = 0x7f7f7f7f, scale_b = 0x7f7f7f7f;
    __device__ __forceinline__ void init(f32x4 (&acc)[2][2][4][2], const Unit&, int, int) const { acc_zero(acc); }
    const bf16_t* Y5; bf16_t* O; const float* bias;
    __device__ __forceinline__ void operator()(const f32x4 (&acc)[2][2][4][2], const Unit& u, int wr, int wc, int fr, int fq) const {
        const int row0 = u.pm * BM + wr * 64 + fr, col0 = u.pn * BM + wc * 32 + 8 * fq;
        f32x4 bv[2][2];
#pragma unroll
        for (int bj = 0; bj < 2; ++bj)
#pragma unroll
            for (int n = 0; n < 2; ++n) bv[bj][n] = *(const f32x4*)(bias + col0 + bj * HALF + 4 * n);
#pragma unroll
        for (int ai = 0; ai < 2; ++ai) {
            u32x4 yv[4][2];
#pragma unroll
            for (int m = 0; m < 4; ++m)
#pragma unroll
                for (int bj = 0; bj < 2; ++bj) yv[m][bj] = *(const u32x4*)(Y5 + (size_t)(row0 + ai * HALF + m * 16) * 512 + col0 + bj * HALF);
#pragma unroll
            for (int m = 0; m < 4; ++m) { const int row = row0 + ai * HALF + m * 16;
#pragma unroll
                for (int bj = 0; bj < 2; ++bj) { const f32x4 z0 = acc[ai][bj][m][0] + bv[bj][0], z1 = acc[ai][bj][m][1] + bv[bj][1];
                    const u32x4 y = yv[m][bj];
                    float o[8];
                    o[0] = bf2f(y.x & 0xffffu) * sigmoidf_(z0[0]); o[1] = bf2f(y.x >> 16) * sigmoidf_(z0[1]); o[2] = bf2f(y.y & 0xffffu) * sigmoidf_(z0[2]); o[3] = bf2f(y.y >> 16) * sigmoidf_(z0[3]);
                    o[4] = bf2f(y.z & 0xffffu) * sigmoidf_(z1[0]); o[5] = bf2f(y.z >> 16) * sigmoidf_(z1[1]); o[6] = bf2f(y.w & 0xffffu) * sigmoidf_(z1[2]); o[7] = bf2f(y.w >> 16) * sigmoidf_(z1[3]);
                    u32x4 w; w.x = cvt_pk_bf16(o[0], o[1]); w.y = cvt_pk_bf16(o[2], o[3]); w.z = cvt_pk_bf16(o[4], o[5]); w.w = cvt_pk_bf16(o[6], o[7]);
                    *(u32x4*)(O + (size_t)row * 1024 + 512 + col0 + bj * HALF) = w; } } }
    }
};
constexpr int XT_TOK = 131072;
constexpr int XT_PS = 139264 + 128;
constexpr int XT_BIAS = 147456;
struct ExpSched {
    const char* A; const char* W; LAS unsigned char* lds; int nT, nN, G, c, ldaB, ldbB; unsigned estride;
    __device__ __forceinline__ bool next(int i, Unit& u) const { int pm, pn; const int nwg = nT * nN, R = nwg / G, rem = nwg - R * G; long L = (long)i * G + c; int hm = 3;
        if (i == R && 2 * rem <= G) { if (c >= 2 * rem) return false; L = (long)R * G + (c >> 1); hm = 1 << (c & 1); }
        if (!order_map_l(L, nT, nN, pm, pn)) return false;
        const int e = __builtin_amdgcn_readfirstlane((int)*(const LAS unsigned char*)(lds + XT_PS + 260 + pm));
        u.pm = pm; u.pn = pn; u.e = e; u.ui = i; u.hmask = hm; u.rp = (pm + pn) & 1; u.ao = (unsigned)pm * BM * ldaB; u.bo = (unsigned)e * estride + (unsigned)pn * BM * ldbB; return true; }
    int ident;
    __device__ __forceinline__ const LAS unsigned short* tok(int i) const { return (const LAS unsigned short*)(lds + XT_TOK) + (ident ? 0 : i * 256); }
    __device__ __forceinline__ const char* abuf() const { return A; }
    __device__ __forceinline__ const char* bbuf() const { return W; }
};
struct EpiSwiglu {
    static constexpr int scale_a = SC_ONE, scale_b = SC_W8;
    unsigned char* O; const LAS float* bias;
    __device__ __forceinline__ void init(f32x4 (&acc)[2][2][4][2], const Unit& u, int wc, int fq) const {
#pragma unroll
        for (int bj = 0; bj < 2; ++bj)
#pragma unroll
            for (int n = 0; n < 2; ++n) { const f32x4 bv = *(const LAS f32x4*)(bias + u.ui * 256 + bj * HALF + wc * 32 + 8 * fq + 4 * n);
#pragma unroll
                for (int ai = 0; ai < 2; ++ai)
#pragma unroll
                    for (int m = 0; m < 4; ++m) acc[ai][bj][m][n] = bv; }
    }
    __device__ __forceinline__ void operator()(const f32x4 (&acc)[2][2][4][2], const Unit& u, int wr, int wc, int fr, int fq) const {
        const int row0 = u.pm * BM + wr * 64 + fr, col0 = u.pn * HALF + wc * 32 + 8 * fq;
#pragma unroll
        for (int ai = 0; ai < 2; ++ai)
#pragma unroll
            for (int m = 0; m < 4; ++m) { const int row = row0 + ai * HALF + m * 16; float o[8];
#pragma unroll
                for (int n = 0; n < 2; ++n) { const f32x4 g4 = acc[ai][0][m][n], u4 = acc[ai][1][m][n];
#pragma unroll
                    for (int i = 0; i < 4; ++i) { const float g = fminf(g4[i], 7.f), up = __builtin_amdgcn_fmed3f(u4[i], -7.f, 7.f);
                        const float sg = g * __builtin_amdgcn_rcpf(1.f + __builtin_amdgcn_exp2f(-2.4554669595930157f * g));
                        o[4 * n + i] = fmaf(up, ACT8_SCALE, ACT8_SCALE) * sg; } }
                v2u w; w.x = (unsigned)__builtin_amdgcn_cvt_pk_fp8_f32(o[2], o[3], __builtin_amdgcn_cvt_pk_fp8_f32(o[0], o[1], 0, false), true);
                w.y = (unsigned)__builtin_amdgcn_cvt_pk_fp8_f32(o[6], o[7], __builtin_amdgcn_cvt_pk_fp8_f32(o[4], o[5], 0, false), true);
                *(v2u*)(O + (size_t)row * 1024 + col0) = w; }
    }
};
__device__ __forceinline__ v2u xchg16(v2u v) { v2u r; r.x = (unsigned)__builtin_amdgcn_ds_swizzle((int)v.x, 0x401f); r.y = (unsigned)__builtin_amdgcn_ds_swizzle((int)v.y, 0x401f); return r; }
struct EpiDown {
    static constexpr int scale_a = SC_ACT8, scale_b = SC_W8;
    unsigned char* O; const LAS float* bias;
    __device__ __forceinline__ void init(f32x4 (&acc)[2][2][4][2], const Unit& u, int wc, int fq) const {
#pragma unroll
        for (int bj = 0; bj < 2; ++bj)
#pragma unroll
            for (int n = 0; n < 2; ++n) { const f32x4 bv = *(const LAS f32x4*)(bias + u.ui * 256 + bj * HALF + wc * 32 + 8 * fq + 4 * n);
#pragma unroll
                for (int ai = 0; ai < 2; ++ai)
#pragma unroll
                    for (int m = 0; m < 4; ++m) acc[ai][bj][m][n] = bv; }
    }
    __device__ __forceinline__ void operator()(const f32x4 (&acc)[2][2][4][2], const Unit& u, int wr, int wc, int fr, int fq) const {
        const int row0 = u.pm * BM + wr * 64 + fr, col0 = u.pn * BM + wc * 32 + 8 * fq; const bool odd = (fq & 1) != 0;
        unsigned char* base = O + (size_t)row0 * 1024 + (odd ? col0 - 8 + HALF : col0);
#pragma unroll
        for (int ai = 0; ai < 2; ++ai)
#pragma unroll
            for (int m = 0; m < 4; ++m) { v2u w[2];
#pragma unroll
                for (int bj = 0; bj < 2; ++bj) { const f32x4 v0 = acc[ai][bj][m][0] * Y8_SCALE, v1 = acc[ai][bj][m][1] * Y8_SCALE;
                    w[bj].x = pk4_fp8(v0[0], v0[1], v0[2], v0[3]); w[bj].y = pk4_fp8(v1[0], v1[1], v1[2], v1[3]); }
                const v2u got = xchg16(odd ? w[0] : w[1]);
                const v4u out = odd ? (v4u){got.x, got.y, w[1].x, w[1].y} : (v4u){w[0].x, w[0].y, got.x, got.y};
                *(v4u*)(base + (size_t)(ai * HALF + m * 16) * 1024) = out; }
    }
};
struct S5Sched {
    const char* UX; const char* Mt; unsigned mstride; int c, ldaB, ldbB;
    __device__ __forceinline__ bool next(int i, Unit& u) const { const int L = c - 128; if (i > 0 || L < 0) return false;
        const int pm = (L >> 3) & 3, g = (L & 7) + 8 * (L >> 5);
        u.pm = pm; u.pn = 0; u.e = g; u.ui = 0; u.hmask = 3; u.rp = 0; u.ao = (unsigned)(g * 1024 + pm * 256) * 768u; u.bo = (unsigned)g * mstride; return true; }
    __device__ __forceinline__ const LAS unsigned short* tok(int) const { return nullptr; }
    __device__ __forceinline__ const char* abuf() const { return UX; }
    __device__ __forceinline__ const char* bbuf() const { return Mt; }
};
struct EpiDX {
    static constexpr int scale_a = SC_ONE, scale_b = SC_ONE;
    __device__ __forceinline__ void init(f32x4 (&acc)[2][2][4][2], const Unit&, int, int) const { acc_zero(acc); }
    float* O;
    __device__ __forceinline__ void operator()(const f32x4 (&acc)[2][2][4][2], const Unit& u, int wr, int wc, int fr, int fq) const {
        const int row0 = u.e * 1024 + u.pm * BM + wr * 64 + fr, col0 = wc * 32 + 8 * fq;
#pragma unroll
        for (int ai = 0; ai < 2; ++ai)
#pragma unroll
            for (int m = 0; m < 4; ++m) { float* rowp = O + (size_t)(row0 + ai * HALF + m * 16) * 128 + col0;
                *(f32x4*)rowp = acc[ai][0][m][0]; *(f32x4*)(rowp + 4) = acc[ai][0][m][1]; }
    }
};
struct EpiS5Y {
    static constexpr int scale_a = SC_ONE, scale_b = SC_ONE;
    __device__ __forceinline__ void init(f32x4 (&acc)[2][2][4][2], const Unit&, int, int) const { acc_zero(acc); }
    bf16_t* Y5;
    __device__ __forceinline__ void operator()(const f32x4 (&acc)[2][2][4][2], const Unit& u, int wr, int wc, int fr, int fq) const {
        const int g = u.e, r0 = u.pm * BM + wr * 64 + fr;
#pragma unroll
        for (int bj = 0; bj < 2; ++bj) { const int col = bj * HALF + wc * 32 + 8 * fq, t = col >> 4, h0 = col & 15;
#pragma unroll
            for (int ai = 0; ai < 2; ++ai)
#pragma unroll
                for (int m = 0; m < 4; ++m) { const int r = r0 + ai * HALF + m * 16;
                    const f32x4 v0 = acc[ai][bj][m][0], v1 = acc[ai][bj][m][1];
                    u32x4 w; w.x = cvt_pk_bf16(gelu_tanh(v0[0]), gelu_tanh(v0[1])); w.y = cvt_pk_bf16(gelu_tanh(v0[2]), gelu_tanh(v0[3]));
                    w.z = cvt_pk_bf16(gelu_tanh(v1[0]), gelu_tanh(v1[1])); w.w = cvt_pk_bf16(gelu_tanh(v1[2]), gelu_tanh(v1[3]));
                    *(u32x4*)(Y5 + ((size_t)(r * 16 + t) * 512 + g * 16 + h0)) = w; } }
    }
};
struct EpiProj {
    static constexpr int scale_a = SC_ONE, scale_b = SC_ONE;
    __device__ __forceinline__ void init(f32x4 (&acc)[2][2][4][2], const Unit&, int, int) const { acc_zero(acc); }
    bf16_t* O; bf16_t* UX;
    __device__ __forceinline__ void operator()(const f32x4 (&acc)[2][2][4][2], const Unit& u, int wr, int wc, int fr, int fq) const {
        const int row0 = u.pm * BM + wr * 64 + fr, col0 = u.pn * BM + wc * 32 + 8 * fq;
#pragma unroll
        for (int ai = 0; ai < 2; ++ai)
#pragma unroll
            for (int m = 0; m < 4; ++m) { const int row = row0 + ai * HALF + m * 16;
#pragma unroll
                for (int bj = 0; bj < 2; ++bj) { const f32x4 v0 = acc[ai][bj][m][0], v1 = acc[ai][bj][m][1]; const int col = col0 + bj * HALF;
                    u32x4 w; w.x = cvt_pk_bf16(v0[0], v0[1]); w.y = cvt_pk_bf16(v0[2], v0[3]); w.z = cvt_pk_bf16(v1[0], v1[1]); w.w = cvt_pk_bf16(v1[2], v1[3]);
                    if (col < 1536) *(u32x4*)(O + (size_t)row * 2048 + col) = w;
                    else { const int cu = col - 1536, g = cu >> 4, h0 = cu & 15; *(u32x4*)(UX + ((size_t)(g * 1024 + (row >> 4)) * 384 + (row & 15) * 16 + h0)) = w; } } }
    }
};
}

struct Args { const float* in[29]; float* out; unsigned char* ws; int ph_lo, ph_hi; };
enum { I_X = 0, I_C, I_ADAW, I_ADAB, I_MIXPRE, I_MIXPOST, I_FFNPRE, I_FFNPOST, I_WIN, I_WALPHA, I_BALPHA, I_GLANORM,
       I_LRE, I_LIM, I_LOGDT, I_BRE, I_BIM, I_CRE, I_CIM, I_SD, I_GLUW, I_GLUB, I_WOUT, I_RW, I_RB, I_WGU, I_BGU, I_WDN, I_BDN };

struct Ctx { int tid, lane, wave, bid, G, gw, ngw, gtid, ngt; LAS unsigned char* lds; };

template <int MODE> __device__ __forceinline__ int rowmap(int n) {
    if (MODE == 1) { return n < 1536 ? n : (n < 1552 ? -1 : n - 16); }
    if (MODE == 2) { const int jj = n & 1023, up = n >> 10; return 256 * (jj >> 7) + 128 * up + (jj & 127); }
    return n;
}
template <int MODE> __device__ __forceinline__ void transpose_item(const float* W, int K, int N, int kb, int nb, bf16_t* dst, int lane) {
    const int n = nb * 64 + lane, nn = n < N ? n : N - 1;
    const float* src = W + (size_t)(kb * 64) * N + nn;
    float v[64];
#pragma unroll
    for (int i = 0; i < 64; ++i) v[i] = src[(size_t)i * N];
    const int row = n < N ? rowmap<MODE>(n) : -1;
    if (row >= 0) {
        bf16_t* p = dst + (size_t)row * K + kb * 64;
#pragma unroll
        for (int c = 0; c < 8; ++c) { v4u o; o.x = pk2(v[8 * c], v[8 * c + 1]); o.y = pk2(v[8 * c + 2], v[8 * c + 3]); o.z = pk2(v[8 * c + 4], v[8 * c + 5]); o.w = pk2(v[8 * c + 6], v[8 * c + 7]);
            *(v4u*)(p + 8 * c) = o; }
    }
}
struct XItem { const float* W; unsigned char* dst; int N, kt, n0, mode; };
__device__ __forceinline__ XItem xitem(const Args& a, int it) {
    XItem x;
    if (it < 2048) { const int e = it >> 6, r = it & 63; x.W = a.in[I_WGU] + (size_t)e * 1024 * 2048; x.dst = (unsigned char*)(a.ws + WS_GU_T) + (size_t)e * 2048 * 1024; x.N = 2048; x.kt = r >> 3; x.n0 = (r & 7) * 256; x.mode = 2; }
    else { const int i2 = it - 2048, e = i2 >> 5, r = i2 & 31; x.W = a.in[I_WDN] + (size_t)e * 1024 * 1024; x.dst = (unsigned char*)(a.ws + WS_DN_T) + (size_t)e * 1024 * 1024; x.N = 1024; x.kt = r >> 2; x.n0 = (r & 3) * 256; x.mode = 0; }
    return x;
}
constexpr int WI_P0 = 2048, WI_BAR = 1792, WI_NBAR = 9, WI_P3 = WI_P0 + WI_BAR * WI_NBAR, WI_P5 = WI_P3 + 1024, WI_P6 = WI_P5 + 3072, WI_END = 24576;
__device__ __forceinline__ void wconv_item(const Args& a, LAS unsigned char* T, int wi, int lane) {
    const XItem x = xitem(a, wi >> 3); const int n0 = x.n0 + 32 * (wi & 7), r8 = lane >> 3, c4 = lane & 7;
    f32x4 v[16];
#pragma unroll
    for (int i = 0; i < 16; ++i) v[i] = __builtin_nontemporal_load((const f32x4*)(x.W + (size_t)(x.kt * 128 + 16 * r8 + i) * x.N + n0 + 4 * c4));
#pragma unroll
    for (int j = 0; j < 4; ++j) { v4u o;
        o.x = pk4_fp8(v[0][j] * W8_SCALE, v[1][j] * W8_SCALE, v[2][j] * W8_SCALE, v[3][j] * W8_SCALE); o.y = pk4_fp8(v[4][j] * W8_SCALE, v[5][j] * W8_SCALE, v[6][j] * W8_SCALE, v[7][j] * W8_SCALE);
        o.z = pk4_fp8(v[8][j] * W8_SCALE, v[9][j] * W8_SCALE, v[10][j] * W8_SCALE, v[11][j] * W8_SCALE); o.w = pk4_fp8(v[12][j] * W8_SCALE, v[13][j] * W8_SCALE, v[14][j] * W8_SCALE, v[15][j] * W8_SCALE);
        *(LAS v4u*)(T + (4 * c4 + j) * 144 + 16 * r8) = o; }
    asm volatile("s_waitcnt lgkmcnt(0)" ::: "memory");
#pragma unroll
    for (int q = 0; q < 4; ++q) { const int idx = lane + 64 * q, n = idx >> 3, ch = idx & 7;
        const int row = x.mode == 2 ? rowmap<2>(n0 + n) : n0 + n;
        *(v4u*)(x.dst + (size_t)row * 1024 + x.kt * 128 + 16 * ch) = *(const LAS v4u*)(T + n * 144 + 16 * ch); }
    asm volatile("s_waitcnt lgkmcnt(0)" ::: "memory");
}
__device__ __forceinline__ void xcd_barrier_conv(const XcdBarrier& b, const Args& a, const Ctx& c, int bi) {
    asm volatile("s_waitcnt vmcnt(0)" ::: "memory");
    __syncthreads();
    if (c.wave == 0) {
      if (threadIdx.x == 0) {
        unsigned* bar = b.bar;
        __builtin_amdgcn_s_waitcnt(0);
        unsigned nloc = b.st[0], nx = b.st[1];
        if (nloc == 0u) { xcd_barrier_complete(bar, b.x, nloc, nx); b.st[0] = nloc; b.st[1] = nx; }
        const unsigned old = xb_add(&bar[XB_XSUB(b.x)], 1u);
        const unsigned gen = old / nloc;
        if (old + 1u == (gen + 1u) * nloc) {
            __builtin_amdgcn_fence(__ATOMIC_RELEASE, "agent");
            asm volatile("s_waitcnt vmcnt(0)" ::: "memory");
            const unsigned og = xb_add(&bar[XB_TOP], 1u);
            const unsigned tg = og / nx;
            if (og + 1u == (tg + 1u) * nx) xb_add(&bar[XB_TOPGEN], 1u);
            else XB_SPIN(xb_ld(&bar[XB_TOPGEN]) == tg, bar);
            __builtin_amdgcn_fence(__ATOMIC_ACQUIRE, "agent");
            xb_add(&bar[XB_XGEN(b.x)], 1u);
            asm volatile("s_waitcnt vmcnt(0)" ::: "memory");
        } else {
            __builtin_amdgcn_fence(__ATOMIC_ACQUIRE, "agent");
            XB_SPIN(xb_ld(&bar[XB_XGEN(b.x)]) == gen, bar);
            asm volatile("s_waitcnt vmcnt(0)" ::: "memory");
        }
      }
    } else if (bi >= 0 && bi < WI_NBAR) {
        wconv_item(a, c.lds + c.wave * 5120, WI_P0 + WI_BAR * bi + c.bid * 7 + (c.wave - 1), c.lane);
    }
    __syncthreads();
}
__device__ __forceinline__ void ph0_prologue(const Args& a, const Ctx& c) {
    if (c.bid < 192) {
        LAS float* sc = (LAS float*)c.lds;
        LAS float* part = (LAS float*)(c.lds + 32768);
        const float* cin = a.in[I_C];
        for (int i = c.tid; i < 8 * 1024; i += NTHR) { const int b = i >> 10, k = i & 1023; const float x = cin[i]; sc[k * 8 + b] = x * sigmoidf_(x); }
        const int cg = c.tid & 7, rg = c.tid >> 3, n0 = c.bid * 32;
        f32x4 w[16];
#pragma unroll
        for (int s2 = 0; s2 < 16; ++s2) w[s2] = __builtin_nontemporal_load((const f32x4*)(a.in[I_ADAW] + (size_t)(rg + 64 * s2) * 6144 + n0 + 4 * cg));
        __syncthreads();
        f32x4 acc[8];
#pragma unroll
        for (int b = 0; b < 8; ++b) acc[b] = (f32x4){0.f, 0.f, 0.f, 0.f};
#pragma unroll
        for (int s2 = 0; s2 < 16; ++s2) { const int k = rg + 64 * s2; const f32x4 s0 = *(const LAS f32x4*)(sc + k * 8), s1 = *(const LAS f32x4*)(sc + k * 8 + 4);
            acc[0] += w[s2] * s0.x; acc[1] += w[s2] * s0.y; acc[2] += w[s2] * s0.z; acc[3] += w[s2] * s0.w;
            acc[4] += w[s2] * s1.x; acc[5] += w[s2] * s1.y; acc[6] += w[s2] * s1.z; acc[7] += w[s2] * s1.w; }
#pragma unroll
        for (int b = 0; b < 8; ++b) *(LAS f32x4*)(part + (rg * 8 + b) * 32 + 4 * cg) = acc[b];
        __syncthreads();
        if (c.tid < 256) { const int b = c.tid >> 5, cl = c.tid & 31; float sum = a.in[I_ADAB][n0 + cl];
            for (int r2 = 0; r2 < 64; ++r2) sum += part[(r2 * 8 + b) * 32 + cl];
            ((float*)(a.ws + WS_MOD))[b * 6144 + n0 + cl] = sum; }
        __syncthreads();
    }
    if (c.bid >= 224 && c.wave == 7) {
        const int sx = (c.bid - 224) * 64 + c.lane, g = sx / SP;
        f32x4 brv[4], biv[4];
#pragma unroll
        for (int q = 0; q < 4; ++q) { brv[q] = *(const f32x4*)(a.in[I_BRE] + sx * SC + 4 * q); biv[q] = *(const f32x4*)(a.in[I_BIM] + sx * SC + 4 * q); }
        const double lr = a.in[I_LRE][sx], li = a.in[I_LIM][sx], dt = exp((double)a.in[I_LOGDT][g]);
        const double mag = exp(lr * dt), abr = mag * cos(li * dt), abi = mag * sin(li * dt), den = lr * lr + li * li;
        const double fr = ((abr - 1.0) * lr + abi * li) / den, fi = (abi * lr - (abr - 1.0) * li) / den;
        float* AB = (float*)(a.ws + WS_S5AB); *(f32x2_t*)(AB + sx * 2) = (f32x2_t){(float)abr, (float)abi};
        { float* AP = (float*)(a.ws + WS_APOW); double pr = 1.0, pi = 0.0;
            for (int n = 0; n <= 16; ++n) { *(f32x2_t*)(AP + ((g * 17 + n) * 64 + (sx & 63)) * 2) = (f32x2_t){(float)pr, (float)pi};
                const double tr = pr * abr - pi * abi, ti = pr * abi + pi * abr; pr = tr; pi = ti; }
            double sr = abr, si = abi;
            for (int q = 0; q < 8; ++q) { const double tr = sr * sr - si * si, ti = 2.0 * sr * si; sr = tr; si = ti; }
            float* A2 = (float*)(a.ws + WS_A256); *(f32x2_t*)(A2 + sx * 2) = (f32x2_t){(float)sr, (float)si}; }
        float* BB = (float*)(a.ws + WS_S5BB);
#pragma unroll
        for (int q = 0; q < 4; ++q) { f32x4 o0, o1;
#pragma unroll
            for (int j = 0; j < 4; ++j) { const double br = brv[q][j], bi = biv[q][j]; const float vr = (float)(fr * br - fi * bi), vi = (float)(fr * bi + fi * br);
                if (j < 2) { o0[2 * j] = vr; o0[2 * j + 1] = vi; } else { o1[2 * (j - 2)] = vr; o1[2 * (j - 2) + 1] = vi; } }
            *(f32x4*)(BB + (sx * SC + 4 * q) * 2) = o0; *(f32x4*)(BB + (sx * SC + 4 * q) * 2 + 4) = o1; }
    }
    { constexpr int IT_WIN = 16 * 33, IT_GLU = 8 * 8, IT_WOUT = 16 * 16, NITEMS = IT_WIN + IT_GLU + IT_WOUT;
        for (int it = (c.bid >= 192 ? (c.bid - 192) * NWAVES + c.wave : NITEMS); it < NITEMS; it += 64 * NWAVES) { int r = it;
            if (r < IT_WIN) { transpose_item<1>(a.in[I_WIN], 1024, NIN, r / 33, r % 33, (bf16_t*)(a.ws + WS_WIN_T), c.lane); continue; } r -= IT_WIN;
            if (r < IT_GLU) { transpose_item<0>(a.in[I_GLUW], 512, 512, r / 8, r % 8, (bf16_t*)(a.ws + WS_GLU_T), c.lane); continue; } r -= IT_GLU;
            transpose_item<0>(a.in[I_WOUT], 1024, 1024, r / 16, r % 16, (bf16_t*)(a.ws + WS_WOUT_T), c.lane); } }
    for (int wi = c.gw; wi < WI_P0; wi += c.ngw) wconv_item(a, c.lds + c.wave * 5120, wi, c.lane);
    __syncthreads();
}

__device__ __forceinline__ void ph1_norm1(const Args& a, const Ctx& c) {
    const float* mod = (const float*)(a.ws + WS_MOD);
    bf16_t* HN = (bf16_t*)(a.ws + WS_HN); float* ALR = (float*)(a.ws + WS_ALR);
    constexpr int PITCH = 2064, LO = 16 * PITCH, PART = 2 * LO;
    s16x8 wh[4], wl[4];
#pragma unroll
    for (int ks = 0; ks < 4; ++ks) { float wv[8];
#pragma unroll
        for (int j = 0; j < 8; ++j) wv[j] = a.in[I_WIN][(size_t)(128 * c.wave + 32 * ks + 8 * (c.lane >> 4) + j) * NIN + 1536 + (c.lane & 15)];
        unsigned hh[4], ll[4];
#pragma unroll
        for (int j = 0; j < 4; ++j) { hh[j] = pk2(wv[2 * j], wv[2 * j + 1]); ll[j] = pk2(wv[2 * j] - bf2f(hh[j] & 0xffffu), wv[2 * j + 1] - bf2f(hh[j] >> 16)); }
        wh[ks] = __builtin_bit_cast(s16x8, (v4u){hh[0], hh[1], hh[2], hh[3]}); wl[ks] = __builtin_bit_cast(s16x8, (v4u){ll[0], ll[1], ll[2], ll[3]}); }
    f32x4 xb[2][2][4];
#define P1_LOAD(buf, it_) do { const int r0_ = 2 * c.gw + 2 * c.ngw * (it_); _Pragma("unroll") for (int r = 0; r < 2; ++r) _Pragma("unroll") for (int j = 0; j < 4; ++j) \
        xb[buf][r][j] = __builtin_nontemporal_load((const f32x4*)(a.in[I_X] + (size_t)(r0_ + r) * D) + c.lane + 64 * j); } while (0)
    P1_LOAD(0, 0);
#pragma unroll
    for (int it = 0; it < 4; ++it) { const int row0 = 2 * c.gw + 2 * c.ngw * it, cbuf = it & 1;
        const int b = row0 / NT;
        f32x4 gv[4], shv[4], scv[4];
#pragma unroll
        for (int j = 0; j < 4; ++j) { const int col = 4 * c.lane + 256 * j; gv[j] = *(const f32x4*)(a.in[I_MIXPRE] + col); shv[j] = *(const f32x4*)(mod + b * 6144 + col); scv[j] = *(const f32x4*)(mod + b * 6144 + 1024 + col) + 1.f; }
        if (it + 1 < 4) P1_LOAD((it + 1) & 1, it + 1);
#pragma unroll
        for (int r = 0; r < 2; ++r) { float ss = 0.f;
#pragma unroll
            for (int j = 0; j < 4; ++j) { const f32x4 v = xb[cbuf][r][j]; ss += (v.x * v.x + v.y * v.y) + (v.z * v.z + v.w * v.w); }
            const float rstd = rsqrtf(wave_sum(ss) * (1.f / D) + EPS);
#pragma unroll
            for (int j = 0; j < 4; ++j) { const int col = 4 * c.lane + 256 * j;
                const f32x4 v = xb[cbuf][r][j] * rstd * gv[j] * scv[j] + shv[j];
                const unsigned h0 = pk2(v.x, v.y), h1 = pk2(v.z, v.w);
                *(v2u*)(HN + (size_t)(row0 + r) * D + col) = (v2u){h0, h1};
                const unsigned l0 = pk2(v.x - bf2f(h0 & 0xffffu), v.y - bf2f(h0 >> 16)), l1 = pk2(v.z - bf2f(h1 & 0xffffu), v.w - bf2f(h1 >> 16));
                const int off = (2 * c.wave + r) * PITCH + col * 2;
                *(LAS v2u*)(c.lds + off) = (v2u){h0, h1}; *(LAS v2u*)(c.lds + LO + off) = (v2u){l0, l1}; } }
        __syncthreads();
        { f32x4 pacc = (f32x4){0.f, 0.f, 0.f, 0.f};
#pragma unroll
            for (int ks = 0; ks < 4; ++ks) { const int aoff = (c.lane & 15) * PITCH + (128 * c.wave + 32 * ks + 8 * (c.lane >> 4)) * 2;
                const s16x8 ahi = *(const LAS s16x8*)(c.lds + aoff), alo = *(const LAS s16x8*)(c.lds + LO + aoff);
                pacc = __builtin_amdgcn_mfma_f32_16x16x32_bf16(ahi, wh[ks], pacc, 0, 0, 0);
                pacc = __builtin_amdgcn_mfma_f32_16x16x32_bf16(ahi, wl[ks], pacc, 0, 0, 0);
                pacc = __builtin_amdgcn_mfma_f32_16x16x32_bf16(alo, wh[ks], pacc, 0, 0, 0); }
            LAS float* part = (LAS float*)(c.lds + PART) + c.wave * 256;
#pragma unroll
            for (int r = 0; r < 4; ++r) part[(4 * (c.lane >> 4) + r) * 16 + (c.lane & 15)] = pacc[r]; }
        __syncthreads();
        if (c.tid < 256) { float sum = 0.f;
#pragma unroll
            for (int w2 = 0; w2 < 8; ++w2) sum += ((const LAS float*)(c.lds + PART))[w2 * 256 + c.tid];
            ALR[((size_t)(16 * c.bid + 2 * c.ngw * it) * 16) + c.tid] = sum; }
    }
#undef P1_LOAD
    __syncthreads();
}

__device__ __forceinline__ float s5_e_val(const float* AP, const float* BB, int g, int row, int col) {
    if (row >= 128) return 0.f;
    const int p = row & 63, im = row >> 6, s_ = col >> 4, h = col & 15;
    const float ar = AP[((g * 17 + 15 - s_) * 64 + p) * 2], ai = AP[((g * 17 + 15 - s_) * 64 + p) * 2 + 1];
    const float br = BB[((g * 64 + p) * 16 + h) * 2], bi = BB[((g * 64 + p) * 16 + h) * 2 + 1];
    return im ? (ar * bi + ai * br) : (ar * br - ai * bi);
}
__device__ __forceinline__ float s5_f_val(const float* AP, const float* CR, const float* CI, int g, int t, int h, int col) {
    const int p = (col - 256) & 63, im = (col - 256) >> 6;
    const float ar = AP[((g * 17 + t + 1) * 64 + p) * 2], ai = AP[((g * 17 + t + 1) * 64 + p) * 2 + 1];
    const float cr = CR[(g * 16 + h) * 64 + p], ci = CI[(g * 16 + h) * 64 + p];
    return im ? -(cr * ai + ci * ar) : (cr * ar - ci * ai);
}
__device__ __forceinline__ void s5_build_mats(const Args& a, const Ctx& c) {
    const float* AP = (const float*)(a.ws + WS_APOW); const float* BB = (const float*)(a.ws + WS_S5BB);
    unsigned* E2 = (unsigned*)(a.ws + WS_SE); unsigned* MF2 = (unsigned*)(a.ws + WS_SMF); bf16_t* MF = (bf16_t*)(a.ws + WS_SMF);
    for (int q0 = c.gtid; q0 < SG * 256 * 128; q0 += 4 * c.ngt) { unsigned w[4];
#pragma unroll
        for (int j = 0; j < 4; ++j) { const int q = q0 + j * c.ngt, qq = q < SG * 256 * 128 ? q : 0, g = qq >> 15, row = (qq >> 7) & 255, col = (qq & 127) * 2;
            w[j] = pk2(s5_e_val(AP, BB, g, row, col), s5_e_val(AP, BB, g, row, col + 1)); }
#pragma unroll
        for (int j = 0; j < 4; ++j) { const int q = q0 + j * c.ngt; if (q < SG * 256 * 128) E2[q] = w[j]; } }
    for (int q0 = c.gtid; q0 < SG * 256 * 192; q0 += 4 * c.ngt) { unsigned w[4]; bool st[4];
#pragma unroll
        for (int j = 0; j < 4; ++j) { const int q = q0 + j * c.ngt, qq = q < SG * 256 * 192 ? q : 0, g = qq / (256 * 192), rem = qq % (256 * 192), row = rem / 192, col = (rem % 192) * 2, t = row >> 4, h = row & 15;
            if (col < 256) { w[j] = 0u; st[j] = (col >> 4) > t; }
            else { w[j] = pk2(s5_f_val(AP, a.in[I_CRE], a.in[I_CIM], g, t, h, col), s5_f_val(AP, a.in[I_CRE], a.in[I_CIM], g, t, h, col + 1)); st[j] = true; }
            st[j] = st[j] && (q < SG * 256 * 192); }
#pragma unroll
        for (int j = 0; j < 4; ++j) if (st[j]) MF2[q0 + j * c.ngt] = w[j]; }
    for (int idx = c.gtid; idx < SG * 16 * 256; idx += c.ngt) { const int g = idx >> 12, tau = (idx >> 8) & 15, h = (idx >> 4) & 15, h2 = idx & 15;
        float sum = 0.f;
#pragma unroll 16
        for (int p = 0; p < 64; ++p) { const float ar = AP[((g * 17 + tau) * 64 + p) * 2], ai = AP[((g * 17 + tau) * 64 + p) * 2 + 1];
            const float br = BB[((g * 64 + p) * 16 + h2) * 2], bi = BB[((g * 64 + p) * 16 + h2) * 2 + 1];
            const float cr = a.in[I_CRE][(g * 16 + h) * 64 + p], ci = a.in[I_CIM][(g * 16 + h) * 64 + p];
            const float zr = ar * br - ai * bi, zi = ar * bi + ai * br;
            sum += cr * zr - ci * zi; }
        if (tau == 0 && h == h2) sum += a.in[I_SD][g * 16 + h];
        const bf16_t kv = (bf16_t)f2bf(sum);
        for (int t = tau; t < 16; ++t) MF[((size_t)g * 256 + t * 16 + h) * 384 + (t - tau) * 16 + h2] = kv; }
}

__device__ __forceinline__ void ph2_gemm1(const Args& a, const Ctx& c) {
    pg8::DenseSched S; S.init((const bf16_t*)(a.ws + WS_HN), (const bf16_t*)(a.ws + WS_WIN_T), NTOK, NPROJ, D, c.G, c.bid);
    pg8::EpiProj E{(bf16_t*)(a.ws + WS_PROJ), (bf16_t*)(a.ws + WS_UX)};
    pg8::gemm_phase<pg8::EpiProj, pg8::DenseSched, false>(c.lds, D / 64, S, E);
}
__device__ __forceinline__ void ph6_glu(const Args& a, const Ctx& c) {
    pg8::DenseSched S; S.init((const bf16_t*)(a.ws + WS_Y5), (const bf16_t*)(a.ws + WS_GLU_T), NTOK, 512, 512, c.G, c.bid);
    pg8::EpiGlu E{(const bf16_t*)(a.ws + WS_Y5), (bf16_t*)(a.ws + WS_MIXIN), a.in[I_GLUB]};
    pg8::gemm_phase<pg8::EpiGlu, pg8::DenseSched, false>(c.lds, 512 / 64, S, E);
}
__device__ __forceinline__ void ph7_wout(const Args& a, const Ctx& c) {
    pg8::DenseSched S; S.init((const bf16_t*)(a.ws + WS_MIXIN), (const bf16_t*)(a.ws + WS_WOUT_T), NTOK, D, D, c.G, c.bid);
    pg8::EpiStore E{(bf16_t*)(a.ws + WS_MIX), D};
    pg8::gemm_phase<pg8::EpiStore, pg8::DenseSched, false>(c.lds, D / 64, S, E);
}


__device__ __forceinline__ void s5_dx_gemm(const Args& a, const Ctx& c) {
    pg8::S5Sched S{(const char*)(a.ws + WS_UX), (const char*)(a.ws + WS_SE), 256u * 256u * 2u, c.bid, 768, 512};
    pg8::EpiDX E{(float*)(a.ws + WS_DX)};
    pg8::gemm_phase<pg8::EpiDX, pg8::S5Sched, false>(c.lds, 256 / 64, S, E);
}
__device__ __forceinline__ void s5_y_gemm(const Args& a, const Ctx& c) {
    pg8::S5Sched S{(const char*)(a.ws + WS_UX), (const char*)(a.ws + WS_SMF), 256u * 384u * 2u, c.bid, 768, 768};
    pg8::EpiS5Y E{(bf16_t*)(a.ws + WS_Y5)};
    pg8::gemm_phase<pg8::EpiS5Y, pg8::S5Sched, false>(c.lds, 384 / 64, S, E);
}
__device__ __forceinline__ void s5_scan(const Args& a, const Ctx& c) {
    const float* AP = (const float*)(a.ws + WS_APOW); const float* A2 = (const float*)(a.ws + WS_A256);
    const float* DX = (const float*)(a.ws + WS_DX); bf16_t* UX = (bf16_t*)(a.ws + WS_UX);
    LAS float* ES = (LAS float*)c.lds;
    for (int bg = c.bid; bg < NB * SG; bg += c.G) { const int b = bg >> 5, g = bg & 31, seg = c.wave, p = c.lane;
        const float ar = AP[((g * 17 + 16) * 64 + p) * 2], ai = AP[((g * 17 + 16) * 64 + p) * 2 + 1];
        const float mr = A2[(g * 64 + p) * 2], mi = A2[(g * 64 + p) * 2 + 1];
        float dr[16], di[16];
        const size_t r0 = (size_t)g * 1024 + b * 128 + seg * 16;
#pragma unroll
        for (int j = 0; j < 16; ++j) { dr[j] = DX[(r0 + j) * 128 + p]; di[j] = DX[(r0 + j) * 128 + 64 + p]; }
        float xr = 0.f, xi = 0.f;
#pragma unroll
        for (int j = 0; j < 16; ++j) { const float nr = ar * xr - ai * xi + dr[j], ni = ar * xi + ai * xr + di[j]; xr = nr; xi = ni; }
        ES[(seg * 64 + p) * 2] = xr; ES[(seg * 64 + p) * 2 + 1] = xi;
        __syncthreads();
        float cr = 0.f, ci = 0.f;
        for (int s2 = 0; s2 < seg; ++s2) { const float er = ES[(s2 * 64 + p) * 2], ei = ES[(s2 * 64 + p) * 2 + 1];
            const float nr = mr * cr - mi * ci + er, ni = mr * ci + mi * cr + ei; cr = nr; ci = ni; }
        xr = cr; xi = ci;
#pragma unroll
        for (int j = 0; j < 16; ++j) { UX[(r0 + j) * 384 + 256 + p] = (bf16_t)f2bf(xr); UX[(r0 + j) * 384 + 320 + p] = (bf16_t)f2bf(xi);
            const float nr = ar * xr - ai * xi + dr[j], ni = ar * xi + ai * xr + di[j]; xr = nr; xi = ni; }
        __syncthreads();
    }
}

__device__ __forceinline__ unsigned offb(unsigned row, unsigned ch) { return 256u * row + 16u * (ch ^ (((row & 3u) << 2) | ((row >> 2) & 3u))); }
__device__ __forceinline__ unsigned offr(unsigned row, unsigned ch) { return 128u * row + 16u * (ch ^ (row & 7u)); }
__device__ __forceinline__ s16x8 tr_frag(const LAS unsigned char* img, int lane, int cb, int ks) {
    const unsigned g = lane >> 4, q = (lane & 15) >> 2, pp = lane & 3;
    const unsigned a0 = offb(32 * ks + 8 * g + q, 2 * cb + (pp >> 1)) + 8 * (pp & 1), a1 = offb(32 * ks + 8 * g + 4 + q, 2 * cb + (pp >> 1)) + 8 * (pp & 1);
    const s16x4 lo = __builtin_amdgcn_ds_read_tr16_b64_v4i16((LAS s16x4*)(img + a0)), hi = __builtin_amdgcn_ds_read_tr16_b64_v4i16((LAS s16x4*)(img + a1));
    return __builtin_shufflevector(lo, hi, 0, 1, 2, 3, 4, 5, 6, 7);
}
__device__ __forceinline__ s16x8 row_frag(const LAS unsigned char* img, int lane, int rb, int ks) {
    return *(const LAS s16x8*)(img + offr(16 * rb + (lane & 15), 4 * ks + (lane >> 4)));
}
__device__ __forceinline__ void gla_pass_a(const Args& a, const Ctx& c) {
    const bf16_t* P = (const bf16_t*)(a.ws + WS_PROJ); const float* ALR = (const float*)(a.ws + WS_ALR);
    float* BC = (float*)(a.ws + WS_BC); bf16_t* DELTA = (bf16_t*)(a.ws + WS_DELTA); float* DEC = (float*)(a.ws + WS_DEC);
    LAS float* ALRl = (LAS float*)c.lds; LAS float* TOT = (LAS float*)(c.lds + 4096);
    LAS unsigned char* KT = c.lds + 8192; LAS unsigned char* VI = c.lds + 16384; LAS bf16_t* Kl = (LAS bf16_t*)(c.lds + 32768);
    const int w = c.wave, d = c.lane;
    const int hh = (c.bid >> 5) & 3;
    float wal[16];
#pragma unroll
    for (int j = 0; j < 16; ++j) wal[j] = a.in[I_WALPHA][j * 256 + hh * 64 + d];
    const float bal = a.in[I_BALPHA][hh * 64 + d];
    f32x4 pa = (f32x4){0.f, 0.f, 0.f, 0.f}; v4u pv[2], pkt;
#define GLA_A_PREFETCH(u_) do { const int b_ = (u_) >> 7, h_ = ((u_) >> 5) & 3, ch_ = (u_) & 31; const size_t r_ = (size_t)b_ * NT + ch_ * 64; \
        if (c.tid < 256) pa = *(const f32x4*)(ALR + (r_ + (c.tid >> 2)) * 16 + (c.tid & 3) * 4); \
        _Pragma("unroll") for (int i = 0; i < 2; ++i) { const int idx = c.tid + 512 * i; pv[i] = *(const v4u*)(P + (r_ + (idx >> 4)) * NPROJ + PV + h_ * 128 + 8 * (idx & 15)); } \
        pkt = *(const v4u*)(P + (r_ + (c.tid >> 3)) * NPROJ + PK + h_ * 64 + 8 * (c.tid & 7)); } while (0)
    if (c.bid < NB * GH * 32) GLA_A_PREFETCH(c.bid);
    for (int unit = c.bid; unit < NB * GH * 32; unit += c.G) {
        const int b = unit >> 7, h = (unit >> 5) & 3, ch = unit & 31; const size_t r0 = (size_t)b * NT + ch * 64;
        if (c.tid < 256) *(LAS f32x4*)(ALRl + (c.tid >> 2) * 16 + (c.tid & 3) * 4) = pa;
#pragma unroll
        for (int i = 0; i < 2; ++i) { const int idx = c.tid + 512 * i; *(LAS v4u*)(VI + offb(idx >> 4, idx & 15)) = pv[i]; }
        *(LAS v4u*)(Kl + (c.tid >> 3) * 64 + 8 * (c.tid & 7)) = pkt;
        __syncthreads();
        if (unit + c.G < NB * GH * 32) GLA_A_PREFETCH(unit + c.G);
        float loc[8]; float run = 0.f;
#pragma unroll
        for (int tt = 0; tt < 8; ++tt) { const int t = 8 * w + tt; float z = bal;
#pragma unroll
            for (int q = 0; q < 4; ++q) { const f32x4 x = *(const LAS f32x4*)(ALRl + t * 16 + 4 * q); z += x.x * wal[4 * q] + x.y * wal[4 * q + 1] + x.z * wal[4 * q + 2] + x.w * wal[4 * q + 3]; }
            run += logsigmoidf_(z) * (1.f / 16.f); loc[tt] = run; }
        TOT[w * 64 + d] = run;
        __syncthreads();
        float pre = 0.f, total = 0.f;
#pragma unroll
        for (int w2 = 0; w2 < 8; ++w2) { const float x = TOT[w2 * 64 + d]; total += x; pre += (w2 < w) ? x : 0.f; }
        float kte[8];
#pragma unroll
        for (int tt = 0; tt < 8; ++tt) { const int t = 8 * w + tt; const float bb = loc[tt] + pre;
            BC[(r0 + t) * 256 + h * 64 + d] = bb;
            kte[tt] = bf2f(Kl[t * 64 + d]) * __expf(total - bb); }
        { v4u o; o.x = pk2(kte[0], kte[1]); o.y = pk2(kte[2], kte[3]); o.z = pk2(kte[4], kte[5]); o.w = pk2(kte[6], kte[7]);
            *(LAS v4u*)(KT + offr(d, w)) = o; }
        if (w == 0) DEC[unit * 64 + d] = __expf(total);
        __syncthreads();
        { const int db = w >> 1, vb0 = 4 * (w & 1);
            f32x4 acc[4];
#pragma unroll
            for (int i = 0; i < 4; ++i) acc[i] = (f32x4){0.f, 0.f, 0.f, 0.f};
#pragma unroll
            for (int ks = 0; ks < 2; ++ks) { const s16x8 af = row_frag(KT, c.lane, db, ks);
#pragma unroll
                for (int i = 0; i < 4; ++i) { const s16x8 bf = tr_frag(VI, c.lane, vb0 + i, ks); acc[i] = __builtin_amdgcn_mfma_f32_16x16x32_bf16(af, bf, acc[i], 0, 0, 0); } }
            __syncthreads();
            LAS bf16_t* DT = (LAS bf16_t*)VI;
#pragma unroll
            for (int i = 0; i < 4; ++i)
#pragma unroll
                for (int r = 0; r < 4; ++r) DT[(16 * db + 4 * (c.lane >> 4) + r) * 128 + 16 * (vb0 + i) + (c.lane & 15)] = (bf16_t)f2bf(acc[i][r]); }
        __syncthreads();
        { const int row = c.tid >> 3, seg = c.tid & 7;
            const LAS v4u* src = (const LAS v4u*)(VI + row * 256 + seg * 32);
            v4u* dst = (v4u*)(DELTA + (size_t)unit * 8192 + row * 128 + seg * 16);
            dst[0] = src[0]; dst[1] = src[1]; }
        __syncthreads();
    }
#undef GLA_A_PREFETCH
}
__device__ __forceinline__ void gla_pass_b(const Args& a, const Ctx& c) {
    const unsigned* DELTA = (const unsigned*)(a.ws + WS_DELTA); const float* DEC = (const float*)(a.ws + WS_DEC); unsigned* SP = (unsigned*)(a.ws + WS_SPREV);
    for (int e = c.gtid; e < NB * GH * 4096; e += c.ngt) { const int bh = __builtin_amdgcn_readfirstlane(e >> 12), d = __builtin_amdgcn_readfirstlane((e >> 6) & 63), vp = e & 63;
        float s0 = 0.f, s1 = 0.f;
        unsigned dw[32]; float dc[32];
#pragma unroll
        for (int j = 0; j < 32; ++j) { const size_t unit = (size_t)bh * 32 + j; dw[j] = DELTA[unit * 4096 + d * 64 + vp]; dc[j] = DEC[unit * 64 + d]; }
#pragma unroll
        for (int j = 0; j < 32; ++j) { const size_t unit = (size_t)bh * 32 + j; SP[unit * 4096 + d * 64 + vp] = pk2(s0, s1); s0 = dc[j] * s0 + bf2f(dw[j] & 0xffffu); s1 = dc[j] * s1 + bf2f(dw[j] >> 16); }
    }
}
__device__ __forceinline__ void gla_pass_c(const Args& a, const Ctx& c) {
    const bf16_t* P = (const bf16_t*)(a.ws + WS_PROJ); const float* BC = (const float*)(a.ws + WS_BC); const bf16_t* SPV = (const bf16_t*)(a.ws + WS_SPREV);
    bf16_t* MI = (bf16_t*)(a.ws + WS_MIXIN);
    LAS unsigned char* VI = c.lds; LAS unsigned char* SI = c.lds + 16384; LAS unsigned char* QD = c.lds + 32768; LAS unsigned char* KI = c.lds + 40960; LAS unsigned char* PI = c.lds + 49152;
    LAS float* OI = (LAS float*)(c.lds + 57344);
    const int w = c.wave, lane = c.lane, g = lane >> 4, cl = lane & 15;
    v4u pv[2], psv[2], pq, pk; f32x4 pb0, pb1;
#define GLA_C_PREFETCH(u_) do { const int b_ = (u_) >> 7, h_ = ((u_) >> 5) & 3, ch_ = (u_) & 31; const size_t r_ = (size_t)b_ * NT + ch_ * 64; \
        _Pragma("unroll") for (int i = 0; i < 2; ++i) { const int idx = c.tid + 512 * i, row = idx >> 4, cc = idx & 15; \
            pv[i] = *(const v4u*)(P + (r_ + row) * NPROJ + PV + h_ * 128 + 8 * cc); psv[i] = *(const v4u*)(SPV + (size_t)(u_) * 8192 + row * 128 + 8 * cc); } \
        { const int t = c.tid >> 3, cc = c.tid & 7; pq = *(const v4u*)(P + (r_ + t) * NPROJ + PQ + h_ * 64 + 8 * cc); pk = *(const v4u*)(P + (r_ + t) * NPROJ + PK + h_ * 64 + 8 * cc); \
            pb0 = *(const f32x4*)(BC + (r_ + t) * 256 + h_ * 64 + 8 * cc); pb1 = *(const f32x4*)(BC + (r_ + t) * 256 + h_ * 64 + 8 * cc + 4); } } while (0)
    if (c.bid < NB * GH * 32) GLA_C_PREFETCH(c.bid);
    for (int unit = c.bid; unit < NB * GH * 32; unit += c.G) {
        const int b = unit >> 7, h = (unit >> 5) & 3, ch = unit & 31; const size_t r0 = (size_t)b * NT + ch * 64;
#pragma unroll
        for (int i = 0; i < 2; ++i) { const int idx = c.tid + 512 * i, row = idx >> 4, cc = idx & 15;
            *(LAS v4u*)(VI + offb(row, cc)) = pv[i];
            *(LAS v4u*)(SI + offb(row, cc)) = psv[i]; }
        { const int t = c.tid >> 3, cc = c.tid & 7;
            const v4u q8 = pq, k8 = pk; const f32x4 b0 = pb0, b1 = pb1;
            const float bb[8] = {b0.x, b0.y, b0.z, b0.w, b1.x, b1.y, b1.z, b1.w};
            const unsigned qw[4] = {q8.x, q8.y, q8.z, q8.w}, kw[4] = {k8.x, k8.y, k8.z, k8.w};
            unsigned qo[4], ko[4];
#pragma unroll
            for (int j = 0; j < 4; ++j) { const float e0 = __expf(bb[2 * j]), e1 = __expf(bb[2 * j + 1]);
                qo[j] = pk2(bf2f(qw[j] & 0xffffu) * 0.125f * e0, bf2f(qw[j] >> 16) * 0.125f * e1);
                ko[j] = pk2(bf2f(kw[j] & 0xffffu) * __builtin_amdgcn_rcpf(e0), bf2f(kw[j] >> 16) * __builtin_amdgcn_rcpf(e1)); }
            *(LAS v4u*)(QD + offr(t, cc)) = (v4u){qo[0], qo[1], qo[2], qo[3]};
            *(LAS v4u*)(KI + offr(t, cc)) = (v4u){ko[0], ko[1], ko[2], ko[3]}; }
        v4u og0, og1; { const bf16_t* ogp = P + (r0 + (c.tid >> 3)) * NPROJ + PG + h * 128 + 16 * (c.tid & 7); og0 = *(const v4u*)ogp; og1 = *(const v4u*)(ogp + 8); }
        __syncthreads();
        if (unit + c.G < NB * GH * 32) GLA_C_PREFETCH(unit + c.G);
        { const int ib = w >> 1;
#pragma unroll
            for (int jj = 0; jj < 2; ++jj) { const int jb = 2 * (w & 1) + jj; f32x4 sc = (f32x4){0.f, 0.f, 0.f, 0.f};
                if (jb <= ib) {
#pragma unroll
                    for (int ks = 0; ks < 2; ++ks) sc = __builtin_amdgcn_mfma_f32_16x16x32_bf16(row_frag(QD, lane, ib, ks), row_frag(KI, lane, jb, ks), sc, 0, 0, 0); }
#pragma unroll
                for (int r = 0; r < 4; ++r) { const int i = 16 * ib + 4 * g + r, j = 16 * jb + cl; const float v = (j <= i) ? sc[r] : 0.f;
                    *(LAS bf16_t*)(PI + offr(i, j >> 3) + 2 * (j & 7)) = (bf16_t)f2bf(v); } } }
        __syncthreads();
        { const int ib = w >> 1, vb0 = 4 * (w & 1);
            f32x4 acc[4];
#pragma unroll
            for (int i = 0; i < 4; ++i) acc[i] = (f32x4){0.f, 0.f, 0.f, 0.f};
#pragma unroll
            for (int ks = 0; ks < 2; ++ks) { const s16x8 ap = row_frag(PI, lane, ib, ks), aq = row_frag(QD, lane, ib, ks);
#pragma unroll
                for (int i = 0; i < 4; ++i) { acc[i] = __builtin_amdgcn_mfma_f32_16x16x32_bf16(ap, tr_frag(VI, lane, vb0 + i, ks), acc[i], 0, 0, 0);
                    acc[i] = __builtin_amdgcn_mfma_f32_16x16x32_bf16(aq, tr_frag(SI, lane, vb0 + i, ks), acc[i], 0, 0, 0); } }
#pragma unroll
            for (int i = 0; i < 4; ++i)
#pragma unroll
                for (int r = 0; r < 4; ++r) OI[(16 * ib + 4 * g + r) * 132 + 16 * (vb0 + i) + cl] = acc[i][r]; }
        __syncthreads();
        { const int t = c.tid >> 3, part = c.tid & 7; float o[16]; float ss = 0.f;
#pragma unroll
            for (int q = 0; q < 4; ++q) { const f32x4 x = *(const LAS f32x4*)(OI + t * 132 + 16 * part + 4 * q); o[4 * q] = x.x; o[4 * q + 1] = x.y; o[4 * q + 2] = x.z; o[4 * q + 3] = x.w;
                ss += (x.x * x.x + x.y * x.y) + (x.z * x.z + x.w * x.w); }
            ss += __shfl_xor(ss, 1); ss += __shfl_xor(ss, 2); ss += __shfl_xor(ss, 4);
            const float rstd = rsqrtf(ss * (1.f / 128.f) + EPS);
            const v4u g0 = og0, g1 = og1;
            const unsigned gw[8] = {g0.x, g0.y, g0.z, g0.w, g1.x, g1.y, g1.z, g1.w};
            unsigned ow[8];
#pragma unroll
            for (int j = 0; j < 8; ++j) { const float ga = bf2f(gw[j] & 0xffffu), gb = bf2f(gw[j] >> 16);
                const float n0 = a.in[I_GLANORM][16 * part + 2 * j], n1 = a.in[I_GLANORM][16 * part + 2 * j + 1];
                ow[j] = pk2(o[2 * j] * rstd * n0 * (ga * sigmoidf_(ga)), o[2 * j + 1] * rstd * n1 * (gb * sigmoidf_(gb))); }
            bf16_t* dst = MI + (r0 + t) * D + h * 128 + 16 * part;
            *(v4u*)dst = (v4u){ow[0], ow[1], ow[2], ow[3]}; *(v4u*)(dst + 8) = (v4u){ow[4], ow[5], ow[6], ow[7]}; }
    }
    __syncthreads();
#undef GLA_C_PREFETCH
}

constexpr int RT_PITCH = 2064, RT_LO = 16 * RT_PITCH, RT_PART = 2 * RT_LO;
__device__ __forceinline__ void ph8_norm2_router(const Args& a, const Ctx& c) {
    const float* mod = (const float*)(a.ws + WS_MOD);
    const bf16_t* MX = (const bf16_t*)(a.ws + WS_MIX);
    bf16_t* HN = (bf16_t*)(a.ws + WS_HN); bf16_t* H1B = (bf16_t*)(a.ws + WS_H1);
    unsigned* cnt = (unsigned*)(a.ws + WS_CTL) + CW_CNT;
    int* RE = (int*)(a.ws + WS_ROUTE_E); float* RW = (float*)(a.ws + WS_ROUTE_W); int* LIST = (int*)(a.ws + WS_LIST);
    s16x8 rwh[4][2], rwl[4][2];
#pragma unroll
    for (int ks = 0; ks < 4; ++ks)
#pragma unroll
        for (int cb = 0; cb < 2; ++cb) { float wv[8];
#pragma unroll
            for (int j = 0; j < 8; ++j) wv[j] = a.in[I_RW][(size_t)(128 * c.wave + 32 * ks + 8 * (c.lane >> 4) + j) * 32 + 16 * cb + (c.lane & 15)];
            unsigned hh[4], ll[4];
#pragma unroll
            for (int j = 0; j < 4; ++j) { hh[j] = pk2(wv[2 * j], wv[2 * j + 1]); ll[j] = pk2(wv[2 * j] - bf2f(hh[j] & 0xffffu), wv[2 * j + 1] - bf2f(hh[j] >> 16)); }
            rwh[ks][cb] = __builtin_bit_cast(s16x8, (v4u){hh[0], hh[1], hh[2], hh[3]}); rwl[ks][cb] = __builtin_bit_cast(s16x8, (v4u){ll[0], ll[1], ll[2], ll[3]}); }
    LAS unsigned* lcnt = (LAS unsigned*)(c.lds + 131072);
    LAS unsigned* lent = (LAS unsigned*)(c.lds + 131072 + 512);
    if (c.tid < 128) lcnt[c.tid] = 0u;
    __syncthreads();
#pragma unroll 1
    for (int it = 0; it < 4; ++it) { const int row0 = 2 * c.gw + 2 * c.ngw * it;
        const int b = row0 / NT;
        f32x4 y[2][4];
        v2u mwb[1][2][4]; f32x4 xvb[1][2][4]; constexpr int cbuf = 0;
#pragma unroll
        for (int r = 0; r < 2; ++r)
#pragma unroll
            for (int j = 0; j < 4; ++j) { const int col = 4 * c.lane + 256 * j; mwb[0][r][j] = __builtin_nontemporal_load((const v2u*)(MX + (size_t)(row0 + r) * D + col));
                xvb[0][r][j] = __builtin_nontemporal_load((const f32x4*)(a.in[I_X] + (size_t)(row0 + r) * D + col)); }
        f32x4 gmv[4], g1v[4], gfv[4], shv[4], scv[4];
#pragma unroll
        for (int j = 0; j < 4; ++j) { const int col = 4 * c.lane + 256 * j; gmv[j] = *(const f32x4*)(a.in[I_MIXPOST] + col); g1v[j] = *(const f32x4*)(mod + b * 6144 + 2048 + col);
            gfv[j] = *(const f32x4*)(a.in[I_FFNPRE] + col); shv[j] = *(const f32x4*)(mod + b * 6144 + 3072 + col); scv[j] = *(const f32x4*)(mod + b * 6144 + 4096 + col) + 1.f; }
#pragma unroll
        for (int r = 0; r < 2; ++r) { const int row = row0 + r;
            f32x4 m[4]; float ss = 0.f;
#pragma unroll
            for (int j = 0; j < 4; ++j) { const v2u w = mwb[cbuf][r][j];
                m[j] = (f32x4){bf2f(w.x & 0xffffu), bf2f(w.x >> 16), bf2f(w.y & 0xffffu), bf2f(w.y >> 16)};
                ss += (m[j].x * m[j].x + m[j].y * m[j].y) + (m[j].z * m[j].z + m[j].w * m[j].w); }
            const float rstd = rsqrtf(wave_sum(ss) * (1.f / D) + EPS);
            float s2 = 0.f;
#pragma unroll
            for (int j = 0; j < 4; ++j) { const int col = 4 * c.lane + 256 * j;
                m[j] = xvb[cbuf][r][j] + g1v[j] * (m[j] * rstd * gmv[j]);
                { v2u o; o.x = pk2(m[j].x, m[j].y); o.y = pk2(m[j].z, m[j].w); *(v2u*)(H1B + (size_t)row * D + col) = o; }
                s2 += (m[j].x * m[j].x + m[j].y * m[j].y) + (m[j].z * m[j].z + m[j].w * m[j].w); }
            const float rstd2 = rsqrtf(wave_sum(s2) * (1.f / D) + EPS);
#pragma unroll
            for (int j = 0; j < 4; ++j) { const int col = 4 * c.lane + 256 * j;
                y[r][j] = m[j] * rstd2 * gfv[j] * scv[j] + shv[j];
                *(unsigned*)((unsigned char*)HN + (size_t)row * D + col) = pk4_fp8(y[r][j].x, y[r][j].y, y[r][j].z, y[r][j].w); } }
#pragma unroll
        for (int r = 0; r < 2; ++r)
#pragma unroll
            for (int j = 0; j < 4; ++j) { const f32x4 v = y[r][j];
                const unsigned h0 = pk2(v.x, v.y), h1 = pk2(v.z, v.w);
                const unsigned l0 = pk2(v.x - bf2f(h0 & 0xffffu), v.y - bf2f(h0 >> 16)), l1 = pk2(v.z - bf2f(h1 & 0xffffu), v.w - bf2f(h1 >> 16));
                const int off = (2 * c.wave + r) * RT_PITCH + (4 * c.lane + 256 * j) * 2;
                *(LAS v2u*)(c.lds + off) = (v2u){h0, h1}; *(LAS v2u*)(c.lds + RT_LO + off) = (v2u){l0, l1}; }
        __syncthreads();
        { f32x4 pacc[2] = {(f32x4){0.f, 0.f, 0.f, 0.f}, (f32x4){0.f, 0.f, 0.f, 0.f}};
#pragma unroll
            for (int ks = 0; ks < 4; ++ks) { const int aoff = (c.lane & 15) * RT_PITCH + (128 * c.wave + 32 * ks + 8 * (c.lane >> 4)) * 2;
                const s16x8 ahi = *(const LAS s16x8*)(c.lds + aoff), alo = *(const LAS s16x8*)(c.lds + RT_LO + aoff);
#pragma unroll
                for (int cb = 0; cb < 2; ++cb) { pacc[cb] = __builtin_amdgcn_mfma_f32_16x16x32_bf16(ahi, rwh[ks][cb], pacc[cb], 0, 0, 0);
                    pacc[cb] = __builtin_amdgcn_mfma_f32_16x16x32_bf16(ahi, rwl[ks][cb], pacc[cb], 0, 0, 0);
                    pacc[cb] = __builtin_amdgcn_mfma_f32_16x16x32_bf16(alo, rwh[ks][cb], pacc[cb], 0, 0, 0); } }
            LAS float* part = (LAS float*)(c.lds + RT_PART) + c.wave * 512;
#pragma unroll
            for (int cb = 0; cb < 2; ++cb)
#pragma unroll
                for (int r = 0; r < 4; ++r) part[(4 * (c.lane >> 4) + r) * 32 + 16 * cb + (c.lane & 15)] = pacc[cb][r]; }
        __syncthreads();
        const int e = c.lane & 31, row = row0 + (c.lane >> 5), l4 = c.lane & 31;
        float val = a.in[I_RB][e];
#pragma unroll
        for (int w2 = 0; w2 < 8; ++w2) val += ((const LAS float*)(c.lds + RT_PART))[w2 * 512 + (c.tid >> 5) * 32 + e];
        int sel_e[4]; float sel_v[4];
#pragma unroll
        for (int k = 0; k < 4; ++k) { float mx = val;
#pragma unroll
            for (int o = 1; o < 32; o <<= 1) mx = fmaxf(mx, __shfl_xor(mx, o));
            const unsigned long long bal = __ballot(val == mx);
            const unsigned half = (unsigned)(c.lane >> 5 ? (bal >> 32) : (bal & 0xffffffffull));
            const int idx = __ffs((int)half) - 1;
            sel_e[k] = idx; sel_v[k] = mx; if (e == idx) val = -3.0e38f; }
        const float e0 = 1.f, e1 = __expf(sel_v[1] - sel_v[0]), e2 = __expf(sel_v[2] - sel_v[0]), e3 = __expf(sel_v[3] - sel_v[0]);
        const float inv = 1.f / (e0 + e1 + e2 + e3);
        if (l4 < 4) { const int ee = l4 == 0 ? sel_e[0] : l4 == 1 ? sel_e[1] : l4 == 2 ? sel_e[2] : sel_e[3];
            const float wv = (l4 == 0 ? e0 : l4 == 1 ? e1 : l4 == 2 ? e2 : e3) * inv;
            const unsigned ls = __hip_atomic_fetch_add((LAS unsigned*)lcnt + ee, 1u, __ATOMIC_RELAXED, __HIP_MEMORY_SCOPE_WORKGROUP);
            const unsigned en = __hip_atomic_fetch_add((LAS unsigned*)lcnt + 32, 1u, __ATOMIC_RELAXED, __HIP_MEMORY_SCOPE_WORKGROUP);
            lent[en & 511u] = (unsigned)row * 4u + (unsigned)l4; lent[512 + (en & 511u)] = (unsigned)ee | (ls << 8); RW[row * 4 + l4] = wv; }
    }
    __syncthreads();
    if (c.tid < 32) lcnt[64 + c.tid] = atomicAdd(cnt + c.tid * 64, lcnt[c.tid]);
    __syncthreads();
    { const unsigned nent = lcnt[32];
        for (unsigned t = c.tid; t < nent; t += NTHR) { const unsigned rk = lent[t], es = lent[512 + t], ee = es & 255u, slot = lcnt[64 + ee] + (es >> 8);
            RE[rk] = (int)(ee | (slot << 8)); LIST[ee * LISTCAP + slot] = (int)(rk >> 2); } }
    __syncthreads();
}

__device__ __forceinline__ void build_pstart(const Args& a, const Ctx& c, LAS int* ps, LAS int* cn) {
    if (c.tid < 64) {
        const unsigned* cnt = (const unsigned*)(a.ws + WS_CTL) + CW_CNT;
        const int n = c.tid < NE ? (int)__hip_atomic_load(cnt + c.tid * 64, __ATOMIC_RELAXED, __HIP_MEMORY_SCOPE_AGENT) : 0;
        const int pad = ((n + 255) >> 8) << 8; int inc = pad;
#pragma unroll
        for (int o = 1; o < 32; o <<= 1) { const int t = __shfl_up(inc, o); if (c.tid >= o) inc += t; }
        if (c.tid < NE) { ps[c.tid] = inc - pad; cn[c.tid] = n; }
        if (c.tid == NE - 1) ps[NE] = inc; }
    __syncthreads();
}
template <bool GATHER> __device__ __forceinline__ void exp_tables(const Args& a, const Ctx& c, pg8::ExpSched& S) {
    LAS int* ps = (LAS int*)(c.lds + pg8::XT_PS); LAS int* cn = ps + 33; LAS unsigned char* te = (LAS unsigned char*)(c.lds + pg8::XT_PS + 260);
    build_pstart(a, c, ps, cn);
    const int nT = ps[NE] >> 8;
    for (int t = c.tid; t < nT; t += NTHR) { int e = 0; for (int q = 1; q < NE; ++q) e = (t * 256 >= ps[q]) ? q : e; te[t] = (unsigned char)e; }
    __syncthreads();
    S.nT = nT; S.lds = c.lds; S.G = c.G; S.c = c.bid; S.ident = GATHER ? 0 : 1;
    { const int* LIST = (const int*)(a.ws + WS_LIST); LAS unsigned short* tk = (LAS unsigned short*)(c.lds + pg8::XT_TOK); LAS float* bt = (LAS float*)(c.lds + pg8::XT_BIAS);
        constexpr int MAXU = 10;
        int tokv[MAXU]; float biasv[MAXU];
        if (c.tid < 256) {
#pragma unroll
            for (int i = 0; i < MAXU; ++i) { pg8::Unit u; const bool ok = S.next(i, u); tokv[i] = 0; biasv[i] = 0.f;
                if (ok) { if (GATHER) { const int slot = u.pm * 256 - ps[u.e] + c.tid; if (slot < cn[u.e]) tokv[i] = LIST[u.e * LISTCAP + slot];
                        biasv[i] = a.in[I_BGU][u.e * 2048 + (c.tid >> 7) * 1024 + u.pn * 128 + (c.tid & 127)]; }
                    else biasv[i] = a.in[I_BDN][u.e * 1024 + u.pn * 256 + c.tid]; } }
#pragma unroll
            for (int i = 0; i < MAXU; ++i) { if (GATHER) tk[i * 256 + c.tid] = (unsigned short)tokv[i]; bt[i * 256 + c.tid] = biasv[i]; }
            if (!GATHER) tk[c.tid] = (unsigned short)c.tid; }
        __syncthreads(); }
}
__device__ __forceinline__ void ph10_exp1(const Args& a, const Ctx& c) {
    pg8::ExpSched S; S.A = (const char*)(a.ws + WS_HN); S.W = (const char*)(a.ws + WS_GU_T); S.nN = 8; S.ldaB = D; S.ldbB = D; S.estride = 2048u * 1024u;
    exp_tables<true>(a, c, S);
    pg8::EpiSwiglu E{(unsigned char*)(a.ws + WS_HACT), (const LAS float*)(c.lds + pg8::XT_BIAS)};
    pg8::gemm_phase<pg8::EpiSwiglu, pg8::ExpSched, true, true>(c.lds, D / 128, S, E);
}
__device__ __forceinline__ void ph11_exp2(const Args& a, const Ctx& c) {
    pg8::ExpSched S; S.A = (const char*)(a.ws + WS_HACT); S.W = (const char*)(a.ws + WS_DN_T); S.nN = 4; S.ldaB = DFF; S.ldbB = DFF; S.estride = 1024u * 1024u;
    exp_tables<false>(a, c, S);
    pg8::EpiDown E{(unsigned char*)(a.ws + WS_YEXP), (const LAS float*)(c.lds + pg8::XT_BIAS)};
    pg8::gemm_phase<pg8::EpiDown, pg8::ExpSched, true, true, true, true>(c.lds, DFF / 128, S, E);
}

__device__ __forceinline__ f32x4 fp8x4_to_f32(unsigned w) { const f32x2_t lo = __builtin_amdgcn_cvt_pk_f32_fp8((int)w, false), hi = __builtin_amdgcn_cvt_pk_f32_fp8((int)w, true); return (f32x4){lo.x, lo.y, hi.x, hi.y}; }
__device__ __forceinline__ void ph12_final(const Args& a, const Ctx& c) {
    LAS int* ps = (LAS int*)c.lds; LAS int* cn = ps + 64;
    build_pstart(a, c, ps, cn);
    const float* mod = (const float*)(a.ws + WS_MOD);
    const unsigned char* YE = (const unsigned char*)(a.ws + WS_YEXP); const bf16_t* H1B = (const bf16_t*)(a.ws + WS_H1);
    const int* RE = (const int*)(a.ws + WS_ROUTE_E); const float* RW = (const float*)(a.ws + WS_ROUTE_W);
    int4 reA[4][2]; f32x4 rwA[4][2];
#pragma unroll
    for (int it = 0; it < 4; ++it)
#pragma unroll
        for (int r = 0; r < 2; ++r) { const int row = 2 * c.gw + 2 * c.ngw * it + r; const int rc = row < NTOK ? row : 0;
            reA[it][r] = *(const int4*)(RE + rc * 4); rwA[it][r] = *(const f32x4*)(RW + rc * 4); }
#pragma unroll
    for (int it = 0; it < 4; ++it) { const int row0 = 2 * c.gw + 2 * c.ngw * it; if (row0 >= NTOK) break;
        const int b = row0 / NT;
        int4 re[2]; f32x4 rw[2];
#pragma unroll
        for (int r = 0; r < 2; ++r) { re[r] = reA[it][r]; rw[r] = rwA[it][r]; }
        v2u hw[2][4];
#pragma unroll
        for (int r = 0; r < 2; ++r)
#pragma unroll
            for (int j = 0; j < 4; ++j) hw[r][j] = __builtin_nontemporal_load((const v2u*)(H1B + (size_t)(row0 + r) * D + 4 * c.lane + 256 * j));
        f32x4 f[2][4];
#pragma unroll
        for (int r = 0; r < 2; ++r) { const int rr[4] = {re[r].x, re[r].y, re[r].z, re[r].w}; const float ww[4] = {rw[r].x, rw[r].y, rw[r].z, rw[r].w};
            unsigned yw[4][4];
#pragma unroll
            for (int k = 0; k < 4; ++k) { const size_t pos = (size_t)(ps[rr[k] & 255] + (rr[k] >> 8));
#pragma unroll
                for (int j = 0; j < 4; ++j) yw[k][j] = __builtin_nontemporal_load((const unsigned*)(YE + pos * D + 4 * c.lane + 256 * j)); }
#pragma unroll
            for (int j = 0; j < 4; ++j) { f[r][j] = fp8x4_to_f32(yw[0][j]) * ww[0];
#pragma unroll
                for (int k = 1; k < 4; ++k) f[r][j] += fp8x4_to_f32(yw[k][j]) * ww[k]; } }
        f32x4 gfv[4], g2v[4];
#pragma unroll
        for (int j = 0; j < 4; ++j) { const int col = 4 * c.lane + 256 * j; gfv[j] = *(const f32x4*)(a.in[I_FFNPOST] + col); g2v[j] = *(const f32x4*)(mod + b * 6144 + 5120 + col); }
#pragma unroll
        for (int r = 0; r < 2; ++r) { float sf = 0.f;
#pragma unroll
            for (int j = 0; j < 4; ++j) sf += (f[r][j].x * f[r][j].x + f[r][j].y * f[r][j].y) + (f[r][j].z * f[r][j].z + f[r][j].w * f[r][j].w);
            const float rf = rsqrtf(wave_sum(sf) * (1.f / (D * Y8_SCALE * Y8_SCALE)) + EPS) * (1.f / Y8_SCALE);
#pragma unroll
            for (int j = 0; j < 4; ++j) { const int col = 4 * c.lane + 256 * j;
                const f32x4 gf = gfv[j], g2 = g2v[j];
                const f32x4 h = (f32x4){bf2f(hw[r][j].x & 0xffffu), bf2f(hw[r][j].x >> 16), bf2f(hw[r][j].y & 0xffffu), bf2f(hw[r][j].y >> 16)};
                __builtin_nontemporal_store(h + g2 * (f[r][j] * rf * gf), (f32x4*)(a.out + (size_t)(row0 + r) * D + col)); } }
    }
}

constexpr int NPHASE = 13;
__global__ void __launch_bounds__(NTHR, 2) mk_fwd(Args a) {
    extern __shared__ __attribute__((aligned(16))) unsigned char lds_raw[];
    Ctx c;
    c.lds = (LAS unsigned char*)lds_raw;
    c.tid = threadIdx.x; c.lane = c.tid & 63; c.wave = __builtin_amdgcn_readfirstlane(c.tid >> 6);
    c.bid = blockIdx.x; c.G = gridDim.x; c.gw = c.bid * NWAVES + c.wave; c.ngw = c.G * NWAVES; c.gtid = c.bid * NTHR + c.tid; c.ngt = c.G * NTHR;
    volatile LAS unsigned* MISC = (volatile LAS unsigned*)(c.lds + MISC_OFF);
    if (c.tid < 32) MISC[c.tid] = 0u;
    __syncthreads();
    const bool one = (a.ph_hi - a.ph_lo) > 1;
    XcdBarrier bar; bar.bar = (unsigned*)(a.ws + WS_CTL) + CW_BAR; bar.x = 0; bar.st = MISC + 8;
    if (one) bar = xcd_barrier_post((unsigned*)(a.ws + WS_CTL) + CW_BAR, MISC + 8);
    const int lo = a.ph_lo, hi = a.ph_hi;
#define IN(k) (lo <= (k) && (k) < hi)
#define SEAM(k) do { if (IN(k) && IN((k) + 1)) { if ((k) <= 8) xcd_barrier_conv(bar, a, c, (k)); else xcd_barrier(bar); } else __syncthreads(); } while (0)
    if (IN(0)) { ph0_prologue(a, c); SEAM(0); }
    if (IN(1)) { ph1_norm1(a, c); s5_build_mats(a, c); SEAM(1); }
    if (IN(2)) { ph2_gemm1(a, c); SEAM(2); }
    if (IN(3)) { gla_pass_a(a, c); s5_dx_gemm(a, c);
        if (c.bid < 128) { for (int wi = WI_P3 + c.bid * 8 + c.wave; wi < WI_P5; wi += 1024) wconv_item(a, c.lds + c.wave * 5120, wi, c.lane); __syncthreads(); }
        SEAM(3); }
    if (IN(4)) { gla_pass_b(a, c); s5_scan(a, c); SEAM(4); }
    if (IN(5)) { gla_pass_c(a, c); s5_y_gemm(a, c);
        if (c.bid < 128) { for (int wi = WI_P5 + c.bid * 8 + c.wave; wi < WI_P6; wi += 1024) wconv_item(a, c.lds + c.wave * 5120, wi, c.lane); __syncthreads(); }
        SEAM(5); }
    if (IN(6)) { ph6_glu(a, c);
        if (c.bid >= 128) { for (int wi = WI_P6 + (c.bid - 128) * 8 + c.wave; wi < WI_END; wi += 1024) wconv_item(a, c.lds + c.wave * 5120, wi, c.lane); __syncthreads(); }
        SEAM(6); }
    if (IN(7)) { ph7_wout(a, c); SEAM(7); }
    if (IN(8)) { ph8_norm2_router(a, c); if (IN(10)) xcd_barrier_conv(bar, a, c, 8); else __syncthreads(); }
    if (IN(10)) { ph10_exp1(a, c); SEAM(10); }
    if (IN(11)) { ph11_exp2(a, c); SEAM(11); }
    if (IN(12)) { ph12_final(a, c); }
#undef IN
#undef SEAM
}

extern "C" void kernel_launch(void* const* d_in, const int* in_sizes, int n_in, void* d_out, int out_size, void* d_ws, size_t ws_size, hipStream_t stream) {
    static int grid = 0;
    if (grid == 0) {
        if (n_in != 29 || in_sizes[0] != NTOK * D || out_size != NTOK * D || ws_size < WS_END) {
            fprintf(stderr, "kernel_launch: unexpected shapes (n_in %d, in0 %d, out %d, ws %zu < %zu)\n", n_in, n_in > 0 ? in_sizes[0] : -1, out_size, ws_size, (size_t)WS_END); grid = -1; return; }
        int dev = 0, cus = 0, per_cu = 0;
        if (hipGetDevice(&dev) != hipSuccess || hipDeviceGetAttribute(&cus, hipDeviceAttributeMultiprocessorCount, dev) != hipSuccess) { grid = -1; return; }
        if (hipFuncSetAttribute((const void*)mk_fwd, hipFuncAttributeMaxDynamicSharedMemorySize, LDS_BYTES) != hipSuccess) { fprintf(stderr, "kernel_launch: hipFuncSetAttribute failed\n"); grid = -1; return; }
        if (hipOccupancyMaxActiveBlocksPerMultiprocessor(&per_cu, (const void*)mk_fwd, NTHR, LDS_BYTES) != hipSuccess || per_cu < 1)
            fprintf(stderr, "kernel_launch: occupancy query reports %d\n", per_cu);
        (void)hipGetLastError();
        grid = 256;
        if (cus != 256) fprintf(stderr, "kernel_launch: built for a 256-CU device, found %d CUs\n", cus);
    }
    if (grid < 0) return;
    (void)hipMemsetAsync((char*)d_ws + WS_CTL, 0, CTL_BYTES, stream);
    Args a{};
    for (int i = 0; i < 29; ++i) a.in[i] = (const float*)d_in[i];
    a.out = (float*)d_out; a.ws = (unsigned char*)d_ws;
    a.ph_lo = 0; a.ph_hi = NPHASE;
    hipLaunchKernelGGL(mk_fwd, dim3(grid), dim3(NTHR), LDS_BYTES, stream, a);
}
```
